# Optimizing an MI355X kernel written in HIP

```python
import math
import jax
import jax.numpy as jnp
from jax import lax
import numpy as np

D_MODEL = 1024
BATCH = 8
SEQ = 8192
DEPTH = 2
DEC_BATCH = 16
DEC_SEQ = 16
PAST_LEN = 1024

CHUNK = 64
N_EVEN = (DEPTH + 1) // 2
N_ODD = DEPTH // 2
RMS_EPS = 1e-6
L2_EPS = 1e-6

S5_WIDTH = D_MODEL // 2
S5_GROUP = 16
S5_GROUPS = S5_WIDTH // S5_GROUP
S5_P = 64

GDN_DK = 128
GDN_DV = 128
GDN_HEADS = (D_MODEL - S5_WIDTH) // GDN_DV
GDN_QK = GDN_HEADS * GDN_DK
GDN_V = GDN_HEADS * GDN_DV
GDN_CONV = 4
GDN_CONV_CH = 2 * GDN_QK + GDN_V

OFF_QKV = S5_WIDTH
OFF_Z = OFF_QKV + GDN_CONV_CH
OFF_B = OFF_Z + GDN_V
OFF_A = OFF_B + GDN_HEADS
IN_COLS = OFF_A + GDN_HEADS
D_MIX_AB = S5_WIDTH + GDN_V

SWA_HEADS = 16
SWA_KV_HEADS = 4
SWA_GROUPS = SWA_HEADS // SWA_KV_HEADS
SWA_HEAD_DIM = 64
WINDOW = 128
WIN_CHUNKS = -(-WINDOW // CHUNK)
KV_WIN = min(WINDOW, PAST_LEN)

D_FF = -(-8 * D_MODEL // (3 * 256)) * 256

kernel_name = "hybrid_s5_gdn_swa_stream_step"


def rmsnorm(x, w):
    xf = x.astype(jnp.float32)
    y = xf * lax.rsqrt(jnp.mean(xf * xf, axis=-1, keepdims=True) + RMS_EPS)
    return (y * w.astype(jnp.float32)).astype(x.dtype)


def l2norm(x):
    return x * lax.rsqrt(jnp.sum(x * x, axis=-1, keepdims=True) + L2_EPS)


def swiglu(h, w_gate, w_up, w_down):
    return (jax.nn.silu(h @ w_gate) * (h @ w_up)) @ w_down


def s5_mixer(u, x0_re, x0_im, lam_re, lam_im, log_dt, b_re, b_im, c_re, c_im, d, w_glu, b_glu, chunk):
    f32 = jnp.float32
    bsz, L, _ = u.shape
    n = L // chunk
    uf = u.astype(f32).reshape(bsz, L, S5_GROUPS, S5_GROUP)
    lam = lax.complex(lam_re.astype(f32), lam_im.astype(f32))
    dt = jnp.exp(log_dt.astype(f32))[:, None]
    lam_bar = jnp.exp(lam * dt)
    b_bar = ((lam_bar - 1.0) / lam)[..., None] * lax.complex(b_re.astype(f32), b_im.astype(f32))
    c = lax.complex(c_re.astype(f32), c_im.astype(f32))
    a_blk = jnp.broadcast_to(lam_bar, (bsz, chunk, S5_GROUPS, S5_P))

    def combine(e1, e2):
        a1, b1 = e1
        a2, b2 = e2
        return a1 * a2, a2 * b1 + b2

    def step(carry, u_blk):
        bu = jnp.einsum('gpc,btgc->btgp', b_bar, u_blk.astype(jnp.complex64))
        bu = bu.at[:, 0].add(lam_bar * carry)
        _, xs = lax.associative_scan(combine, (a_blk, bu), axis=1)
        y_blk = jnp.einsum('gcp,btgp->btgc', c, xs).real
        return xs[:, -1], y_blk

    x0 = lax.complex(x0_re.astype(f32), x0_im.astype(f32))
    u_blocks = jnp.moveaxis(uf.reshape(bsz, n, chunk, S5_GROUPS, S5_GROUP), 1, 0)
    x_last, y = lax.scan(step, x0, u_blocks)
    y = jnp.moveaxis(y, 0, 1).reshape(bsz, L, S5_GROUPS, S5_GROUP)
    y = y + d.astype(f32).reshape(S5_GROUPS, S5_GROUP) * uf
    y = y.reshape(bsz, L, S5_WIDTH).astype(u.dtype)
    z = jax.nn.gelu(y)
    out = z * jax.nn.sigmoid(z @ w_glu + b_glu)
    return out, x_last.real, x_last.imag


def causal_conv(x, buf, w):
    L = x.shape[1]
    xp = jnp.concatenate([buf.astype(x.dtype), x], axis=1)
    y = xp[:, 0:L] * w[0]
    for j in range(1, GDN_CONV):
        y = y + xp[:, j:j + L] * w[j]
    return y, xp[:, -(GDN_CONV - 1):]


def gated_delta_chunked(q, k, v, g, beta, s0, chunk):
    bsz, L, H, _ = q.shape
    n = L // chunk

    def blk(t):
        t = t.reshape((bsz, n, chunk, H) + t.shape[3:])
        return jnp.moveaxis(t, 3, 1)

    q, k, v, g, beta = blk(q), blk(k), blk(v), blk(g), blk(beta)
    gc = jnp.cumsum(g, axis=-1)
    idx = jnp.arange(chunk)
    incl = idx[:, None] >= idx[None, :]
    strict = idx[:, None] > idx[None, :]
    decay = jnp.exp(jnp.where(incl, gc[..., :, None] - gc[..., None, :], -jnp.inf))
    kb = k * beta[..., None]
    a_mat = jnp.where(strict, jnp.einsum('bhnid,bhnjd->bhnij', kb, k) * decay, 0.0)
    eye = jnp.eye(chunk, dtype=q.dtype)
    t_inv = lax.linalg.triangular_solve(a_mat + eye, jnp.broadcast_to(eye, a_mat.shape),
                                        left_side=True, lower=True, unit_diagonal=True)
    gexp = jnp.exp(gc)[..., None]
    u_val = t_inv @ (v * beta[..., None])
    w_key = t_inv @ (kb * gexp)
    q_dec = q * gexp
    attn = jnp.einsum('bhnid,bhnjd->bhnij', q, k) * decay
    k_dec = k * jnp.exp(gc[..., -1:] - gc)[..., None]
    g_last = jnp.exp(gc[..., -1])

    def step(s, xs):
        u_c, w_c, q_c, a_c, k_c, gl = xs
        v_new = u_c - w_c @ s
        o = q_c @ s + a_c @ v_new
        s = s * gl[..., None, None] + jnp.swapaxes(k_c, -1, -2) @ v_new
        return s, o

    xs = tuple(jnp.moveaxis(t, 2, 0) for t in (u_val, w_key, q_dec, attn, k_dec, g_last))
    s_fin, o = lax.scan(step, s0, xs)
    o = jnp.moveaxis(jnp.moveaxis(o, 0, 2), 1, 3).reshape(bsz, L, H, -1)
    return o, s_fin


def gdn_mixer(qkv, z, b, a, conv_buf, s0, conv_w, a_log, dt_bias, norm_w, chunk):
    f32 = jnp.float32
    bsz, L, _ = qkv.shape
    y, new_buf = causal_conv(qkv, conv_buf, conv_w)
    y = jax.nn.silu(y).astype(f32)
    q = l2norm(y[..., :GDN_QK].reshape(bsz, L, GDN_HEADS, GDN_DK)) * (GDN_DK ** -0.5)
    k = l2norm(y[..., GDN_QK:2 * GDN_QK].reshape(bsz, L, GDN_HEADS, GDN_DK))
    v = y[..., 2 * GDN_QK:].reshape(bsz, L, GDN_HEADS, GDN_DV)
    beta = jax.nn.sigmoid(b.astype(f32))
    g = -jnp.exp(a_log.astype(f32)) * jax.nn.softplus(a.astype(f32) + dt_bias.astype(f32))
    o, s_fin = gated_delta_chunked(q, k, v, g, beta, s0.astype(f32), chunk)
    o = rmsnorm(o, norm_w) * jax.nn.silu(z.astype(f32).reshape(bsz, L, GDN_HEADS, GDN_DV))
    return o.reshape(bsz, L, GDN_V).astype(qkv.dtype), s_fin, new_buf


def mixer_ab(h, x0_re, x0_im, s0, conv_buf, w_in, lam_re, lam_im, log_dt, b_re, b_im, c_re, c_im,
             d, w_glu, b_glu, conv_w, a_log, dt_bias, norm_w, w_out, chunk):
    proj = h @ w_in
    a_out, x_re, x_im = s5_mixer(proj[..., :OFF_QKV], x0_re, x0_im, lam_re, lam_im, log_dt,
                                 b_re, b_im, c_re, c_im, d, w_glu, b_glu, chunk)
    b_out, s_fin, new_buf = gdn_mixer(proj[..., OFF_QKV:OFF_Z], proj[..., OFF_Z:OFF_B],
                                      proj[..., OFF_B:OFF_A], proj[..., OFF_A:IN_COLS],
                                      conv_buf, s0, conv_w, a_log, dt_bias, norm_w, chunk)
    out = jnp.concatenate([a_out, b_out], axis=-1) @ w_out
    return out, x_re, x_im, s_fin, new_buf


def sink_softmax(scores, sinks):
    sk = jnp.broadcast_to(sinks.astype(jnp.float32).reshape(SWA_KV_HEADS, SWA_GROUPS, 1, 1),
                          scores.shape[:-1] + (1,))
    return jax.nn.softmax(jnp.concatenate([scores, sk], axis=-1), axis=-1)[..., :-1]


def swa_prompt(h, wq, wk, wv, sinks, wo):
    bsz, L, _ = h.shape
    n = L // CHUNK
    span = (WIN_CHUNKS + 1) * CHUNK
    q = (h @ wq).reshape(bsz, n, CHUNK, SWA_KV_HEADS, SWA_GROUPS, SWA_HEAD_DIM)
    k = (h @ wk).reshape(bsz, L, SWA_KV_HEADS, SWA_HEAD_DIM)
    v = (h @ wv).reshape(bsz, L, SWA_KV_HEADS, SWA_HEAD_DIM)
    pad = ((0, 0), (WIN_CHUNKS, 0), (0, 0), (0, 0), (0, 0))
    kp = jnp.pad(k.reshape(bsz, n, CHUNK, SWA_KV_HEADS, SWA_HEAD_DIM), pad)
    vp = jnp.pad(v.reshape(bsz, n, CHUNK, SWA_KV_HEADS, SWA_HEAD_DIM), pad)
    kband = jnp.concatenate([kp[:, j:j + n] for j in range(WIN_CHUNKS + 1)], axis=2)
    vband = jnp.concatenate([vp[:, j:j + n] for j in range(WIN_CHUNKS + 1)], axis=2)
    key_chunk = jnp.arange(n)[:, None] - WIN_CHUNKS + jnp.arange(span)[None, :] // CHUNK
    valid = key_chunk >= 0
    scores = jnp.einsum('bnqkgd,bnskd->bnkgqs', q, kband).astype(jnp.float32) * (SWA_HEAD_DIM ** -0.5)
    scores = jnp.where(valid[None, :, None, None, None, :], scores, -1e30)
    p = sink_softmax(scores, sinks).astype(vband.dtype)
    o = jnp.einsum('bnkgqs,bnskd->bnqkgd', p, vband).reshape(bsz, L, SWA_HEADS * SWA_HEAD_DIM)
    return o @ wo, k[:, -KV_WIN:], v[:, -KV_WIN:]


def swa_sample(h, cache_k, cache_v, wq, wk, wv, sinks, wo):
    bsz, L, _ = h.shape
    q = (h @ wq).reshape(bsz, L, SWA_KV_HEADS, SWA_GROUPS, SWA_HEAD_DIM)
    k_new = (h @ wk).reshape(bsz, L, SWA_KV_HEADS, SWA_HEAD_DIM)
    v_new = (h @ wv).reshape(bsz, L, SWA_KV_HEADS, SWA_HEAD_DIM)
    k_all = jnp.concatenate([cache_k.astype(k_new.dtype), k_new], axis=1)
    v_all = jnp.concatenate([cache_v.astype(v_new.dtype), v_new], axis=1)
    scores = jnp.einsum('bqkgd,bskd->bkgqs', q, k_all).astype(jnp.float32) * (SWA_HEAD_DIM ** -0.5)
    p = sink_softmax(scores, sinks).astype(v_all.dtype)
    o = jnp.einsum('bkgqs,bskd->bqkgd', p, v_all).reshape(bsz, L, SWA_HEADS * SWA_HEAD_DIM)
    return o @ wo, k_all[:, -KV_WIN:], v_all[:, -KV_WIN:]


def trunk(x, s5_re, s5_im, gdn_s, gdn_conv, kv_k, kv_v, p, is_prompt):
    chunk = CHUNK if is_prompt else x.shape[1]
    n_re, n_im, n_s, n_conv, n_k, n_v = [], [], [], [], [], []
    for layer in range(DEPTH):
        j = layer // 2
        h = rmsnorm(x, p['norm_mix'][layer])
        if layer % 2 == 0:
            mix, x_re, x_im, s_fin, buf = mixer_ab(
                h, s5_re[j], s5_im[j], gdn_s[j], gdn_conv[j], p['w_in'][j],
                p['s5_lam_re'][j], p['s5_lam_im'][j], p['s5_log_dt'][j], p['s5_b_re'][j], p['s5_b_im'][j],
                p['s5_c_re'][j], p['s5_c_im'][j], p['s5_d'][j], p['s5_w_glu'][j], p['s5_b_glu'][j],
                p['gdn_conv_w'][j], p['gdn_a_log'][j], p['gdn_dt_bias'][j], p['gdn_norm_w'][j],
                p['w_out_ab'][j], chunk)
            n_re.append(x_re)
            n_im.append(x_im)
            n_s.append(s_fin)
            n_conv.append(buf)
        else:
            if is_prompt:
                mix, ck, cv = swa_prompt(h, p['swa_wq'][j], p['swa_wk'][j], p['swa_wv'][j],
                                         p['swa_sinks'][j], p['swa_wo'][j])
            else:
                mix, ck, cv = swa_sample(h, kv_k[j], kv_v[j], p['swa_wq'][j], p['swa_wk'][j],
                                         p['swa_wv'][j], p['swa_sinks'][j], p['swa_wo'][j])
            n_k.append(ck)
            n_v.append(cv)
        x = x + mix
        x = x + swiglu(rmsnorm(x, p['norm_ffn'][layer]), p['ffn_w_gate'][layer],
                       p['ffn_w_up'][layer], p['ffn_w_down'][layer])
    y = rmsnorm(x, p['norm_final'])
    return y, jnp.stack(n_re), jnp.stack(n_im), jnp.stack(n_s), jnp.stack(n_conv), jnp.stack(n_k), jnp.stack(n_v)


def setup_inputs(seed: int = 0) -> dict:
    key = jax.random.key(seed)
    ks = iter(jax.random.split(key, 48))
    f32 = jnp.float32

    def nrm(shape, scale):
        return scale * jax.random.normal(next(ks), shape, f32)

    def unif(shape, lo, hi):
        return jax.random.uniform(next(ks), shape, f32, lo, hi)

    x_prompt = nrm((BATCH, SEQ, D_MODEL), 1.0)
    x_sample = nrm((DEC_BATCH, DEC_SEQ, D_MODEL), 1.0)
    state_s5_re = nrm((N_EVEN, DEC_BATCH, S5_GROUPS, S5_P), 0.5)
    state_s5_im = nrm((N_EVEN, DEC_BATCH, S5_GROUPS, S5_P), 0.5)
    state_gdn = nrm((N_EVEN, DEC_BATCH, GDN_HEADS, GDN_DK, GDN_DV), 0.1)
    state_gdn_conv = nrm((N_EVEN, DEC_BATCH, GDN_CONV - 1, GDN_CONV_CH), 1.0)
    cache_swa_k = nrm((N_ODD, DEC_BATCH, KV_WIN, SWA_KV_HEADS, SWA_HEAD_DIM), 1.0)
    cache_swa_v = nrm((N_ODD, DEC_BATCH, KV_WIN, SWA_KV_HEADS, SWA_HEAD_DIM), 1.0)
    norm_mix = 1.0 + nrm((DEPTH, D_MODEL), 0.02)
    norm_ffn = 1.0 + nrm((DEPTH, D_MODEL), 0.02)
    norm_final = 1.0 + nrm((D_MODEL,), 0.02)
    w_in = nrm((N_EVEN, D_MODEL, IN_COLS), D_MODEL ** -0.5)
    n_idx = jnp.arange(S5_P, dtype=f32)
    s5_lam_re = -0.5 + nrm((N_EVEN, S5_GROUPS, S5_P), 0.01)
    s5_lam_im = math.pi * n_idx + nrm((N_EVEN, S5_GROUPS, S5_P), 0.01)
    s5_log_dt = unif((N_EVEN, S5_GROUPS), math.log(1e-3), math.log(1e-1))
    s5_b_re = nrm((N_EVEN, S5_GROUPS, S5_P, S5_GROUP), (2 * S5_GROUP) ** -0.5)
    s5_b_im = nrm((N_EVEN, S5_GROUPS, S5_P, S5_GROUP), (2 * S5_GROUP) ** -0.5)
    s5_c_re = nrm((N_EVEN, S5_GROUPS, S5_GROUP, S5_P), (2 * S5_P) ** -0.5)
    s5_c_im = nrm((N_EVEN, S5_GROUPS, S5_GROUP, S5_P), (2 * S5_P) ** -0.5)
    s5_d = nrm((N_EVEN, S5_WIDTH), 0.5)
    s5_w_glu = nrm((N_EVEN, S5_WIDTH, S5_WIDTH), S5_WIDTH ** -0.5)
    s5_b_glu = nrm((N_EVEN, S5_WIDTH), 0.01)
    gdn_conv_w = nrm((N_EVEN, GDN_CONV, GDN_CONV_CH), GDN_CONV ** -0.5)
    gdn_a_log = jnp.log(unif((N_EVEN, GDN_HEADS), 1.0, 16.0))
    dt0 = jnp.exp(unif((N_EVEN, GDN_HEADS), math.log(1e-3), math.log(1e-1)))
    gdn_dt_bias = dt0 + jnp.log(-jnp.expm1(-dt0))
    gdn_norm_w = 1.0 + nrm((N_EVEN, GDN_DV), 0.02)
    w_out_ab = nrm((N_EVEN, D_MIX_AB, D_MODEL), D_MIX_AB ** -0.5)
    swa_wq = nrm((N_ODD, D_MODEL, SWA_HEADS * SWA_HEAD_DIM), D_MODEL ** -0.5)
    swa_wk = nrm((N_ODD, D_MODEL, SWA_KV_HEADS * SWA_HEAD_DIM), D_MODEL ** -0.5)
    swa_wv = nrm((N_ODD, D_MODEL, SWA_KV_HEADS * SWA_HEAD_DIM), D_MODEL ** -0.5)
    swa_sinks = nrm((N_ODD, SWA_HEADS), 0.5)
    swa_wo = nrm((N_ODD, SWA_HEADS * SWA_HEAD_DIM, D_MODEL), (SWA_HEADS * SWA_HEAD_DIM) ** -0.5)
    ffn_w_gate = nrm((DEPTH, D_MODEL, D_FF), D_MODEL ** -0.5)
    ffn_w_up = nrm((DEPTH, D_MODEL, D_FF), D_MODEL ** -0.5)
    ffn_w_down = nrm((DEPTH, D_FF, D_MODEL), D_FF ** -0.5)
    return {"x_prompt": x_prompt, "x_sample": x_sample,
            "state_s5_re": state_s5_re, "state_s5_im": state_s5_im, "state_gdn": state_gdn,
            "state_gdn_conv": state_gdn_conv, "cache_swa_k": cache_swa_k, "cache_swa_v": cache_swa_v,
            "norm_mix": norm_mix, "norm_ffn": norm_ffn, "norm_final": norm_final, "w_in": w_in,
            "s5_lam_re": s5_lam_re, "s5_lam_im": s5_lam_im, "s5_log_dt": s5_log_dt,
            "s5_b_re": s5_b_re, "s5_b_im": s5_b_im, "s5_c_re": s5_c_re, "s5_c_im": s5_c_im,
            "s5_d": s5_d, "s5_w_glu": s5_w_glu, "s5_b_glu": s5_b_glu,
            "gdn_conv_w": gdn_conv_w, "gdn_a_log": gdn_a_log, "gdn_dt_bias": gdn_dt_bias,
            "gdn_norm_w": gdn_norm_w, "w_out_ab": w_out_ab,
            "swa_wq": swa_wq, "swa_wk": swa_wk, "swa_wv": swa_wv, "swa_sinks": swa_sinks, "swa_wo": swa_wo,
            "ffn_w_gate": ffn_w_gate, "ffn_w_up": ffn_w_up, "ffn_w_down": ffn_w_down}


def reference(x_prompt, x_sample, state_s5_re, state_s5_im, state_gdn, state_gdn_conv, cache_swa_k, cache_swa_v,
              norm_mix, norm_ffn, norm_final, w_in, s5_lam_re, s5_lam_im, s5_log_dt, s5_b_re, s5_b_im,
              s5_c_re, s5_c_im, s5_d, s5_w_glu, s5_b_glu, gdn_conv_w, gdn_a_log, gdn_dt_bias, gdn_norm_w,
              w_out_ab, swa_wq, swa_wk, swa_wv, swa_sinks, swa_wo, ffn_w_gate, ffn_w_up, ffn_w_down):
    p = dict(norm_mix=norm_mix, norm_ffn=norm_ffn, norm_final=norm_final, w_in=w_in,
             s5_lam_re=s5_lam_re, s5_lam_im=s5_lam_im, s5_log_dt=s5_log_dt, s5_b_re=s5_b_re, s5_b_im=s5_b_im,
             s5_c_re=s5_c_re, s5_c_im=s5_c_im, s5_d=s5_d, s5_w_glu=s5_w_glu, s5_b_glu=s5_b_glu,
             gdn_conv_w=gdn_conv_w, gdn_a_log=gdn_a_log, gdn_dt_bias=gdn_dt_bias, gdn_norm_w=gdn_norm_w,
             w_out_ab=w_out_ab, swa_wq=swa_wq, swa_wk=swa_wk, swa_wv=swa_wv, swa_sinks=swa_sinks,
             swa_wo=swa_wo, ffn_w_gate=ffn_w_gate, ffn_w_up=ffn_w_up, ffn_w_down=ffn_w_down)
    bsz = x_prompt.shape[0]
    f32 = jnp.float32
    z_s5 = jnp.zeros((N_EVEN, bsz, S5_GROUPS, S5_P), f32)
    z_gdn = jnp.zeros((N_EVEN, bsz, GDN_HEADS, GDN_DK, GDN_DV), f32)
    z_conv = jnp.zeros((N_EVEN, bsz, GDN_CONV - 1, GDN_CONV_CH), f32)
    y_prompt, p_s5_re, p_s5_im, p_gdn, p_gdn_conv, p_swa_k, p_swa_v = trunk(
        x_prompt, z_s5, z_s5, z_gdn, z_conv, None, None, p, True)
    y_sample, s_s5_re, s_s5_im, s_gdn, s_gdn_conv, s_swa_k, s_swa_v = trunk(
        x_sample, state_s5_re, state_s5_im, state_gdn, state_gdn_conv, cache_swa_k, cache_swa_v, p, False)
    return (y_prompt, y_sample, p_s5_re, p_s5_im, p_gdn, p_gdn_conv, p_swa_k, p_swa_v,
            s_s5_re, s_s5_im, s_gdn, s_gdn_conv, s_swa_k, s_swa_v)
```

```cpp
#include <hip/hip_runtime.h>
#include <hip/hip_cooperative_groups.h>
#include <cstdio>
namespace cg = cooperative_groups;

#define LAS __attribute__((address_space(3)))
typedef unsigned short bf16_t;
typedef short bf16x8 __attribute__((ext_vector_type(8)));
typedef short bf16x4 __attribute__((ext_vector_type(4)));
typedef float f32x4 __attribute__((ext_vector_type(4)));
typedef unsigned u32x4 __attribute__((ext_vector_type(4)));
typedef unsigned u32x2 __attribute__((ext_vector_type(2)));

constexpr int TP = 65536;
constexpr int TS = 256;
constexpr int T = TP + TS;
constexpr int DM = 1024;
constexpr int NCH = 4160;
constexpr int CRG = 4352;
constexpr int CRV = 4112;

constexpr size_t al256(size_t x) { return (x + 255) & ~(size_t)255; }
constexpr size_t WS_W1T = 0;
constexpr size_t WS_WGLU = WS_W1T + (size_t)2816 * 1024 * 2;
constexpr size_t WS_WOUT = WS_WGLU + (size_t)512 * 512 * 2;
constexpr size_t WS_WF1_0 = WS_WOUT + (size_t)1024 * 1024 * 2;
constexpr size_t WS_WFD_0 = WS_WF1_0 + (size_t)5632 * 1024 * 2;
constexpr size_t WS_WQKV = WS_WFD_0 + (size_t)1024 * 2816 * 2;
constexpr size_t WS_WO = WS_WQKV + (size_t)1536 * 1024 * 2;
constexpr size_t WS_WF1_1 = WS_WO + (size_t)1024 * 1024 * 2;
constexpr size_t WS_WFD_1 = WS_WF1_1 + (size_t)5632 * 1024 * 2;
constexpr size_t WS_KGT = WS_WFD_1 + (size_t)1024 * 2816 * 2;
constexpr size_t WS_HT = WS_KGT + (size_t)32 * 256 * 384 * 2;
constexpr size_t WS_LP16 = WS_HT + (size_t)32 * 256 * 256 * 2;
constexpr size_t WS_SUMSQ = WS_LP16 + (size_t)32 * 64 * 2 * 4;
constexpr size_t WS_GATES = WS_SUMSQ + al256((size_t)4 * T * 4);
constexpr size_t WS_GL = WS_GATES + al256((size_t)T * 8 * 4);
constexpr size_t WS_BAR = WS_GL + al256((size_t)NCH * 4);
constexpr size_t WS_R1 = WS_BAR + 256;
constexpr size_t R1_BYTES = (size_t)T * 1024 * 2;
constexpr size_t WS_R2 = WS_R1 + R1_BYTES;
constexpr size_t R2_BYTES = (size_t)T * 1536 * 2;
constexpr size_t WS_R3 = WS_R2 + R2_BYTES;
constexpr size_t GDN_CH_BYTES = 73728;
constexpr size_t GDN_BYTES = (size_t)NCH * GDN_CH_BYTES;
constexpr size_t R3_BYTES = GDN_BYTES + (size_t)T * 512 * 2;
constexpr size_t WS_R4 = WS_R3 + R3_BYTES;
constexpr size_t R4_BYTES = (size_t)T * 1024 * 2;
constexpr size_t WS_R5 = WS_R4 + R4_BYTES;
constexpr size_t R5_BYTES = (size_t)32 * CRG * 384 * 2;
constexpr size_t WS_END = WS_R5 + R5_BYTES;
static_assert(R3_BYTES >= (size_t)T * 2816 * 2, "ACT fits R3");
static_assert((size_t)32 * CRG * 128 * 4 <= R1_BYTES, "SS fits R1");
static_assert((size_t)T * 512 * 2 <= R5_BYTES, "K|V fit R5");
static_assert(WS_END <= (size_t)1073741824, "workspace");

constexpr size_t O_Y = 0;
constexpr size_t O_PS5RE = 67371008, O_PS5IM = 67387392, O_PGDN = 67403776, O_PCONV = 67928064, O_PK = 67964928, O_PV = 68227072;
constexpr size_t O_SS5RE = 68489216, O_SS5IM = 68521984, O_SGDN = 68554752, O_SCONV = 69603328, O_SK = 69677056, O_SV = 70201344;

constexpr int LDS_BYTES = 131072;
#ifndef CG_SEAMS
#define CG_SEAMS 0
#endif
#ifndef REP_MASK
#define REP_MASK 0
#endif
#ifndef PH_HI
#define PH_HI 15
#endif

struct Params { const float* in[35]; float* out; unsigned char* ws; int ph_lo, ph_hi; };
typedef const __attribute__((address_space(4))) Params& KPR;
typedef const __attribute__((address_space(4))) Params* KPP;
__device__ __forceinline__ int ltid() { int t = threadIdx.x; asm volatile("" : "+v"(t)); return t; }
__device__ __forceinline__ KPP launder_kp() { KPP q = (KPP)__builtin_amdgcn_kernarg_segment_ptr(); asm volatile("" : "+s"(q)); return q; }

typedef float f32x2v __attribute__((ext_vector_type(2)));
typedef __bf16 bf16x2v __attribute__((ext_vector_type(2)));
__device__ __forceinline__ unsigned cvt_pk_bf16(float lo, float hi) { const f32x2v v = {lo, hi}; const bf16x2v b = __builtin_convertvector(v, bf16x2v); return __builtin_bit_cast(unsigned, b); }
__device__ __forceinline__ bf16_t f2bf(float f) { return (bf16_t)(cvt_pk_bf16(f, 0.f) & 0xffffu); }
__device__ __forceinline__ float bf2f(bf16_t b) { return __uint_as_float(((unsigned)b) << 16); }
__device__ __forceinline__ float bflo(unsigned w) { return __uint_as_float(w << 16); }
__device__ __forceinline__ float bfhi(unsigned w) { return __uint_as_float(w & 0xffff0000u); }
__device__ __forceinline__ float silu_f(float x) { return x / (1.0f + __expf(-x)); }
__device__ __forceinline__ float sigmoid_f(float x) { return 1.0f / (1.0f + __expf(-x)); }
__device__ __forceinline__ float gelu_tanh_f(float x) { const float u = 1.5957691216057308f * (x + 0.044715f * x * x * x); return x / (1.0f + __expf(-u)); }
#define LDS_BARRIER() do { asm volatile("s_waitcnt lgkmcnt(0)" ::: "memory"); __builtin_amdgcn_s_barrier(); asm volatile("" ::: "memory"); } while (0)

namespace pg8 {
constexpr int BM = 256, BK = 64, HALF = 128, HTB = HALF * BK * 2, STAGE_BYTES = 8 * HTB, NXCD = 8, WGM = 8;
__device__ __forceinline__ int lds_byte(int r, int c) { const int st = (r >> 4) * 2 + (c >> 5), rr = r & 15, cc = c & 31, ob = rr * 64 + cc * 2; return st * 1024 + (ob ^ (((ob >> 9) & 1) << 5)); }
__device__ __forceinline__ void stage_rc(int b, int& R, int& C) { const int st = b / 1024, sb = b % 1024, swz = sb ^ (((sb >> 9) & 1) << 5); R = (st >> 1) * 16 + swz / 64; C = (st & 1) * 32 + (swz % 64) / 2; }
__device__ __forceinline__ int perm32(int rho) { const int n = rho >> 4, i = rho & 15; return 8 * (i >> 2) + 4 * n + (i & 3); }
struct Unit { int pm, pn; };
struct Gemm { const bf16_t* A; const bf16_t* Bt; int lda, ldb, K; };
struct StaticOrder {
    int nM, nN, nwg, G, c;
    __device__ void init(int M, int N, int G_, int c_) { nM = M / BM; nN = N / BM; nwg = nM * nN; G = G_; c = c_; }
    __device__ bool next(int i, Unit& u) const {
        const long L = (long)i * G + c; if (L >= nwg) return false;
        int wgid = (int)L; { const int q = nwg / NXCD, r = nwg % NXCD, xcd = wgid % NXCD, off = wgid / NXCD; wgid = (xcd < r ? xcd * (q + 1) : r * (q + 1) + (xcd - r) * q) + off; }
        const int nig = WGM * nN, gid = wgid / nig, fm = gid * WGM, gsz = (nM - fm) < WGM ? (nM - fm) : WGM;
        u.pm = fm + ((wgid % nig) % gsz); u.pn = (wgid % nig) / gsz; return true;
    }
};
struct GroupOrder {
    int G, c;
    __device__ bool next(int i, Unit& u) const { const int L = i * G + c; if (L >= 32 * 17) return false; u.pm = L; u.pn = L / 17; return true; }
};

template <class Epi, class Sched>
__device__ __forceinline__ void gemm_phase(LAS unsigned char* lds, const Gemm g, const Sched& S, const Epi& E) {
    const int tid = ltid(), wid = __builtin_amdgcn_readfirstlane(tid >> 6), lane = tid & 63, wr = wid >> 2, wc = wid & 3, fr = lane & 15, fq = lane >> 4;
    const int K = g.K, nt = K / BK;
    unsigned voffA[2], voffB[2];
#pragma unroll
    for (int i = 0; i < 2; ++i) { int R, C; stage_rc(tid * 16 + i * 8192, R, C); const int Rb = Epi::PERM ? ((R & ~31) + perm32(R & 31)) : R;
        voffA[i] = (unsigned)(R * g.lda + C) * 2u; voffB[i] = (unsigned)(Rb * g.ldb + C) * 2u; }
    const size_t kstep = (size_t)(BK * 2);
    const size_t hstepA = (size_t)HALF * g.lda * 2, hstepB = (size_t)HALF * g.ldb * 2;
    const size_t tstepA = 2 * hstepA, tstepB = 2 * hstepB;
    const unsigned ldsw = (unsigned)wid * 1024u;
    const int aoff = lds_byte(wr * 64 + fr, fq * 8), boff = lds_byte(wc * 32 + fr, fq * 8);
#define PG8_SA(b, h) (((b) * 2 + (h)) * HTB)
#define PG8_SB(b, h) ((4 + (b) * 2 + (h)) * HTB)
#define PG8_STAGE(bufoff, gbase, voff) do { _Pragma("unroll") for (int _i = 0; _i < 2; ++_i) \
        __builtin_amdgcn_global_load_lds((const unsigned*)((const char*)(gbase) + (voff)[_i]), (LAS unsigned*)(lds + (bufoff) + ldsw + _i * 8192), 16, 0, 0); } while (0)
#define PG8_LDA(dst, b, h) do { _Pragma("unroll") for (int m = 0; m < 4; ++m) _Pragma("unroll") for (int k = 0; k < 2; ++k) dst[m][k] = *(const LAS bf16x8*)(lds + PG8_SA(b, h) + aoff + m * 2048 + k * 1024); } while (0)
#define PG8_LDB(dst, b, h) do { _Pragma("unroll") for (int n = 0; n < 2; ++n) _Pragma("unroll") for (int k = 0; k < 2; ++k) dst[n][k] = *(const LAS bf16x8*)(lds + PG8_SB(b, h) + boff + n * 2048 + k * 1024); } while (0)
#define PG8_MMA(ai, bj, At, Bt) do { __builtin_amdgcn_s_setprio(1); _Pragma("unroll") for (int m = 0; m < 4; ++m) _Pragma("unroll") for (int n = 0; n < 2; ++n) _Pragma("unroll") for (int k = 0; k < 2; ++k) \
        acc[ai][bj][m][n] = __builtin_amdgcn_mfma_f32_16x16x32_bf16(Bt[n][k], At[m][k], acc[ai][bj][m][n], 0, 0, 0); __builtin_amdgcn_s_setprio(0); } while (0)
#define PG8_WAIT_V(n) asm volatile("s_waitcnt vmcnt(" #n ")" ::: "memory")
#define PG8_WAIT_L(n) asm volatile("s_waitcnt lgkmcnt(" #n ")" ::: "memory")
#define PG8_BAR __builtin_amdgcn_s_barrier()
#define PG8_SCHED __builtin_amdgcn_sched_barrier(0)
    Unit cur, nxt; int ui = 0;
    if (!S.next(0, cur)) return;
    f32x4 acc[2][2][4][2];
#pragma unroll
    for (int a = 0; a < 2; ++a)
#pragma unroll
        for (int b = 0; b < 2; ++b)
#pragma unroll
            for (int m = 0; m < 4; ++m)
#pragma unroll
                for (int n = 0; n < 2; ++n) acc[a][b][m][n] = (f32x4){0.f, 0.f, 0.f, 0.f};
    bf16x8 At[4][2], B0[2][2], B1[2][2];
    const char* cA = (const char*)g.A + (size_t)cur.pm * tstepA; const char* cB = (const char*)g.Bt + (size_t)cur.pn * tstepB;
    PG8_STAGE(PG8_SB(0, 0), cB, voffB); PG8_STAGE(PG8_SA(0, 0), cA, voffA); PG8_STAGE(PG8_SB(0, 1), cB + hstepB, voffB); PG8_STAGE(PG8_SA(0, 1), cA + hstepA, voffA);
    if (wr == 1) PG8_BAR;
    PG8_WAIT_V(4); PG8_BAR;
    PG8_STAGE(PG8_SB(1, 0), cB + kstep, voffB); PG8_STAGE(PG8_SA(1, 0), cA + kstep, voffA); PG8_STAGE(PG8_SB(1, 1), cB + hstepB + kstep, voffB);
    PG8_WAIT_V(6); PG8_BAR;
    for (;;) {
        const bool has_next = S.next(ui + 1, nxt);
        const char* nA = has_next ? (const char*)g.A + (size_t)nxt.pm * tstepA : cA; const char* nB = has_next ? (const char*)g.Bt + (size_t)nxt.pn * tstepB : cB;
        for (int t = 0; t < nt; t += 2) {
            const bool last = (t == nt - 2);
            const char* a1 = cA + (size_t)(t + 1) * kstep;
            const char* a2 = last ? nA : cA + (size_t)(t + 2) * kstep; const char* b2 = last ? nB : cB + (size_t)(t + 2) * kstep;
            const char* a3 = a2 + kstep; const char* b3 = b2 + kstep;
            PG8_LDB(B0, 0, 0); PG8_SCHED; PG8_LDA(At, 0, 0); PG8_STAGE(PG8_SA(1, 1), a1 + hstepA, voffA);
            PG8_WAIT_L(8); PG8_BAR; PG8_WAIT_L(0); PG8_MMA(0, 0, At, B0); PG8_BAR; PG8_SCHED;
            PG8_LDB(B1, 0, 1); PG8_STAGE(PG8_SB(0, 0), b2, voffB);
            PG8_BAR; PG8_WAIT_L(0); PG8_MMA(0, 1, At, B1); PG8_BAR;
            PG8_LDA(At, 0, 1); PG8_STAGE(PG8_SA(0, 0), a2, voffA);
            PG8_BAR; PG8_WAIT_L(0); PG8_MMA(1, 0, At, B0); PG8_BAR; PG8_SCHED;
            PG8_STAGE(PG8_SB(0, 1), b2 + hstepB, voffB);
            PG8_WAIT_V(6); PG8_BAR; PG8_MMA(1, 1, At, B1); PG8_BAR;
            PG8_LDB(B0, 1, 0); PG8_SCHED; PG8_LDA(At, 1, 0); PG8_STAGE(PG8_SA(0, 1), a2 + hstepA, voffA);
            PG8_WAIT_L(8); PG8_BAR; PG8_WAIT_L(0); PG8_MMA(0, 0, At, B0); PG8_BAR; PG8_SCHED;
            PG8_LDB(B1, 1, 1); PG8_STAGE(PG8_SB(1, 0), b3, voffB);
            PG8_BAR; PG8_WAIT_L(0); PG8_MMA(0, 1, At, B1); PG8_BAR;
            PG8_LDA(At, 1, 1); PG8_STAGE(PG8_SA(1, 0), a3, voffA);
            PG8_BAR; PG8_WAIT_L(0); PG8_MMA(1, 0, At, B0); PG8_BAR; PG8_SCHED;
            PG8_STAGE(PG8_SB(1, 1), b3 + hstepB, voffB);
            PG8_WAIT_V(6); PG8_BAR; PG8_MMA(1, 1, At, B1); PG8_BAR;
        }
        { int frE = fr, fqE = fq; asm volatile("" : "+v"(frE), "+v"(fqE)); E(acc, cur, wr, wc, frE, fqE); }
        if (!has_next) break;
#pragma unroll
        for (int a = 0; a < 2; ++a)
#pragma unroll
            for (int b = 0; b < 2; ++b)
#pragma unroll
                for (int m = 0; m < 4; ++m)
#pragma unroll
                    for (int n = 0; n < 2; ++n) acc[a][b][m][n] = (f32x4){0.f, 0.f, 0.f, 0.f};
        cur = nxt; cA = nA; cB = nB; ++ui;
    }
    PG8_WAIT_V(0);
    if (wr == 0) PG8_BAR;
    PG8_BAR;
#undef PG8_SA
#undef PG8_SB
#undef PG8_STAGE
#undef PG8_LDA
#undef PG8_LDB
#undef PG8_MMA
#undef PG8_WAIT_V
#undef PG8_WAIT_L
#undef PG8_BAR
#undef PG8_SCHED
}
}
using pg8::Unit;

__device__ __forceinline__ u32x4 pack8(const f32x4 a, const f32x4 b) { u32x4 w; w.x = cvt_pk_bf16(a[0], a[1]); w.y = cvt_pk_bf16(a[2], a[3]); w.z = cvt_pk_bf16(b[0], b[1]); w.w = cvt_pk_bf16(b[2], b[3]); return w; }
__device__ __forceinline__ void unpack8(const u32x4 w, f32x4& a, f32x4& b) { a = (f32x4){bflo(w.x), bfhi(w.x), bflo(w.y), bfhi(w.y)}; b = (f32x4){bflo(w.z), bfhi(w.z), bflo(w.w), bfhi(w.w)}; }

struct Epi1 {
    static constexpr bool PERM = true;
    bf16_t* ucat; bf16_t* qkvraw; bf16_t* zg; float* gates;
    __device__ __forceinline__ void operator()(const f32x4 (&acc)[2][2][4][2], const Unit& u, int wr, int wc, int fr, int fq) const {
        const int row0 = u.pm * 256 + wr * 64 + fr, pn = u.pn;
#pragma unroll
        for (int ai = 0; ai < 2; ++ai)
#pragma unroll
            for (int m = 0; m < 4; ++m) { const int r = row0 + ai * 128 + m * 16;
#pragma unroll
                for (int bj = 0; bj < 2; ++bj) { const int c0 = pn * 256 + bj * 128 + wc * 32 + 8 * fq;
                    if (pn == 10) { if (bj == 0 && wc == 0 && fq == 0) { *(f32x4*)(gates + (size_t)r * 8) = acc[ai][bj][m][0]; *(f32x4*)(gates + (size_t)r * 8 + 4) = acc[ai][bj][m][1]; } }
                    else { const u32x4 w = pack8(acc[ai][bj][m][0], acc[ai][bj][m][1]); bf16_t* dst;
                        if (pn < 2) dst = ucat + ((size_t)((c0 >> 4) * CRG + (r >> 4)) * 384 + (r & 15) * 16 + (c0 & 15));
                        else if (pn < 8) dst = qkvraw + (size_t)r * 1536 + (c0 - 512);
                        else dst = zg + (size_t)r * 512 + (c0 - 2048);
                        *(u32x4*)dst = w; } } }
    }
};
struct EpiS {
    static constexpr bool PERM = false;
    float* ss;
    __device__ __forceinline__ void operator()(const f32x4 (&acc)[2][2][4][2], const Unit& u, int wr, int wc, int fr, int fq) const {
        const int row0 = u.pm * 256 + wr * 64 + fr, col0 = wc * 32 + 4 * fq;
#pragma unroll
        for (int ai = 0; ai < 2; ++ai)
#pragma unroll
            for (int m = 0; m < 4; ++m) { float* rp = ss + (size_t)(row0 + ai * 128 + m * 16) * 128 + col0;
#pragma unroll
                for (int n = 0; n < 2; ++n) *(f32x4*)(rp + n * 16) = acc[ai][0][m][n]; }
    }
};
struct EpiY {
    static constexpr bool PERM = true;
    const bf16_t* ucat; const float* dvec; bf16_t* zs5;
    __device__ __forceinline__ void operator()(const f32x4 (&acc)[2][2][4][2], const Unit& u, int wr, int wc, int fr, int fq) const {
        const int g = u.pn, crow0 = u.pm * 256 + wr * 64 + fr;
#pragma unroll
        for (int ai = 0; ai < 2; ++ai)
#pragma unroll
            for (int m = 0; m < 4; ++m) { const int crow = crow0 + ai * 128 + m * 16, cr = crow - g * CRG;
                if (cr < CRV) {
#pragma unroll
                    for (int bj = 0; bj < 2; ++bj) { const int n0 = bj * 128 + wc * 32 + 8 * fq, tl = n0 >> 4, cp = n0 & 15;
                        const f32x4 d0 = *(const f32x4*)(dvec + g * 16 + cp), d1 = *(const f32x4*)(dvec + g * 16 + cp + 4);
                        const u32x4 uw = *(const u32x4*)(ucat + (size_t)crow * 384 + n0); f32x4 u0, u1; unpack8(uw, u0, u1);
                        f32x4 y0 = acc[ai][bj][m][0] + d0 * u0, y1 = acc[ai][bj][m][1] + d1 * u1;
#pragma unroll
                        for (int j = 0; j < 4; ++j) { y0[j] = gelu_tanh_f(y0[j]); y1[j] = gelu_tanh_f(y1[j]); }
                        *(u32x4*)(zs5 + (size_t)(cr * 16 + tl) * 512 + g * 16 + cp) = pack8(y0, y1); } }
                asm volatile("" ::: "memory"); }
    }
};
struct EpiGlu {
    static constexpr bool PERM = true;
    const bf16_t* zs5; const float* bglu; bf16_t* mixin;
    __device__ __forceinline__ void operator()(const f32x4 (&acc)[2][2][4][2], const Unit& u, int wr, int wc, int fr, int fq) const {
        const int row0 = u.pm * 256 + wr * 64 + fr;
#pragma unroll
        for (int bj = 0; bj < 2; ++bj) { const int c0 = u.pn * 256 + bj * 128 + wc * 32 + 8 * fq;
            const f32x4 b0 = *(const f32x4*)(bglu + c0), b1 = *(const f32x4*)(bglu + c0 + 4);
#pragma unroll
            for (int ai = 0; ai < 2; ++ai)
#pragma unroll
                for (int m = 0; m < 4; ++m) { const int r = row0 + ai * 128 + m * 16;
                    const u32x4 zw = *(const u32x4*)(zs5 + (size_t)r * 512 + c0); f32x4 z0, z1; unpack8(zw, z0, z1);
                    f32x4 o0, o1;
#pragma unroll
                    for (int j = 0; j < 4; ++j) { o0[j] = z0[j] * sigmoid_f(acc[ai][bj][m][0][j] + b0[j]); o1[j] = z1[j] * sigmoid_f(acc[ai][bj][m][1][j] + b1[j]); }
                    *(u32x4*)(mixin + (size_t)r * 1024 + c0) = pack8(o0, o1); } }
    }
};
struct EpiRes {
    static constexpr bool PERM = false;
    const float* base_p; const float* base_s; float* out; bf16_t* xb; float* sumsq;
    __device__ __forceinline__ void operator()(const f32x4 (&acc)[2][2][4][2], const Unit& u, int wr, int wc, int fr, int fq) const {
        const int row0 = u.pm * 256 + wr * 64 + fr, col0 = u.pn * 256 + wc * 32 + 4 * fq;
#pragma unroll
        for (int ai = 0; ai < 2; ++ai)
#pragma unroll
            for (int m = 0; m < 4; ++m) { const int r = row0 + ai * 128 + m * 16;
                const float* bp = (r < TP) ? base_p + (size_t)r * 1024 : base_s + (size_t)(r - TP) * 1024; float s = 0.f;
#pragma unroll
                for (int bj = 0; bj < 2; ++bj)
#pragma unroll
                    for (int n = 0; n < 2; ++n) { const int c = col0 + bj * 128 + n * 16; const f32x4 v = *(const f32x4*)(bp + c) + acc[ai][bj][m][n];
                        *(f32x4*)(out + (size_t)r * 1024 + c) = v;
                        if (xb) { u32x2 w; w.x = cvt_pk_bf16(v[0], v[1]); w.y = cvt_pk_bf16(v[2], v[3]); *(u32x2*)(xb + (size_t)r * 1024 + c) = w; }
                        s += (v[0] * v[0] + v[1] * v[1]) + (v[2] * v[2] + v[3] * v[3]); }
                s += __shfl_xor(s, 16); s += __shfl_xor(s, 32);
                if (fq == 0) atomicAdd(sumsq + r, s);
                asm volatile("" ::: "memory"); }
    }
};
struct EpiFF {
    static constexpr bool PERM = true;
    const float* sumsq; bf16_t* act;
    __device__ __forceinline__ void operator()(const f32x4 (&acc)[2][2][4][2], const Unit& u, int wr, int wc, int fr, int fq) const {
        const int row0 = u.pm * 256 + wr * 64 + fr, c0 = u.pn * 128 + wc * 32 + 8 * fq;
#pragma unroll
        for (int ai = 0; ai < 2; ++ai)
#pragma unroll
            for (int m = 0; m < 4; ++m) { const int r = row0 + ai * 128 + m * 16; const float rs = rsqrtf(sumsq[r] * (1.0f / 1024.0f) + 1e-6f);
                f32x4 o0, o1;
#pragma unroll
                for (int j = 0; j < 4; ++j) { o0[j] = silu_f(acc[ai][0][m][0][j] * rs) * (acc[ai][1][m][0][j] * rs); o1[j] = silu_f(acc[ai][0][m][1][j] * rs) * (acc[ai][1][m][1][j] * rs); }
                *(u32x4*)(act + (size_t)r * 2816 + c0) = pack8(o0, o1); }
    }
};
struct EpiQKV {
    static constexpr bool PERM = true;
    const float* sumsq; bf16_t* q; bf16_t* kb; bf16_t* vb; float* opk; float* opv; float* osk; float* osv;
    __device__ __forceinline__ void operator()(const f32x4 (&acc)[2][2][4][2], const Unit& u, int wr, int wc, int fr, int fq) const {
        const int row0 = u.pm * 256 + wr * 64 + fr, pn = u.pn;
#pragma unroll
        for (int ai = 0; ai < 2; ++ai)
#pragma unroll
            for (int m = 0; m < 4; ++m) { const int r = row0 + ai * 128 + m * 16; const float rs = rsqrtf(sumsq[r] * (1.0f / 1024.0f) + 1e-6f);
#pragma unroll
                for (int bj = 0; bj < 2; ++bj) { const int cl = bj * 128 + wc * 32 + 8 * fq;
                    if (pn < 4) { const float sc = rs * 0.125f; *(u32x4*)(q + (size_t)r * 1024 + pn * 256 + cl) = pack8(acc[ai][bj][m][0] * sc, acc[ai][bj][m][1] * sc); }
                    else { const f32x4 v0 = acc[ai][bj][m][0] * rs, v1 = acc[ai][bj][m][1] * rs;
                        bf16_t* dst = (pn == 4 ? kb : vb) + (size_t)r * 256 + cl; *(u32x4*)dst = pack8(v0, v1);
                        float* od = nullptr;
                        if (r < TP) { const int t = r & 8191; if (t >= 8064) od = (pn == 4 ? opk : opv) + ((size_t)((r >> 13) * 128 + (t - 8064)) * 256 + cl); }
                        else { const int rr = r - TP; od = (pn == 4 ? osk : osv) + ((size_t)((rr >> 4) * 128 + 112 + (rr & 15)) * 256 + cl); }
                        if (od) { *(f32x4*)od = v0; *(f32x4*)(od + 4) = v1; } } } }
    }
};

struct WDesc { const float* src; int ld, K, N, rowoff, mode; bf16_t* dst; const float* fold; };
__device__ __forceinline__ void wt_tile(const WDesc& d, int tile, LAS float* tl) {
    const int ntn = (d.N + 63) >> 6, kt = tile / ntn, ntile = tile - kt * ntn, k0 = kt * 64, n0 = ntile * 64, tid = ltid();
#pragma unroll
    for (int ps = 0; ps < 8; ++ps) { const int k = ps * 8 + (tid >> 6), n = tid & 63; float v = 0.f;
        if (n0 + n < d.N) v = d.src[(size_t)(k0 + k) * d.ld + n0 + n];
        if (d.fold) v *= d.fold[k0 + k];
        tl[k * 65 + n] = v; }
    __syncthreads();
#pragma unroll
    for (int ps = 0; ps < 8; ++ps) { const int n = ps * 8 + (tid >> 6), k = tid & 63, gn = n0 + n;
        if (gn < d.N) { const int drow = (d.mode ? ((gn >> 7) * 256 + (gn & 127)) : gn) + d.rowoff; d.dst[(size_t)drow * d.K + k0 + k] = f2bf(tl[k * 65 + n]); } }
    __syncthreads();
}

__device__ __forceinline__ void s5_gen_group(KPR p, int g, LAS unsigned char* lds) {
    LAS float* LP = (LAS float*)lds;
    LAS float* BB = LP + 17 * 64 * 2;
    LAS float* KL = BB + 64 * 16 * 2;
    LAS float* CF = KL + 4096;
    const int tid = ltid();
    const float* lam_re = p.in[12]; const float* lam_im = p.in[13]; const float* log_dt = p.in[14];
    const float* b_re = p.in[15]; const float* b_im = p.in[16]; const float* c_re = p.in[17]; const float* c_im = p.in[18];
    bf16_t* kgt = (bf16_t*)(p.ws + WS_KGT) + (size_t)g * 256 * 384; bf16_t* ht = (bf16_t*)(p.ws + WS_HT) + (size_t)g * 256 * 256; float* lp16 = (float*)(p.ws + WS_LP16) + g * 128;
    if (tid < 64) { const int pp = tid; const double dt = exp((double)log_dt[g]); const double lr = (double)lam_re[g * 64 + pp], li = (double)lam_im[g * 64 + pp];
        for (int k = 0; k <= 16; ++k) { const double mg = exp(k * lr * dt), an = k * li * dt; const double cr = mg * cos(an), ci = mg * sin(an);
            LP[(k * 64 + pp) * 2] = (float)cr; LP[(k * 64 + pp) * 2 + 1] = (float)ci;
            if (k == 16) { lp16[pp * 2] = (float)cr; lp16[pp * 2 + 1] = (float)ci; }
            if (k == 1) { const double nr = cr - 1.0, ni = ci, dn = lr * lr + li * li; CF[pp * 2] = (float)((nr * lr + ni * li) / dn); CF[pp * 2 + 1] = (float)((ni * lr - nr * li) / dn); } } }
    __syncthreads();
    for (int e = tid; e < 1024; e += 512) { const int pp = e >> 4; const float br = b_re[(size_t)g * 1024 + e], bi = b_im[(size_t)g * 1024 + e], fr_ = CF[pp * 2], fi_ = CF[pp * 2 + 1];
        BB[e * 2] = fr_ * br - fi_ * bi; BB[e * 2 + 1] = fr_ * bi + fi_ * br; }
    __syncthreads();
    for (int e = tid; e < 4096; e += 512) { const int k = e >> 8, c = (e >> 4) & 15, cp = e & 15; float s = 0.f;
        for (int pp = 0; pp < 64; ++pp) { const float cr = c_re[(size_t)g * 1024 + c * 64 + pp], ci = c_im[(size_t)g * 1024 + c * 64 + pp];
            const float lr = LP[(k * 64 + pp) * 2], li = LP[(k * 64 + pp) * 2 + 1], br = BB[(pp * 16 + cp) * 2], bi = BB[(pp * 16 + cp) * 2 + 1];
            const float mr = lr * br - li * bi, mi = lr * bi + li * br; s += cr * mr - ci * mi; }
        KL[e] = s; }
    __syncthreads();
    for (int e = tid; e < 256 * 384; e += 512) { const int n = e / 384, k = e - n * 384, t = n >> 4, c = n & 15; float v;
        if (k < 256) { const int s = k >> 4, cp = k & 15; v = (s <= t) ? KL[((t - s) * 16 + c) * 16 + cp] : 0.f; }
        else { const int pp = (k - 256) & 63; const float cr = c_re[(size_t)g * 1024 + c * 64 + pp], ci = c_im[(size_t)g * 1024 + c * 64 + pp];
            const float lr = LP[((t + 1) * 64 + pp) * 2], li = LP[((t + 1) * 64 + pp) * 2 + 1];
            v = (k < 320) ? (cr * lr - ci * li) : -(cr * li + ci * lr); }
        kgt[e] = f2bf(v); }
    for (int e = tid; e < 256 * 256; e += 512) { const int n = e >> 8, k = e & 255; float v = 0.f;
        if (n < 128) { const int pp = n & 63, s = k >> 4, cp = k & 15; const float lr = LP[((15 - s) * 64 + pp) * 2], li = LP[((15 - s) * 64 + pp) * 2 + 1], br = BB[(pp * 16 + cp) * 2], bi = BB[(pp * 16 + cp) * 2 + 1];
            v = (n < 64) ? (lr * br - li * bi) : (lr * bi + li * br); }
        ht[e] = f2bf(v); }
    __syncthreads();
}

__device__ __forceinline__ void phase0(KPR p, LAS unsigned char* lds) {
    const int tid = ltid(), G = gridDim.x, bx = blockIdx.x, lane = tid & 63, wid = tid >> 6;
    for (int g = bx; g < 32; g += G) s5_gen_group(p, g, lds);
    {
        const float* nf = p.in[9]; const float* nm = p.in[8];
        const int shift = (bx + G - (32 % G)) % G;
        for (int it = shift; it < 5840; it += G) {
            int t = it; WDesc d;
            if (t < 656) d = WDesc{p.in[11], 2568, 1024, 2568, 0, 0, (bf16_t*)(p.ws + WS_W1T), nullptr};
            else if ((t -= 656) < 64) d = WDesc{p.in[20], 512, 512, 512, 0, 0, (bf16_t*)(p.ws + WS_WGLU), nullptr};
            else if ((t -= 64) < 256) d = WDesc{p.in[26], 1024, 1024, 1024, 0, 0, (bf16_t*)(p.ws + WS_WOUT), nullptr};
            else if ((t -= 256) < 704) d = WDesc{p.in[32], 2816, 1024, 2816, 0, 1, (bf16_t*)(p.ws + WS_WF1_0), nf};
            else if ((t -= 704) < 704) d = WDesc{p.in[33], 2816, 1024, 2816, 128, 1, (bf16_t*)(p.ws + WS_WF1_0), nf};
            else if ((t -= 704) < 704) d = WDesc{p.in[34], 1024, 2816, 1024, 0, 0, (bf16_t*)(p.ws + WS_WFD_0), nullptr};
            else if ((t -= 704) < 256) d = WDesc{p.in[27], 1024, 1024, 1024, 0, 0, (bf16_t*)(p.ws + WS_WQKV), nm + 1024};
            else if ((t -= 256) < 64) d = WDesc{p.in[28], 256, 1024, 256, 1024, 0, (bf16_t*)(p.ws + WS_WQKV), nm + 1024};
            else if ((t -= 64) < 64) d = WDesc{p.in[29], 256, 1024, 256, 1280, 0, (bf16_t*)(p.ws + WS_WQKV), nm + 1024};
            else if ((t -= 64) < 256) d = WDesc{p.in[31], 1024, 1024, 1024, 0, 0, (bf16_t*)(p.ws + WS_WO), nullptr};
            else if ((t -= 256) < 704) d = WDesc{p.in[32] + (size_t)1024 * 2816, 2816, 1024, 2816, 0, 1, (bf16_t*)(p.ws + WS_WF1_1), nf + 1024};
            else if ((t -= 704) < 704) d = WDesc{p.in[33] + (size_t)1024 * 2816, 2816, 1024, 2816, 128, 1, (bf16_t*)(p.ws + WS_WF1_1), nf + 1024};
            else { t -= 704; d = WDesc{p.in[34] + (size_t)2816 * 1024, 1024, 2816, 1024, 0, 0, (bf16_t*)(p.ws + WS_WFD_1), nullptr}; }
            wt_tile(d, t, (LAS float*)lds);
        }
    }
    {
        bf16_t* h0 = (bf16_t*)(p.ws + WS_R1); const float* nw = p.in[8];
        f32x4 wv[4];
#pragma unroll
        for (int i = 0; i < 4; ++i) wv[i] = *(const f32x4*)(nw + lane * 4 + i * 256);
        for (int r = bx * 8 + wid; r < T; r += G * 8) {
            const float* xp = (r < TP) ? p.in[0] + (size_t)r * 1024 : p.in[1] + (size_t)(r - TP) * 1024;
            f32x4 v[4]; float s = 0.f;
#pragma unroll
            for (int i = 0; i < 4; ++i) { v[i] = *(const f32x4*)(xp + lane * 4 + i * 256); s += (v[i][0] * v[i][0] + v[i][1] * v[i][1]) + (v[i][2] * v[i][2] + v[i][3] * v[i][3]); }
#pragma unroll
            for (int o = 32; o >= 1; o >>= 1) s += __shfl_xor(s, o);
            const float rs = rsqrtf(s * (1.0f / 1024.0f) + 1e-6f);
#pragma unroll
            for (int i = 0; i < 4; ++i) { const f32x4 y = v[i] * rs * wv[i]; u32x2 w; w.x = cvt_pk_bf16(y[0], y[1]); w.y = cvt_pk_bf16(y[2], y[3]); *(u32x2*)(h0 + (size_t)r * 1024 + lane * 4 + i * 256) = w; }
        }
    }
    {
        const size_t gt = (size_t)bx * 512 + tid, gs = (size_t)G * 512;
        float* sq = (float*)(p.ws + WS_SUMSQ); for (size_t i = gt; i < (size_t)4 * T; i += gs) sq[i] = 0.f;
        unsigned* wpad = (unsigned*)(p.ws + WS_W1T + (size_t)2568 * 1024 * 2); for (size_t i = gt; i < (size_t)248 * 512; i += gs) wpad[i] = 0u;
        const float* ck = p.in[6]; const float* cv = p.in[7]; float* ok = p.out + O_SK; float* ov = p.out + O_SV;
        for (size_t i = gt; i < (size_t)16 * 112 * 256; i += gs) { const size_t b = i / (112 * 256), rem = i - b * (112 * 256); ok[b * 32768 + rem] = ck[b * 32768 + 4096 + rem]; ov[b * 32768 + rem] = cv[b * 32768 + 4096 + rem]; }
    }
}

__device__ __forceinline__ void gdn_prep_item(KPR p, int ch, LAS unsigned char* lds) {
    const int tid = ltid(), lane = tid & 63, w = tid >> 6, fr = lane & 15, fq = lane >> 4;
    const bool samp = ch >= 4096; int b, h, n; int rowbase;
    if (!samp) { b = ch >> 9; h = (ch >> 7) & 3; n = ch & 127; rowbase = b * 8192 + n * 64; } else { const int s = ch - 4096; b = s >> 2; h = s & 3; n = 0; rowbase = TP + b * 16; }
    const int ntok = samp ? 16 : 64;
    LAS bf16_t* qn = (LAS bf16_t*)lds; LAS bf16_t* kn = qn + 64 * 136; LAS bf16_t* vv = kn + 64 * 136;
    LAS float* Am = (LAS float*)(lds + 3 * 17408); LAS float* gcs = Am + 4096; LAS float* betas = gcs + 64; LAS float* egc = betas + 64;
    const bf16_t* qkvraw = (const bf16_t*)(p.ws + WS_R2); const float* gates = (const float*)(p.ws + WS_GATES);
    unsigned char* cb = p.ws + WS_R3 + (size_t)ch * GDN_CH_BYTES;
    bf16_t* o_uT = (bf16_t*)cb; bf16_t* o_w = (bf16_t*)(cb + 16384); bf16_t* o_qd = (bf16_t*)(cb + 32768); bf16_t* o_kdT = (bf16_t*)(cb + 49152); bf16_t* o_attn = (bf16_t*)(cb + 65536);
#ifndef NO_S1
    {
        const int tok = tid >> 3, seg = tid & 7; const float* cw = p.in[22]; const float* cst = p.in[5];
#pragma unroll 1
        for (int part = 0; part < 3; ++part) {
            const int cbase = part * 512 + h * 128 + seg * 16; float y[16];
#pragma unroll
            for (int i = 0; i < 16; ++i) y[i] = 0.f;
            if (tok < ntok) {
#pragma unroll
                for (int j = 0; j < 4; ++j) { const int ti = tok - 3 + j; const int tabs = n * 64 + ti; float xv[16];
                    if (tabs >= 0) { const u32x4 a0 = *(const u32x4*)(qkvraw + (size_t)(rowbase + ti) * 1536 + cbase), a1 = *(const u32x4*)(qkvraw + (size_t)(rowbase + ti) * 1536 + cbase + 8);
                        f32x4 t0, t1, t2, t3; unpack8(a0, t0, t1); unpack8(a1, t2, t3);
#pragma unroll
                        for (int i = 0; i < 4; ++i) { xv[i] = t0[i]; xv[4 + i] = t1[i]; xv[8 + i] = t2[i]; xv[12 + i] = t3[i]; } }
                    else if (samp) { const float* sp = cst + (size_t)(b * 3 + 3 + tabs) * 1536 + cbase;
#pragma unroll
                        for (int i = 0; i < 16; ++i) xv[i] = sp[i]; }
                    else {
#pragma unroll
                        for (int i = 0; i < 16; ++i) xv[i] = 0.f; }
#pragma unroll
                    for (int i = 0; i < 16; ++i) y[i] += xv[i] * cw[j * 1536 + cbase + i]; }
#pragma unroll
                for (int i = 0; i < 16; ++i) y[i] = silu_f(y[i]);
            }
            float sc = 1.0f;
            if (part < 2) { float ss = 0.f;
#pragma unroll
                for (int i = 0; i < 16; ++i) ss += y[i] * y[i];
                ss += __shfl_xor(ss, 1); ss += __shfl_xor(ss, 2); ss += __shfl_xor(ss, 4);
                sc = rsqrtf(ss + 1e-6f); if (part == 0) sc *= 0.08838834764831845f; }
            LAS bf16_t* dst = (part == 0 ? qn : (part == 1 ? kn : vv)) + tok * 136 + seg * 16;
            u32x4 w0, w1; w0.x = cvt_pk_bf16(y[0] * sc, y[1] * sc); w0.y = cvt_pk_bf16(y[2] * sc, y[3] * sc); w0.z = cvt_pk_bf16(y[4] * sc, y[5] * sc); w0.w = cvt_pk_bf16(y[6] * sc, y[7] * sc);
            w1.x = cvt_pk_bf16(y[8] * sc, y[9] * sc); w1.y = cvt_pk_bf16(y[10] * sc, y[11] * sc); w1.z = cvt_pk_bf16(y[12] * sc, y[13] * sc); w1.w = cvt_pk_bf16(y[14] * sc, y[15] * sc);
            *(LAS u32x4*)dst = w0; *(LAS u32x4*)(dst + 8) = w1;
        }
    }
#endif
    if (tid < 64) { float gg = 0.f, be = 0.f;
        if (tid < ntok) { const float a = gates[(size_t)(rowbase + tid) * 8 + 4 + h], bb = gates[(size_t)(rowbase + tid) * 8 + h];
            const float xs = a + p.in[24][h]; const float sp = xs > 20.f ? xs : log1pf(expf(xs)); gg = -expf(p.in[23][h]) * sp; be = 1.0f / (1.0f + expf(-bb)); }
        float gc = gg;
#pragma unroll
        for (int o = 1; o < 64; o <<= 1) { const float v = __shfl_up(gc, o); if (lane >= o) gc += v; }
        gcs[tid] = gc; betas[tid] = be; egc[tid] = expf(gc);
        if (tid == 63) ((float*)(p.ws + WS_GL))[ch] = expf(gc); }
    __syncthreads();
#ifndef NO_S3
    {
        const int rt = w & 3, kind = w >> 2; LAS bf16_t* am = kind ? qn : kn;
        bf16x8 af[4];
#pragma unroll
        for (int ks = 0; ks < 4; ++ks) af[ks] = *(const LAS bf16x8*)(am + (16 * rt + fr) * 136 + 32 * ks + 8 * fq);
#pragma unroll
        for (int ct = 0; ct < 4; ++ct) {
            f32x4 acc = (f32x4){0.f, 0.f, 0.f, 0.f};
            if (ct <= rt) {
#pragma unroll
                for (int ks = 0; ks < 4; ++ks) { const bf16x8 bfr = *(const LAS bf16x8*)(kn + (16 * ct + fr) * 136 + 32 * ks + 8 * fq); acc = __builtin_amdgcn_mfma_f32_16x16x32_bf16(af[ks], bfr, acc, 0, 0, 0); } }
            const int col = 16 * ct + fr; const float gcc = gcs[col];
#pragma unroll
            for (int j = 0; j < 4; ++j) { const int row = 16 * rt + 4 * fq + j; const float dec = __expf(fminf(gcs[row] - gcc, 0.f));
                if (kind == 0) Am[row * 64 + col] = (row > col) ? betas[row] * acc[j] * dec : 0.f;
                else o_attn[row * 64 + col] = f2bf((row >= col) ? acc[j] * dec : 0.f); }
        }
    }
#endif
    __syncthreads();
#ifndef NO_S4
    int vz = 0; asm volatile("" : "+v"(vz));
    if (tid < 256) {
        const int c = tid; const bool isu = c < 128; const int cc = isu ? c : c - 128; LAS bf16_t* srcm = isu ? vv : kn;
        LAS float* AmV = Am + vz; LAS float* beV = betas + vz; LAS float* egV = egc + vz;
        float X[64];
#pragma unroll
        for (int i = 0; i < 64; ++i) {
            float r = bf2f(srcm[i * 136 + cc]) * beV[i]; if (!isu) r *= egV[i];
#pragma unroll
            for (int j4 = 0; j4 < (i + 3) / 4; ++j4) { const f32x4 a4 = *(const LAS f32x4*)(AmV + i * 64 + j4 * 4);
#pragma unroll
                for (int jj = 0; jj < 4; ++jj) { if (j4 * 4 + jj < i) r -= a4[jj] * X[j4 * 4 + jj]; } }
            asm volatile("" : "+v"(r) :: "memory"); X[i] = r; }
        if (isu) {
#pragma unroll
            for (int i8 = 0; i8 < 8; ++i8) { u32x4 wv; wv.x = cvt_pk_bf16(X[i8 * 8], X[i8 * 8 + 1]); wv.y = cvt_pk_bf16(X[i8 * 8 + 2], X[i8 * 8 + 3]); wv.z = cvt_pk_bf16(X[i8 * 8 + 4], X[i8 * 8 + 5]); wv.w = cvt_pk_bf16(X[i8 * 8 + 6], X[i8 * 8 + 7]);
                *(u32x4*)(o_uT + cc * 64 + i8 * 8) = wv; } }
        else {
#pragma unroll
            for (int i = 0; i < 64; ++i) o_w[i * 128 + cc] = f2bf(X[i]); }
    } else {
        const int c = tid - 256;
        LAS float* gcV = gcs + vz; LAS float* egV = egc + vz;
        if (c < 128) { const float gl_ = gcV[63];
#pragma unroll
            for (int i8 = 0; i8 < 8; ++i8) { float v[8];
#pragma unroll
                for (int e = 0; e < 8; ++e) { const int tk = i8 * 8 + e; v[e] = bf2f(kn[tk * 136 + c]) * __expf(gl_ - gcV[tk]); }
                u32x4 wv; wv.x = cvt_pk_bf16(v[0], v[1]); wv.y = cvt_pk_bf16(v[2], v[3]); wv.z = cvt_pk_bf16(v[4], v[5]); wv.w = cvt_pk_bf16(v[6], v[7]);
                *(u32x4*)(o_kdT + c * 64 + i8 * 8) = wv; } }
        else { const int cc = c - 128;
#pragma unroll 8
            for (int i = 0; i < 64; ++i) o_qd[i * 128 + cc] = f2bf(bf2f(qn[i * 136 + cc]) * egV[i]); }
    }
#endif
    __syncthreads();
}

struct GFrag { bf16x8 Aw[4], Aq[4], Aa[2], Ak[2]; bf16x4 u; float gl; };
__device__ __forceinline__ void gdn_load(GFrag& f, const unsigned char* ws, int ch, int w, int tt, int dt, int sl, int fr, int fq) {
    const unsigned char* cb = ws + WS_R3 + (size_t)ch * GDN_CH_BYTES;
    const bf16_t* uT = (const bf16_t*)cb; const bf16_t* wm = (const bf16_t*)(cb + 16384); const bf16_t* qd = (const bf16_t*)(cb + 32768); const bf16_t* kdT = (const bf16_t*)(cb + 49152); const bf16_t* at = (const bf16_t*)(cb + 65536);
#pragma unroll
    for (int ks = 0; ks < 4; ++ks) { f.Aw[ks] = *(const bf16x8*)(wm + (16 * tt + fr) * 128 + 32 * ks + 8 * fq); f.Aq[ks] = *(const bf16x8*)(qd + (16 * tt + fr) * 128 + 32 * ks + 8 * fq); }
#pragma unroll
    for (int k2 = 0; k2 < 2; ++k2) { f.Aa[k2] = *(const bf16x8*)(at + (16 * tt + fr) * 64 + 32 * k2 + 8 * fq); f.Ak[k2] = *(const bf16x8*)(kdT + (16 * w + fr) * 64 + 32 * k2 + 8 * fq); }
    f.u = *(const bf16x4*)(uT + (sl * 32 + 16 * dt + fr) * 64 + 16 * tt + 4 * fq);
    f.gl = ((const float*)(ws + WS_GL))[ch];
}
__device__ __forceinline__ void gdn_chain_item(KPR p, int item, LAS unsigned char* lds) {
    const int tid = ltid(), lane = tid & 63, w = __builtin_amdgcn_readfirstlane(tid >> 6), fr = lane & 15, fq = lane >> 4, tt = w & 3, dt = w >> 2;
    int bh, sl, nsteps, ch0, rowbase, h, ntok; float* sout; const float* sin = nullptr;
    if (item < 128) { bh = item >> 2; sl = item & 3; nsteps = 128; ch0 = bh * 128; rowbase = (bh >> 2) * 8192; h = bh & 3; ntok = 64; sout = p.out + O_PGDN + (size_t)bh * 16384; }
    else { const int j = item - 128; bh = j >> 2; sl = j & 3; nsteps = 1; ch0 = 4096 + bh; rowbase = TP + (bh >> 2) * 16; h = bh & 3; ntok = 16; sout = p.out + O_SGDN + (size_t)bh * 16384; sin = p.in[4] + (size_t)bh * 16384; }
    LAS unsigned char* ST = lds; LAS unsigned char* VN = lds + 32 * 272;
    bf16_t* go = (bf16_t*)(p.ws + WS_R4);
    f32x4 accS[2];
#pragma unroll
    for (int d2 = 0; d2 < 2; ++d2) {
#pragma unroll
        for (int j = 0; j < 4; ++j) accS[d2][j] = sin ? sin[(size_t)(16 * w + 4 * fq + j) * 128 + sl * 32 + 16 * d2 + fr] : 0.f;
        u32x2 wv; wv.x = cvt_pk_bf16(accS[d2][0], accS[d2][1]); wv.y = cvt_pk_bf16(accS[d2][2], accS[d2][3]);
        *(LAS u32x2*)(ST + (16 * d2 + fr) * 272 + (16 * w + 4 * fq) * 2) = wv; }
    GFrag cur; gdn_load(cur, p.ws, ch0, w, tt, dt, sl, fr, fq);
    LDS_BARRIER();
    for (int n = 0; n < nsteps; ++n) {
        GFrag nx; const int chn = (n + 1 < nsteps) ? ch0 + n + 1 : ch0 + n; gdn_load(nx, p.ws, chn, w, tt, dt, sl, fr, fq);
        f32x4 accV = (f32x4){0.f, 0.f, 0.f, 0.f}, accO = (f32x4){0.f, 0.f, 0.f, 0.f};
#pragma unroll
        for (int ks = 0; ks < 4; ++ks) { const bf16x8 bs = *(const LAS bf16x8*)(ST + (16 * dt + fr) * 272 + (32 * ks + 8 * fq) * 2);
            accV = __builtin_amdgcn_mfma_f32_16x16x32_bf16(cur.Aw[ks], bs, accV, 0, 0, 0); accO = __builtin_amdgcn_mfma_f32_16x16x32_bf16(cur.Aq[ks], bs, accO, 0, 0, 0); }
        { const float v0 = bf2f((bf16_t)cur.u[0]) - accV[0], v1 = bf2f((bf16_t)cur.u[1]) - accV[1], v2 = bf2f((bf16_t)cur.u[2]) - accV[2], v3 = bf2f((bf16_t)cur.u[3]) - accV[3];
            u32x2 wv; wv.x = cvt_pk_bf16(v0, v1); wv.y = cvt_pk_bf16(v2, v3); *(LAS u32x2*)(VN + (16 * dt + fr) * 144 + (16 * tt + 4 * fq) * 2) = wv; }
        LDS_BARRIER();
#pragma unroll
        for (int k2 = 0; k2 < 2; ++k2) { const bf16x8 bv = *(const LAS bf16x8*)(VN + (16 * dt + fr) * 144 + (32 * k2 + 8 * fq) * 2); accO = __builtin_amdgcn_mfma_f32_16x16x32_bf16(cur.Aa[k2], bv, accO, 0, 0, 0); }
#pragma unroll
        for (int j = 0; j < 4; ++j) { const int tok = 16 * tt + 4 * fq + j; if (tok < ntok) go[(size_t)(rowbase + n * 64 + tok) * 512 + h * 128 + sl * 32 + 16 * dt + fr] = f2bf(accO[j]); }
#pragma unroll
        for (int d2 = 0; d2 < 2; ++d2) { accS[d2] = accS[d2] * cur.gl;
#pragma unroll
            for (int k2 = 0; k2 < 2; ++k2) { const bf16x8 bv = *(const LAS bf16x8*)(VN + (16 * d2 + fr) * 144 + (32 * k2 + 8 * fq) * 2); accS[d2] = __builtin_amdgcn_mfma_f32_16x16x32_bf16(cur.Ak[k2], bv, accS[d2], 0, 0, 0); }
            u32x2 wv; wv.x = cvt_pk_bf16(accS[d2][0], accS[d2][1]); wv.y = cvt_pk_bf16(accS[d2][2], accS[d2][3]);
            *(LAS u32x2*)(ST + (16 * d2 + fr) * 272 + (16 * w + 4 * fq) * 2) = wv; }
        LDS_BARRIER();
        cur = nx;
    }
#pragma unroll
    for (int d2 = 0; d2 < 2; ++d2)
#pragma unroll
        for (int j = 0; j < 4; ++j) sout[(size_t)(16 * w + 4 * fq + j) * 128 + sl * 32 + 16 * d2 + fr] = accS[d2][j];
    __syncthreads();
}

__device__ __forceinline__ void s5_scan_prompt(KPR p, int item) {
    const int idx = item * 512 + ltid(), pp = idx & 63, g = (idx >> 6) & 31, b = idx >> 11;
    const float* ss = (const float*)(p.ws + WS_R1) + ((size_t)g * CRG + b * 512) * 128; bf16_t* uc = (bf16_t*)(p.ws + WS_R5) + ((size_t)g * CRG + b * 512) * 384 + 256;
    const float* lp = (const float*)(p.ws + WS_LP16) + g * 128 + pp * 2; const float lr = lp[0], li = lp[1];
    float xr = 0.f, xi = 0.f;
    float sr[8], si[8], nr[8], ni[8];
#pragma unroll
    for (int k = 0; k < 8; ++k) { sr[k] = ss[(size_t)k * 128 + pp]; si[k] = ss[(size_t)k * 128 + 64 + pp]; }
    for (int n0 = 0; n0 < 512; n0 += 8) {
        const int nn = (n0 + 8 < 512) ? n0 + 8 : n0;
#pragma unroll
        for (int k = 0; k < 8; ++k) { nr[k] = ss[(size_t)(nn + k) * 128 + pp]; ni[k] = ss[(size_t)(nn + k) * 128 + 64 + pp]; }
#pragma unroll
        for (int k = 0; k < 8; ++k) { uc[(size_t)(n0 + k) * 384 + pp] = f2bf(xr); uc[(size_t)(n0 + k) * 384 + 64 + pp] = f2bf(xi);
            const float tr = lr * xr - li * xi + sr[k], ti = lr * xi + li * xr + si[k]; xr = tr; xi = ti; }
#pragma unroll
        for (int k = 0; k < 8; ++k) { sr[k] = nr[k]; si[k] = ni[k]; }
    }
    p.out[O_PS5RE + (size_t)(b * 32 + g) * 64 + pp] = xr; p.out[O_PS5IM + (size_t)(b * 32 + g) * 64 + pp] = xi;
}
__device__ __forceinline__ void s5_scan_sample(KPR p, int item) {
    const int idx = item * 512 + threadIdx.x, pp = idx & 63, g = (idx >> 6) & 31, b = idx >> 11;
    const size_t row = (size_t)g * CRG + 4096 + b;
    const float* ss = (const float*)(p.ws + WS_R1) + row * 128; bf16_t* uc = (bf16_t*)(p.ws + WS_R5) + row * 384 + 256;
    const float* lp = (const float*)(p.ws + WS_LP16) + g * 128 + pp * 2; const float lr = lp[0], li = lp[1];
    const float xr = p.in[2][(size_t)(b * 32 + g) * 64 + pp], xi = p.in[3][(size_t)(b * 32 + g) * 64 + pp];
    uc[pp] = f2bf(xr); uc[64 + pp] = f2bf(xi);
    p.out[O_SS5RE + (size_t)(b * 32 + g) * 64 + pp] = lr * xr - li * xi + ss[pp]; p.out[O_SS5IM + (size_t)(b * 32 + g) * 64 + pp] = lr * xi + li * xr + ss[64 + pp];
}

__device__ __forceinline__ void attn_item(KPR p, int item, LAS unsigned char* lds) {
    const int tid = ltid(), lane = tid & 63, w = __builtin_amdgcn_readfirstlane(tid >> 6), fr = lane & 15, fq = lane >> 4;
    const bf16_t* Q = (const bf16_t*)(p.ws + WS_R1); const bf16_t* KB = (const bf16_t*)(p.ws + WS_R5); const bf16_t* VB = KB + (size_t)T * 256; bf16_t* AO = (bf16_t*)(p.ws + WS_R2);
    LAS unsigned char* Ks = lds; LAS unsigned char* Vt = lds + 192 * 144;
    int kvh, qrow0, nq, nkt, nvalid; const bool samp = item >= 4096;
    if (!samp) { kvh = item & 3; const int c = (item >> 2) & 127, b = item >> 9; const int c0 = c >= 2 ? c - 2 : 0; qrow0 = b * 8192 + c * 64; nq = 64; nvalid = (c - c0 + 1) * 64; nkt = nvalid >> 4;
        const int krow0 = b * 8192 + c0 * 64;
        for (int e = tid; e < nvalid * 8; e += 512) { const int row = e >> 3, pc = e & 7;
            const u32x4 kw = *(const u32x4*)(KB + (size_t)(krow0 + row) * 256 + kvh * 64 + pc * 8); *(LAS u32x4*)(Ks + row * 144 + pc * 16) = kw;
            const u32x4 vw = *(const u32x4*)(VB + (size_t)(krow0 + row) * 256 + kvh * 64 + pc * 8);
            const unsigned vs[4] = {vw.x, vw.y, vw.z, vw.w};
#pragma unroll
            for (int jj = 0; jj < 4; ++jj) { *(LAS bf16_t*)(Vt + (pc * 8 + 2 * jj) * 400 + row * 2) = (bf16_t)(vs[jj] & 0xffffu); *(LAS bf16_t*)(Vt + (pc * 8 + 2 * jj + 1) * 400 + row * 2) = (bf16_t)(vs[jj] >> 16); } } }
    else { const int j = item - 4096; kvh = j & 3; const int b = j >> 2; qrow0 = TP + b * 16; nq = 16; nvalid = 144; nkt = 10;
        const float* ck = p.in[6]; const float* cv = p.in[7];
        for (int e = tid; e < 160 * 8; e += 512) { const int row = e >> 3, pc = e & 7; u32x4 kw = (u32x4){0u, 0u, 0u, 0u}, vw = (u32x4){0u, 0u, 0u, 0u};
            if (row < 128) { const float* kp = ck + ((size_t)(b * 128 + row) * 4 + kvh) * 64 + pc * 8; const float* vp = cv + ((size_t)(b * 128 + row) * 4 + kvh) * 64 + pc * 8;
                kw = pack8(*(const f32x4*)kp, *(const f32x4*)(kp + 4)); vw = pack8(*(const f32x4*)vp, *(const f32x4*)(vp + 4)); }
            else if (row < 144) { kw = *(const u32x4*)(KB + (size_t)(qrow0 + row - 128) * 256 + kvh * 64 + pc * 8); vw = *(const u32x4*)(VB + (size_t)(qrow0 + row - 128) * 256 + kvh * 64 + pc * 8); }
            *(LAS u32x4*)(Ks + row * 144 + pc * 16) = kw;
            const unsigned vs[4] = {vw.x, vw.y, vw.z, vw.w};
#pragma unroll
            for (int jj = 0; jj < 4; ++jj) { *(LAS bf16_t*)(Vt + (pc * 8 + 2 * jj) * 400 + row * 2) = (bf16_t)(vs[jj] & 0xffffu); *(LAS bf16_t*)(Vt + (pc * 8 + 2 * jj + 1) * 400 + row * 2) = (bf16_t)(vs[jj] >> 16); } } }
    const int hg = w >> 1, th = w & 1, head = kvh * 4 + hg;
    bf16x8 qf[2][2];
#pragma unroll
    for (int qt = 0; qt < 2; ++qt)
#pragma unroll
        for (int ks = 0; ks < 2; ++ks) { const int tok = 32 * th + 16 * qt + fr; qf[qt][ks] = (bf16x8){0, 0, 0, 0, 0, 0, 0, 0};
            if (tok < nq) qf[qt][ks] = *(const bf16x8*)(Q + (size_t)(qrow0 + tok) * 1024 + head * 64 + 32 * ks + 8 * fq); }
    const float sink = p.in[30][head];
    __syncthreads();
    f32x4 sc[12][2];
#pragma unroll
    for (int kt = 0; kt < 12; ++kt) {
#pragma unroll
        for (int qt = 0; qt < 2; ++qt) sc[kt][qt] = (f32x4){0.f, 0.f, 0.f, 0.f};
        if (kt < nkt) {
#pragma unroll
            for (int ks = 0; ks < 2; ++ks) { const bf16x8 kf = *(const LAS bf16x8*)(Ks + (16 * kt + fr) * 144 + (32 * ks + 8 * fq) * 2);
#pragma unroll
                for (int qt = 0; qt < 2; ++qt) sc[kt][qt] = __builtin_amdgcn_mfma_f32_16x16x32_bf16(kf, qf[qt][ks], sc[kt][qt], 0, 0, 0); } }
    }
    float mx[2] = {sink, sink};
#pragma unroll
    for (int kt = 0; kt < 12; ++kt)
#pragma unroll
        for (int qt = 0; qt < 2; ++qt)
#pragma unroll
            for (int j = 0; j < 4; ++j) { const bool ok = (kt < nkt) && (16 * kt + 4 * fq + j < nvalid); if (!ok) sc[kt][qt][j] = -1e30f; mx[qt] = fmaxf(mx[qt], sc[kt][qt][j]); }
    float sm[2];
#pragma unroll
    for (int qt = 0; qt < 2; ++qt) { mx[qt] = fmaxf(mx[qt], __shfl_xor(mx[qt], 16)); mx[qt] = fmaxf(mx[qt], __shfl_xor(mx[qt], 32)); sm[qt] = 0.f; }
#pragma unroll
    for (int kt = 0; kt < 12; ++kt)
#pragma unroll
        for (int qt = 0; qt < 2; ++qt)
#pragma unroll
            for (int j = 0; j < 4; ++j) { const float e = __expf(sc[kt][qt][j] - mx[qt]); sc[kt][qt][j] = e; sm[qt] += e; }
    float inv[2];
#pragma unroll
    for (int qt = 0; qt < 2; ++qt) { sm[qt] += __shfl_xor(sm[qt], 16); sm[qt] += __shfl_xor(sm[qt], 32); inv[qt] = 1.0f / (sm[qt] + __expf(sink - mx[qt])); }
    f32x4 oacc[4][2];
#pragma unroll
    for (int dd = 0; dd < 4; ++dd)
#pragma unroll
        for (int qt = 0; qt < 2; ++qt) oacc[dd][qt] = (f32x4){0.f, 0.f, 0.f, 0.f};
#pragma unroll
    for (int kp = 0; kp < 6; ++kp) {
        if (2 * kp < nkt) {
            bf16x8 pf[2];
#pragma unroll
            for (int qt = 0; qt < 2; ++qt) { const f32x4 a = sc[2 * kp][qt] * inv[qt], b2 = sc[2 * kp + 1][qt] * inv[qt]; const u32x4 pw = pack8(a, b2); pf[qt] = __builtin_bit_cast(bf16x8, pw); }
#pragma unroll
            for (int dd = 0; dd < 4; ++dd) { const bf16x4 v0 = *(const LAS bf16x4*)(Vt + (16 * dd + fr) * 400 + (32 * kp + 4 * fq) * 2), v1 = *(const LAS bf16x4*)(Vt + (16 * dd + fr) * 400 + (32 * kp + 16 + 4 * fq) * 2);
                const bf16x8 vf = (bf16x8){v0[0], v0[1], v0[2], v0[3], v1[0], v1[1], v1[2], v1[3]};
#pragma unroll
                for (int qt = 0; qt < 2; ++qt) oacc[dd][qt] = __builtin_amdgcn_mfma_f32_16x16x32_bf16(vf, pf[qt], oacc[dd][qt], 0, 0, 0); } }
    }
#pragma unroll
    for (int qt = 0; qt < 2; ++qt) { const int tok = 32 * th + 16 * qt + fr;
        if (tok < nq) {
#pragma unroll
            for (int dd = 0; dd < 4; ++dd) { u32x2 wv; wv.x = cvt_pk_bf16(oacc[dd][qt][0], oacc[dd][qt][1]); wv.y = cvt_pk_bf16(oacc[dd][qt][2], oacc[dd][qt][3]);
                *(u32x2*)(AO + (size_t)(qrow0 + tok) * 1024 + head * 64 + 16 * dd + 4 * fq) = wv; } } }
    __syncthreads();
}

__global__ void __launch_bounds__(512) fwd_kernel(Params p_arg) {
    extern __shared__ __attribute__((aligned(16))) unsigned char lds_raw[];
    LAS unsigned char* lds = (LAS unsigned char*)lds_raw;
    cg::grid_group grid = cg::this_grid();
    const int G = gridDim.x, bx = blockIdx.x, tid = threadIdx.x;
    const int lo = p_arg.ph_lo, hi = p_arg.ph_hi;
#ifndef PHMASK
#define PHMASK 0x7fff
#endif
#define IN(k) (((PHMASK >> (k)) & 1) && lo <= (k) && (k) < hi)
    unsigned* const barctr = (unsigned*)(p_arg.ws + WS_BAR); unsigned nbar = 0;
#define GRIDBAR() do { __syncthreads(); ++nbar; \
        if (tid == 0) { const unsigned target = nbar * (unsigned)G; __builtin_amdgcn_fence(__ATOMIC_RELEASE, "agent"); __hip_atomic_fetch_add(barctr, 1u, __ATOMIC_RELAXED, __HIP_MEMORY_SCOPE_AGENT); \
            while (__hip_atomic_load(barctr, __ATOMIC_RELAXED, __HIP_MEMORY_SCOPE_AGENT) < target) __builtin_amdgcn_s_sleep(1); \
            __builtin_amdgcn_fence(__ATOMIC_ACQUIRE, "agent"); } \
        __syncthreads(); } while (0)
#define SEAM(k) do { if (IN(k) && IN((k) + 1)) { if ((k) <= CG_SEAMS) grid.sync(); else GRIDBAR(); } } while (0)
#define PHASE_BEGIN(k) _Pragma("unroll 1") for (int rep_ = 0; rep_ < ((((REP_MASK) >> (k)) & 1) ? 2 : 1); ++rep_) { if (rep_) GRIDBAR();
#define PHASE_END }
#define R1 ((bf16_t*)(p.ws + WS_R1))
#define R2 ((bf16_t*)(p.ws + WS_R2))
#define ACT ((bf16_t*)(p.ws + WS_R3))
#define ZG ((bf16_t*)(p.ws + WS_R3 + GDN_BYTES))
#define XB ((bf16_t*)(p.ws + WS_R4))
#define GO XB
#define ZS5 (XB + (size_t)T * 512)
#define UCAT ((bf16_t*)(p.ws + WS_R5))
#define SUMSQ ((float*)(p.ws + WS_SUMSQ))
#define GATES ((float*)(p.ws + WS_GATES))
    PHASE_BEGIN(0)
    if (IN(0)) { KPR p = *launder_kp(); phase0(p, lds); }
    PHASE_END
    SEAM(0);
    PHASE_BEGIN(1)
    if (IN(1)) { KPR p = *launder_kp(); pg8::Gemm g{R1, (const bf16_t*)(p.ws + WS_W1T), 1024, 1024, 1024}; pg8::StaticOrder S; S.init(T, 2816, G, bx); Epi1 E{UCAT, R2, ZG, GATES}; pg8::gemm_phase(lds, g, S, E); }
    PHASE_END
    SEAM(1);
    PHASE_BEGIN(2)
    if (IN(2)) { KPR p = *launder_kp();
        { pg8::Gemm g{UCAT, (const bf16_t*)(p.ws + WS_HT), 384, 256, 256}; pg8::GroupOrder S{G, bx}; EpiS E{(float*)(p.ws + WS_R1)}; pg8::gemm_phase(lds, g, S, E); }
        __syncthreads();
        for (int ch = bx; ch < NCH; ch += G) gdn_prep_item(p, ch, lds);
        for (int i = bx * 512 + tid; i < 24 * 3 * 1536; i += G * 512) { const int c = i % 1536, j = (i / 1536) % 3, b = i / 4608;
            if (b < 8) p.out[O_PCONV + (size_t)(b * 3 + j) * 1536 + c] = bf2f(R2[(size_t)(b * 8192 + 8189 + j) * 1536 + c]);
            else p.out[O_SCONV + (size_t)((b - 8) * 3 + j) * 1536 + c] = bf2f(R2[(size_t)(TP + (b - 8) * 16 + 13 + j) * 1536 + c]); }
    }
    PHASE_END
    SEAM(2);
    PHASE_BEGIN(3)
    if (IN(3)) { KPR p = *launder_kp();
        for (int it = bx; it < 480; it += G) {
            if (it < 128) gdn_chain_item(p, it, lds);
            else if (it < 160) s5_scan_prompt(p, it - 128);
            else if (it < 416) gdn_chain_item(p, it - 160 + 128, lds);
            else s5_scan_sample(p, it - 416);
        }
    }
    PHASE_END
    SEAM(3);
    PHASE_BEGIN(4)
    if (IN(4)) { KPR p = *launder_kp();
        { pg8::Gemm g{UCAT, (const bf16_t*)(p.ws + WS_KGT), 384, 384, 384}; pg8::GroupOrder S{G, bx}; EpiY E{UCAT, p.in[19], ZS5}; pg8::gemm_phase(lds, g, S, E); }
        const float* nw = p.in[25];
        for (size_t gi = ((size_t)bx * 512 + tid) >> 4; gi < (size_t)T * 4; gi += ((size_t)G * 512) >> 4) { const int l16 = tid & 15; const size_t r = gi >> 2; const int h = (int)(gi & 3);
            const u32x4 ow = *(const u32x4*)(GO + r * 512 + h * 128 + l16 * 8), zw = *(const u32x4*)(ZG + r * 512 + h * 128 + l16 * 8);
            f32x4 o0, o1, z0, z1; unpack8(ow, o0, o1); unpack8(zw, z0, z1);
            float s = (o0[0] * o0[0] + o0[1] * o0[1]) + (o0[2] * o0[2] + o0[3] * o0[3]) + (o1[0] * o1[0] + o1[1] * o1[1]) + (o1[2] * o1[2] + o1[3] * o1[3]);
            s += __shfl_xor(s, 1); s += __shfl_xor(s, 2); s += __shfl_xor(s, 4); s += __shfl_xor(s, 8);
            const float rs = rsqrtf(s * (1.0f / 128.0f) + 1e-6f); const f32x4 w0 = *(const f32x4*)(nw + l16 * 8), w1 = *(const f32x4*)(nw + l16 * 8 + 4);
            f32x4 y0, y1;
#pragma unroll
            for (int j = 0; j < 4; ++j) { y0[j] = o0[j] * rs * w0[j] * silu_f(z0[j]); y1[j] = o1[j] * rs * w1[j] * silu_f(z1[j]); }
            *(u32x4*)(R1 + r * 1024 + 512 + h * 128 + l16 * 8) = pack8(y0, y1); }
    }
    PHASE_END
    SEAM(4);
    PHASE_BEGIN(5)
    if (IN(5)) { KPR p = *launder_kp(); pg8::Gemm g{ZS5, (const bf16_t*)(p.ws + WS_WGLU), 512, 512, 512}; pg8::StaticOrder S; S.init(T, 512, G, bx); EpiGlu E{ZS5, p.in[21], R1}; pg8::gemm_phase(lds, g, S, E); }
    PHASE_END
    SEAM(5);
    PHASE_BEGIN(6)
    if (IN(6)) { KPR p = *launder_kp(); pg8::Gemm g{R1, (const bf16_t*)(p.ws + WS_WOUT), 1024, 1024, 1024}; pg8::StaticOrder S; S.init(T, 1024, G, bx); EpiRes E{p.in[0], p.in[1], p.out, XB, SUMSQ}; pg8::gemm_phase(lds, g, S, E); }
    PHASE_END
    SEAM(6);
    PHASE_BEGIN(7)
    if (IN(7)) { KPR p = *launder_kp(); pg8::Gemm g{XB, (const bf16_t*)(p.ws + WS_WF1_0), 1024, 1024, 1024}; pg8::StaticOrder S; S.init(T, 5632, G, bx); EpiFF E{SUMSQ, ACT}; pg8::gemm_phase(lds, g, S, E); }
    PHASE_END
    SEAM(7);
    PHASE_BEGIN(8)
    if (IN(8)) { KPR p = *launder_kp(); pg8::Gemm g{ACT, (const bf16_t*)(p.ws + WS_WFD_0), 2816, 2816, 2816}; pg8::StaticOrder S; S.init(T, 1024, G, bx); EpiRes E{p.out, p.out + (size_t)TP * 1024, p.out, XB, SUMSQ + T}; pg8::gemm_phase(lds, g, S, E); }
    PHASE_END
    SEAM(8);
    PHASE_BEGIN(9)
    if (IN(9)) { KPR p = *launder_kp(); pg8::Gemm g{XB, (const bf16_t*)(p.ws + WS_WQKV), 1024, 1024, 1024}; pg8::StaticOrder S; S.init(T, 1536, G, bx);
        EpiQKV E{SUMSQ + T, R1, UCAT, UCAT + (size_t)T * 256, p.out + O_PK, p.out + O_PV, p.out + O_SK, p.out + O_SV}; pg8::gemm_phase(lds, g, S, E); }
    PHASE_END
    SEAM(9);
    PHASE_BEGIN(10)
    if (IN(10)) { KPR p = *launder_kp(); for (int it = bx; it < 4160; it += G) attn_item(p, it, lds); }
    PHASE_END
    SEAM(10);
    PHASE_BEGIN(11)
    if (IN(11)) { KPR p = *launder_kp(); pg8::Gemm g{R2, (const bf16_t*)(p.ws + WS_WO), 1024, 1024, 1024}; pg8::StaticOrder S; S.init(T, 1024, G, bx); EpiRes E{p.out, p.out + (size_t)TP * 1024, p.out, XB, SUMSQ + 2 * T}; pg8::gemm_phase(lds, g, S, E); }
    PHASE_END
    SEAM(11);
    PHASE_BEGIN(12)
    if (IN(12)) { KPR p = *launder_kp(); pg8::Gemm g{XB, (const bf16_t*)(p.ws + WS_WF1_1), 1024, 1024, 1024}; pg8::StaticOrder S; S.init(T, 5632, G, bx); EpiFF E{SUMSQ + 2 * T, ACT}; pg8::gemm_phase(lds, g, S, E); }
    PHASE_END
    SEAM(12);
    PHASE_BEGIN(13)
    if (IN(13)) { KPR p = *launder_kp(); pg8::Gemm g{ACT, (const bf16_t*)(p.ws + WS_WFD_1), 2816, 2816, 2816}; pg8::StaticOrder S; S.init(T, 1024, G, bx); EpiRes E{p.out, p.out + (size_t)TP * 1024, p.out, nullptr, SUMSQ + 3 * T}; pg8::gemm_phase(lds, g, S, E); }
    PHASE_END
    SEAM(13);
    PHASE_BEGIN(14)
    if (IN(14)) { KPR p = *launder_kp();
        const int lane = tid & 63, wid = tid >> 6; const float* nw = p.in[10]; const float* sq = SUMSQ + 3 * T;
        f32x4 wv[4];
#pragma unroll
        for (int i = 0; i < 4; ++i) wv[i] = *(const f32x4*)(nw + lane * 4 + i * 256);
        for (int r = bx * 8 + wid; r < T; r += G * 8) { const float rs = rsqrtf(sq[r] * (1.0f / 1024.0f) + 1e-6f); float* xp = p.out + (size_t)r * 1024;
#pragma unroll
            for (int i = 0; i < 4; ++i) { const f32x4 v = *(const f32x4*)(xp + lane * 4 + i * 256); *(f32x4*)(xp + lane * 4 + i * 256) = v * rs * wv[i]; } }
    }
    PHASE_END
#undef IN
#undef SEAM
}

extern "C" void kernel_launch(void* const* d_in, const int* in_sizes, int n_in, void* d_out, int out_size, void* d_ws, size_t ws_size, hipStream_t stream) {
    static int grid_blocks = 0;
    if (!grid_blocks) {
        int dev = 0, cus = 0, per_cu = 0;
        hipGetDevice(&dev);
        hipDeviceGetAttribute(&cus, hipDeviceAttributeMultiprocessorCount, dev);
        hipFuncSetAttribute((const void*)fwd_kernel, hipFuncAttributeMaxDynamicSharedMemorySize, LDS_BYTES);
        hipOccupancyMaxActiveBlocksPerMultiprocessor(&per_cu, (const void*)fwd_kernel, 512, LDS_BYTES);
        if (per_cu < 1) per_cu = 1;
        grid_blocks = cus * per_cu;
        if (ws_size < WS_END) fprintf(stderr, "kernel_launch: workspace too small: %zu < %zu\n", ws_size, (size_t)WS_END);
    }
    hipMemsetAsync((unsigned char*)d_ws + WS_BAR, 0, 256, stream);
    Params p{};
    for (int i = 0; i < 35; ++i) p.in[i] = (const float*)d_in[i];
    p.out = (float*)d_out; p.ws = (unsigned char*)d_ws; p.ph_lo = 0; p.ph_hi = PH_HI;
    void* args[] = {&p};
    hipError_t e = hipLaunchCooperativeKernel((const void*)fwd_kernel, dim3(grid_blocks), dim3(512), args, LDS_BYTES, stream);
    if (e != hipSuccess) fprintf(stderr, "cooperative launch failed: %s (grid %d)\n", hipGetErrorString(e), grid_blocks);
}
```

```cpp
#include <hip/hip_runtime.h>
#include <hip/hip_cooperative_groups.h>
#include <cstdio>
namespace cg = cooperative_groups;

#define LAS __attribute__((address_space(3)))
typedef unsigned short bf16_t;
typedef short bf16x8 __attribute__((ext_vector_type(8)));
typedef short bf16x4 __attribute__((ext_vector_type(4)));
typedef float f32x4 __attribute__((ext_vector_type(4)));
typedef unsigned u32x4 __attribute__((ext_vector_type(4)));
typedef unsigned u32x2 __attribute__((ext_vector_type(2)));

constexpr int TP = 65536;
constexpr int TS = 256;
constexpr int T = TP + TS;
constexpr int DM = 1024;
constexpr int NCH = 4160;
constexpr int CRG = 4352;
constexpr int CRV = 4112;

constexpr size_t al256(size_t x) { return (x + 255) & ~(size_t)255; }
constexpr size_t WS_W1T = 0;
constexpr size_t WS_WGLU = WS_W1T + (size_t)2816 * 1024 * 2;
constexpr size_t WS_WOUT = WS_WGLU + (size_t)512 * 512 * 2;
constexpr size_t WS_WF1_0 = WS_WOUT + (size_t)1024 * 1024 * 2;
constexpr size_t WS_WFD_0 = WS_WF1_0 + (size_t)5632 * 1024 * 2;
constexpr size_t WS_WQKV = WS_WFD_0 + (size_t)1024 * 2816 * 2;
constexpr size_t WS_WO = WS_WQKV + (size_t)1536 * 1024 * 2;
constexpr size_t WS_WF1_1 = WS_WO + (size_t)1024 * 1024 * 2;
constexpr size_t WS_WFD_1 = WS_WF1_1 + (size_t)5632 * 1024 * 2;
constexpr size_t WS_KGT = WS_WFD_1 + (size_t)1024 * 2816 * 2;
constexpr size_t WS_HT = WS_KGT + (size_t)32 * 256 * 384 * 2;
constexpr size_t WS_LP16 = WS_HT + (size_t)32 * 256 * 256 * 2;
constexpr size_t WS_SUMSQ = WS_LP16 + (size_t)32 * 64 * 2 * 4;
constexpr size_t WS_GATES = WS_SUMSQ + al256((size_t)4 * T * 4);
constexpr size_t WS_GL = WS_GATES + al256((size_t)T * 8 * 4);
constexpr size_t WS_BAR = WS_GL + al256((size_t)NCH * 4);
constexpr size_t WS_R1 = WS_BAR + 256;
constexpr size_t R1_BYTES = (size_t)T * 1024 * 2;
constexpr size_t WS_R2 = WS_R1 + R1_BYTES;
constexpr size_t R2_BYTES = (size_t)T * 1536 * 2;
constexpr size_t WS_R3 = WS_R2 + R2_BYTES;
constexpr size_t GDN_CH_BYTES = 73728;
constexpr size_t GDN_BYTES = (size_t)NCH * GDN_CH_BYTES;
constexpr size_t R3_BYTES = GDN_BYTES + (size_t)T * 512 * 2;
constexpr size_t WS_R4 = WS_R3 + R3_BYTES;
constexpr size_t R4_BYTES = (size_t)T * 1024 * 2;
constexpr size_t WS_R5 = WS_R4 + R4_BYTES;
constexpr size_t R5_BYTES = (size_t)32 * CRG * 384 * 2;
constexpr size_t WS_END = WS_R5 + R5_BYTES;
static_assert(R3_BYTES >= (size_t)T * 2816 * 2, "ACT fits R3");
static_assert((size_t)32 * CRG * 128 * 4 <= R1_BYTES, "SS fits R1");
static_assert((size_t)T * 512 * 2 <= R5_BYTES, "K|V fit R5");
static_assert(WS_END <= (size_t)1073741824, "workspace");

constexpr size_t O_Y = 0;
constexpr size_t O_PS5RE = 67371008, O_PS5IM = 67387392, O_PGDN = 67403776, O_PCONV = 67928064, O_PK = 67964928, O_PV = 68227072;
constexpr size_t O_SS5RE = 68489216, O_SS5IM = 68521984, O_SGDN = 68554752, O_SCONV = 69603328, O_SK = 69677056, O_SV = 70201344;

constexpr int LDS_BYTES = 131072;
#ifndef CG_SEAMS
#define CG_SEAMS 0
#endif
#ifndef REP_MASK
#define REP_MASK 0
#endif
#ifndef PH_HI
#define PH_HI 15
#endif

struct Params { const float* in[35]; float* out; unsigned char* ws; int ph_lo, ph_hi; };
typedef const __attribute__((address_space(4))) Params& KPR;
typedef const __attribute__((address_space(4))) Params* KPP;
__device__ __forceinline__ int ltid() { int t = threadIdx.x; asm volatile("" : "+v"(t)); return t; }
__device__ __forceinline__ KPP launder_kp() { KPP q = (KPP)__builtin_amdgcn_kernarg_segment_ptr(); asm volatile("" : "+s"(q)); return q; }

typedef float f32x2v __attribute__((ext_vector_type(2)));
typedef __bf16 bf16x2v __attribute__((ext_vector_type(2)));
__device__ __forceinline__ unsigned cvt_pk_bf16(float lo, float hi) { const f32x2v v = {lo, hi}; const bf16x2v b = __builtin_convertvector(v, bf16x2v); return __builtin_bit_cast(unsigned, b); }
__device__ __forceinline__ bf16_t f2bf(float f) { return (bf16_t)(cvt_pk_bf16(f, 0.f) & 0xffffu); }
__device__ __forceinline__ float bf2f(bf16_t b) { return __uint_as_float(((unsigned)b) << 16); }
__device__ __forceinline__ float bflo(unsigned w) { return __uint_as_float(w << 16); }
__device__ __forceinline__ float bfhi(unsigned w) { return __uint_as_float(w & 0xffff0000u); }
__device__ __forceinline__ float silu_f(float x) { return x * __builtin_amdgcn_rcpf(1.0f + __expf(-x)); }
__device__ __forceinline__ float sigmoid_f(float x) { return __builtin_amdgcn_rcpf(1.0f + __expf(-x)); }
__device__ __forceinline__ float gelu_tanh_f(float x) { const float u = 1.5957691216057308f * (x + 0.044715f * x * x * x); return x * __builtin_amdgcn_rcpf(1.0f + __expf(-u)); }
#define LDS_BARRIER() do { asm volatile("s_waitcnt lgkmcnt(0)" ::: "memory"); __builtin_amdgcn_s_barrier(); asm volatile("" ::: "memory"); } while (0)

namespace pg8 {
constexpr int BM = 256, BK = 64, HALF = 128, HTB = HALF * BK * 2, STAGE_BYTES = 8 * HTB, NXCD = 8, WGM = 8;
__device__ __forceinline__ int lds_byte(int r, int c) { const int st = (r >> 4) * 2 + (c >> 5), rr = r & 15, cc = c & 31, ob = rr * 64 + cc * 2; return st * 1024 + (ob ^ (((ob >> 9) & 1) << 5)); }
__device__ __forceinline__ void stage_rc(int b, int& R, int& C) { const int st = b / 1024, sb = b % 1024, swz = sb ^ (((sb >> 9) & 1) << 5); R = (st >> 1) * 16 + swz / 64; C = (st & 1) * 32 + (swz % 64) / 2; }
__device__ __forceinline__ int perm32(int rho) { const int n = rho >> 4, i = rho & 15; return 8 * (i >> 2) + 4 * n + (i & 3); }
struct Unit { int pm, pn; };
struct Gemm { const bf16_t* A; const bf16_t* Bt; int lda, ldb, K; };
struct StaticOrder {
    int nM, nN, nwg, G, c;
    __device__ void init(int M, int N, int G_, int c_) { nM = M / BM; nN = N / BM; nwg = nM * nN; G = G_; c = c_; }
    __device__ bool next(int i, Unit& u) const {
        const long L = (long)i * G + c; if (L >= nwg) return false;
        int wgid = (int)L; { const int q = nwg / NXCD, r = nwg % NXCD, xcd = wgid % NXCD, off = wgid / NXCD; wgid = (xcd < r ? xcd * (q + 1) : r * (q + 1) + (xcd - r) * q) + off; }
        const int nig = WGM * nN, gid = wgid / nig, fm = gid * WGM, gsz = (nM - fm) < WGM ? (nM - fm) : WGM;
        u.pm = fm + ((wgid % nig) % gsz); u.pn = (wgid % nig) / gsz; return true;
    }
};
struct GroupOrder {
    int G, c;
    __device__ bool next(int i, Unit& u) const { const int L = i * G + c; if (L >= 32 * 17) return false; u.pm = L; u.pn = L / 17; return true; }
};

template <class Epi, class Sched>
__device__ __forceinline__ void gemm_phase(LAS unsigned char* lds, const Gemm g, const Sched& S, const Epi& E) {
    const int tid = ltid(), wid = __builtin_amdgcn_readfirstlane(tid >> 6), lane = tid & 63, wr = wid >> 2, wc = wid & 3, fr = lane & 15, fq = lane >> 4;
    const int K = g.K, nt = K / BK;
    unsigned voffA[2], voffB[2];
#pragma unroll
    for (int i = 0; i < 2; ++i) { int R, C; stage_rc(tid * 16 + i * 8192, R, C); const int Rb = Epi::PERM ? ((R & ~31) + perm32(R & 31)) : R;
        voffA[i] = (unsigned)(R * g.lda + C) * 2u; voffB[i] = (unsigned)(Rb * g.ldb + C) * 2u; }
    const size_t kstep = (size_t)(BK * 2);
    const size_t hstepA = (size_t)HALF * g.lda * 2, hstepB = (size_t)HALF * g.ldb * 2;
    const size_t tstepA = 2 * hstepA, tstepB = 2 * hstepB;
    const unsigned ldsw = (unsigned)wid * 1024u;
    const int aoff = lds_byte(wr * 64 + fr, fq * 8), boff = lds_byte(wc * 32 + fr, fq * 8);
#define PG8_SA(b, h) (((b) * 2 + (h)) * HTB)
#define PG8_SB(b, h) ((4 + (b) * 2 + (h)) * HTB)
#define PG8_STAGE(bufoff, gbase, voff) do { _Pragma("unroll") for (int _i = 0; _i < 2; ++_i) \
        __builtin_amdgcn_global_load_lds((const unsigned*)((const char*)(gbase) + (voff)[_i]), (LAS unsigned*)(lds + (bufoff) + ldsw + _i * 8192), 16, 0, 0); } while (0)
#define PG8_LDA(dst, b, h) do { _Pragma("unroll") for (int m = 0; m < 4; ++m) _Pragma("unroll") for (int k = 0; k < 2; ++k) dst[m][k] = *(const LAS bf16x8*)(lds + PG8_SA(b, h) + aoff + m * 2048 + k * 1024); } while (0)
#define PG8_LDB(dst, b, h) do { _Pragma("unroll") for (int n = 0; n < 2; ++n) _Pragma("unroll") for (int k = 0; k < 2; ++k) dst[n][k] = *(const LAS bf16x8*)(lds + PG8_SB(b, h) + boff + n * 2048 + k * 1024); } while (0)
#define PG8_MMA(ai, bj, At, Bt) do { __builtin_amdgcn_s_setprio(1); _Pragma("unroll") for (int m = 0; m < 4; ++m) _Pragma("unroll") for (int n = 0; n < 2; ++n) _Pragma("unroll") for (int k = 0; k < 2; ++k) \
        acc[ai][bj][m][n] = __builtin_amdgcn_mfma_f32_16x16x32_bf16(Bt[n][k], At[m][k], acc[ai][bj][m][n], 0, 0, 0); __builtin_amdgcn_s_setprio(0); } while (0)
#define PG8_WAIT_V(n) asm volatile("s_waitcnt vmcnt(" #n ")" ::: "memory")
#define PG8_WAIT_L(n) asm volatile("s_waitcnt lgkmcnt(" #n ")" ::: "memory")
#define PG8_BAR __builtin_amdgcn_s_barrier()
#define PG8_SCHED __builtin_amdgcn_sched_barrier(0)
    Unit cur, nxt; int ui = 0;
    if (!S.next(0, cur)) return;
    f32x4 acc[2][2][4][2];
#pragma unroll
    for (int a = 0; a < 2; ++a)
#pragma unroll
        for (int b = 0; b < 2; ++b)
#pragma unroll
            for (int m = 0; m < 4; ++m)
#pragma unroll
                for (int n = 0; n < 2; ++n) acc[a][b][m][n] = (f32x4){0.f, 0.f, 0.f, 0.f};
    bf16x8 At[4][2], B0[2][2], B1[2][2];
    const char* cA = (const char*)g.A + (size_t)cur.pm * tstepA; const char* cB = (const char*)g.Bt + (size_t)cur.pn * tstepB;
    PG8_STAGE(PG8_SB(0, 0), cB, voffB); PG8_STAGE(PG8_SB(0, 1), cB + hstepB, voffB); PG8_STAGE(PG8_SA(0, 0), cA, voffA); PG8_STAGE(PG8_SA(0, 1), cA + hstepA, voffA);
    if (wr == 1) PG8_BAR;
    PG8_WAIT_V(2); PG8_BAR;
    PG8_STAGE(PG8_SB(1, 0), cB + kstep, voffB); PG8_STAGE(PG8_SA(1, 0), cA + kstep, voffA); PG8_STAGE(PG8_SB(1, 1), cB + hstepB + kstep, voffB);
    PG8_WAIT_V(6); PG8_BAR;
    for (;;) {
        const bool has_next = S.next(ui + 1, nxt);
        const char* nA = has_next ? (const char*)g.A + (size_t)nxt.pm * tstepA : cA; const char* nB = has_next ? (const char*)g.Bt + (size_t)nxt.pn * tstepB : cB;
        for (int t = 0; t < nt; t += 2) {
            const bool last = (t == nt - 2);
            const char* a1 = cA + (size_t)(t + 1) * kstep;
            const char* a2 = last ? nA : cA + (size_t)(t + 2) * kstep; const char* b2 = last ? nB : cB + (size_t)(t + 2) * kstep;
            const char* a3 = a2 + kstep; const char* b3 = b2 + kstep;
            PG8_LDB(B0, 0, 0); PG8_LDB(B1, 0, 1); PG8_SCHED; PG8_LDA(At, 0, 0); PG8_STAGE(PG8_SA(1, 1), a1 + hstepA, voffA);
            PG8_WAIT_V(8); PG8_WAIT_L(0); PG8_BAR; PG8_MMA(0, 0, At, B0); PG8_MMA(0, 1, At, B1); PG8_BAR; PG8_SCHED;
            PG8_LDA(At, 0, 1); PG8_STAGE(PG8_SB(0, 0), b2, voffB); PG8_STAGE(PG8_SB(0, 1), b2 + hstepB, voffB); PG8_STAGE(PG8_SA(0, 0), a2, voffA);
            PG8_WAIT_V(8); PG8_WAIT_L(0); PG8_BAR; PG8_MMA(1, 0, At, B0); PG8_MMA(1, 1, At, B1); PG8_BAR; PG8_SCHED;
            PG8_LDB(B0, 1, 0); PG8_LDB(B1, 1, 1); PG8_SCHED; PG8_LDA(At, 1, 0); PG8_STAGE(PG8_SA(0, 1), a2 + hstepA, voffA);
            PG8_WAIT_V(8); PG8_WAIT_L(0); PG8_BAR; PG8_MMA(0, 0, At, B0); PG8_MMA(0, 1, At, B1); PG8_BAR; PG8_SCHED;
            PG8_LDA(At, 1, 1); PG8_STAGE(PG8_SB(1, 0), b3, voffB); PG8_STAGE(PG8_SB(1, 1), b3 + hstepB, voffB); PG8_STAGE(PG8_SA(1, 0), a3, voffA);
            PG8_WAIT_V(8); PG8_WAIT_L(0); PG8_BAR; PG8_MMA(1, 0, At, B0); PG8_MMA(1, 1, At, B1); PG8_BAR; PG8_SCHED;
        }
        if (wr == 0) PG8_BAR;
        { int frE = fr, fqE = fq; asm volatile("" : "+v"(frE), "+v"(fqE)); E(acc, cur, wr, wc, frE, fqE); }
        if (!has_next) break;
#pragma unroll
        for (int a = 0; a < 2; ++a)
#pragma unroll
            for (int b = 0; b < 2; ++b)
#pragma unroll
                for (int m = 0; m < 4; ++m)
#pragma unroll
                    for (int n = 0; n < 2; ++n) acc[a][b][m][n] = (f32x4){0.f, 0.f, 0.f, 0.f};
        cur = nxt; cA = nA; cB = nB; ++ui;
        if (wr == 1) PG8_BAR;
    }
    PG8_WAIT_V(0);
    PG8_BAR;
#undef PG8_SA
#undef PG8_SB
#undef PG8_STAGE
#undef PG8_LDA
#undef PG8_LDB
#undef PG8_MMA
#undef PG8_WAIT_V
#undef PG8_WAIT_L
#undef PG8_BAR
#undef PG8_SCHED
}
}
using pg8::Unit;

__device__ __forceinline__ u32x4 pack8(const f32x4 a, const f32x4 b) { u32x4 w; w.x = cvt_pk_bf16(a[0], a[1]); w.y = cvt_pk_bf16(a[2], a[3]); w.z = cvt_pk_bf16(b[0], b[1]); w.w = cvt_pk_bf16(b[2], b[3]); return w; }
__device__ __forceinline__ void unpack8(const u32x4 w, f32x4& a, f32x4& b) { a = (f32x4){bflo(w.x), bfhi(w.x), bflo(w.y), bfhi(w.y)}; b = (f32x4){bflo(w.z), bfhi(w.z), bflo(w.w), bfhi(w.w)}; }

struct Epi1 {
    static constexpr bool PERM = true;
    bf16_t* ucat; bf16_t* qkvraw; bf16_t* zg; float* gates;
    __device__ __forceinline__ void operator()(const f32x4 (&acc)[2][2][4][2], const Unit& u, int wr, int wc, int fr, int fq) const {
        const int row0 = u.pm * 256 + wr * 64 + fr, pn = u.pn;
#pragma unroll
        for (int ai = 0; ai < 2; ++ai)
#pragma unroll
            for (int m = 0; m < 4; ++m) { const int r = row0 + ai * 128 + m * 16;
#pragma unroll
                for (int bj = 0; bj < 2; ++bj) { const int c0 = pn * 256 + bj * 128 + wc * 32 + 8 * fq;
                    if (pn == 10) { if (bj == 0 && wc == 0 && fq == 0) { *(f32x4*)(gates + (size_t)r * 8) = acc[ai][bj][m][0]; *(f32x4*)(gates + (size_t)r * 8 + 4) = acc[ai][bj][m][1]; } }
                    else { const u32x4 w = pack8(acc[ai][bj][m][0], acc[ai][bj][m][1]); bf16_t* dst;
                        if (pn < 2) dst = ucat + ((size_t)((c0 >> 4) * CRG + (r >> 4)) * 384 + (r & 15) * 16 + (c0 & 15));
                        else if (pn < 8) dst = qkvraw + (size_t)r * 1536 + (c0 - 512);
                        else dst = zg + (size_t)r * 512 + (c0 - 2048);
                        *(u32x4*)dst = w; } } }
    }
};
struct EpiS {
    static constexpr bool PERM = false;
    float* ss;
    __device__ __forceinline__ void operator()(const f32x4 (&acc)[2][2][4][2], const Unit& u, int wr, int wc, int fr, int fq) const {
        const int row0 = u.pm * 256 + wr * 64 + fr, col0 = wc * 32 + 4 * fq;
#pragma unroll
        for (int ai = 0; ai < 2; ++ai)
#pragma unroll
            for (int m = 0; m < 4; ++m) { float* rp = ss + (size_t)(row0 + ai * 128 + m * 16) * 128 + col0;
#pragma unroll
                for (int n = 0; n < 2; ++n) *(f32x4*)(rp + n * 16) = acc[ai][0][m][n]; }
    }
};
struct EpiY {
    static constexpr bool PERM = true;
    const bf16_t* ucat; const float* dvec; bf16_t* zs5;
    __device__ __forceinline__ void operator()(const f32x4 (&acc)[2][2][4][2], const Unit& u, int wr, int wc, int fr, int fq) const {
        const int g = u.pn, crow0 = u.pm * 256 + wr * 64 + fr;
#pragma unroll
        for (int ai = 0; ai < 2; ++ai)
#pragma unroll
            for (int m = 0; m < 4; ++m) { const int crow = crow0 + ai * 128 + m * 16, cr = crow - g * CRG;
                if (cr < CRV) {
#pragma unroll
                    for (int bj = 0; bj < 2; ++bj) { const int n0 = bj * 128 + wc * 32 + 8 * fq, tl = n0 >> 4, cp = n0 & 15;
                        const f32x4 d0 = *(const f32x4*)(dvec + g * 16 + cp), d1 = *(const f32x4*)(dvec + g * 16 + cp + 4);
                        const u32x4 uw = *(const u32x4*)(ucat + (size_t)crow * 384 + n0); f32x4 u0, u1; unpack8(uw, u0, u1);
                        f32x4 y0 = acc[ai][bj][m][0] + d0 * u0, y1 = acc[ai][bj][m][1] + d1 * u1;
#pragma unroll
                        for (int j = 0; j < 4; ++j) { y0[j] = gelu_tanh_f(y0[j]); y1[j] = gelu_tanh_f(y1[j]); }
                        *(u32x4*)(zs5 + (size_t)(cr * 16 + tl) * 512 + g * 16 + cp) = pack8(y0, y1); } }
                asm volatile("" ::: "memory"); }
    }
};
struct EpiGlu {
    static constexpr bool PERM = true;
    const bf16_t* zs5; const float* bglu; bf16_t* mixin;
    __device__ __forceinline__ void operator()(const f32x4 (&acc)[2][2][4][2], const Unit& u, int wr, int wc, int fr, int fq) const {
        const int row0 = u.pm * 256 + wr * 64 + fr;
#pragma unroll
        for (int bj = 0; bj < 2; ++bj) { const int c0 = u.pn * 256 + bj * 128 + wc * 32 + 8 * fq;
            const f32x4 b0 = *(const f32x4*)(bglu + c0), b1 = *(const f32x4*)(bglu + c0 + 4);
#pragma unroll
            for (int ai = 0; ai < 2; ++ai)
#pragma unroll
                for (int m = 0; m < 4; ++m) { const int r = row0 + ai * 128 + m * 16;
                    const u32x4 zw = *(const u32x4*)(zs5 + (size_t)r * 512 + c0); f32x4 z0, z1; unpack8(zw, z0, z1);
                    f32x4 o0, o1;
#pragma unroll
                    for (int j = 0; j < 4; ++j) { o0[j] = z0[j] * sigmoid_f(acc[ai][bj][m][0][j] + b0[j]); o1[j] = z1[j] * sigmoid_f(acc[ai][bj][m][1][j] + b1[j]); }
                    *(u32x4*)(mixin + (size_t)r * 1024 + c0) = pack8(o0, o1); } }
    }
};
struct EpiRes {
    static constexpr bool PERM = false;
    const float* base_p; const float* base_s; bf16_t* xb; float* sumsq;
    __device__ __forceinline__ void operator()(const f32x4 (&acc)[2][2][4][2], const Unit& u, int wr, int wc, int fr, int fq) const {
        const int row0 = u.pm * 256 + wr * 64 + fr, col0 = u.pn * 256 + wc * 32 + 4 * fq;
#pragma unroll
        for (int ai = 0; ai < 2; ++ai)
#pragma unroll
            for (int m = 0; m < 4; ++m) { const int r = row0 + ai * 128 + m * 16; float s = 0.f;
                const float* bp = base_p ? ((r < TP) ? base_p + (size_t)r * 1024 : base_s + (size_t)(r - TP) * 1024) : nullptr;
#pragma unroll
                for (int bj = 0; bj < 2; ++bj)
#pragma unroll
                    for (int n = 0; n < 2; ++n) { const int c = col0 + bj * 128 + n * 16; f32x4 b;
                        if (bp) b = *(const f32x4*)(bp + c);
                        else { const u32x2 bw = *(const u32x2*)(xb + (size_t)r * 1024 + c); b = (f32x4){bflo(bw.x), bfhi(bw.x), bflo(bw.y), bfhi(bw.y)}; }
                        const f32x4 v = b + acc[ai][bj][m][n];
                        u32x2 w; w.x = cvt_pk_bf16(v[0], v[1]); w.y = cvt_pk_bf16(v[2], v[3]); *(u32x2*)(xb + (size_t)r * 1024 + c) = w;
                        s += (v[0] * v[0] + v[1] * v[1]) + (v[2] * v[2] + v[3] * v[3]); }
                s += __shfl_xor(s, 16); s += __shfl_xor(s, 32);
                if (fq == 0) atomicAdd(sumsq + r, s);
                asm volatile("" ::: "memory"); }
    }
};
struct EpiFF {
    static constexpr bool PERM = true;
    const float* sumsq; bf16_t* act;
    __device__ __forceinline__ void operator()(const f32x4 (&acc)[2][2][4][2], const Unit& u, int wr, int wc, int fr, int fq) const {
        const int row0 = u.pm * 256 + wr * 64 + fr, c0 = u.pn * 128 + wc * 32 + 8 * fq;
#pragma unroll
        for (int ai = 0; ai < 2; ++ai)
#pragma unroll
            for (int m = 0; m < 4; ++m) { const int r = row0 + ai * 128 + m * 16; const float rs = rsqrtf(sumsq[r] * (1.0f / 1024.0f) + 1e-6f);
                f32x4 o0, o1;
#pragma unroll
                for (int j = 0; j < 4; ++j) { o0[j] = silu_f(acc[ai][0][m][0][j] * rs) * (acc[ai][1][m][0][j] * rs); o1[j] = silu_f(acc[ai][0][m][1][j] * rs) * (acc[ai][1][m][1][j] * rs); }
                *(u32x4*)(act + (size_t)r * 2816 + c0) = pack8(o0, o1); }
    }
};
struct EpiQKV {
    static constexpr bool PERM = true;
    const float* sumsq; bf16_t* q; bf16_t* kb; bf16_t* vb; float* opk; float* opv; float* osk; float* osv;
    __device__ __forceinline__ void operator()(const f32x4 (&acc)[2][2][4][2], const Unit& u, int wr, int wc, int fr, int fq) const {
        const int row0 = u.pm * 256 + wr * 64 + fr, pn = u.pn;
#pragma unroll
        for (int ai = 0; ai < 2; ++ai)
#pragma unroll
            for (int m = 0; m < 4; ++m) { const int r = row0 + ai * 128 + m * 16; const float rs = rsqrtf(sumsq[r] * (1.0f / 1024.0f) + 1e-6f);
#pragma unroll
                for (int bj = 0; bj < 2; ++bj) { const int cl = bj * 128 + wc * 32 + 8 * fq;
                    if (pn < 4) { const float sc = rs * 0.125f; *(u32x4*)(q + (size_t)r * 1024 + pn * 256 + cl) = pack8(acc[ai][bj][m][0] * sc, acc[ai][bj][m][1] * sc); }
                    else { const f32x4 v0 = acc[ai][bj][m][0] * rs, v1 = acc[ai][bj][m][1] * rs;
                        bf16_t* dst = (pn == 4 ? kb : vb) + (size_t)r * 256 + cl; *(u32x4*)dst = pack8(v0, v1);
                        float* od = nullptr;
                        if (r < TP) { const int t = r & 8191; if (t >= 8064) od = (pn == 4 ? opk : opv) + ((size_t)((r >> 13) * 128 + (t - 8064)) * 256 + cl); }
                        else { const int rr = r - TP; od = (pn == 4 ? osk : osv) + ((size_t)((rr >> 4) * 128 + 112 + (rr & 15)) * 256 + cl); }
                        if (od) { *(f32x4*)od = v0; *(f32x4*)(od + 4) = v1; } } } }
    }
};

struct WDesc { const float* src; int ld, K, N, rowoff, mode; bf16_t* dst; const float* fold; };
__device__ __forceinline__ void wt_tile(const WDesc& d, int tile, LAS float* tl) {
    const int ntn = (d.N + 63) >> 6, kt = tile / ntn, ntile = tile - kt * ntn, k0 = kt * 64, n0 = ntile * 64, tid = ltid();
#pragma unroll
    for (int ps = 0; ps < 8; ++ps) { const int k = ps * 8 + (tid >> 6), n = tid & 63; float v = 0.f;
        if (n0 + n < d.N) v = d.src[(size_t)(k0 + k) * d.ld + n0 + n];
        if (d.fold) v *= d.fold[k0 + k];
        tl[k * 65 + n] = v; }
    __syncthreads();
#pragma unroll
    for (int ps = 0; ps < 8; ++ps) { const int n = ps * 8 + (tid >> 6), k = tid & 63, gn = n0 + n;
        if (gn < d.N) { const int drow = (d.mode ? ((gn >> 7) * 256 + (gn & 127)) : gn) + d.rowoff; d.dst[(size_t)drow * d.K + k0 + k] = f2bf(tl[k * 65 + n]); } }
    __syncthreads();
}

__device__ __forceinline__ void s5_gen_group(KPR p, int g, LAS unsigned char* lds) {
    LAS float* LP = (LAS float*)lds;
    LAS float* BB = LP + 17 * 64 * 2;
    LAS float* KL = BB + 64 * 16 * 2;
    LAS float* CF = KL + 4096;
    const int tid = ltid();
    const float* lam_re = p.in[12]; const float* lam_im = p.in[13]; const float* log_dt = p.in[14];
    const float* b_re = p.in[15]; const float* b_im = p.in[16]; const float* c_re = p.in[17]; const float* c_im = p.in[18];
    bf16_t* kgt = (bf16_t*)(p.ws + WS_KGT) + (size_t)g * 256 * 384; bf16_t* ht = (bf16_t*)(p.ws + WS_HT) + (size_t)g * 256 * 256; float* lp16 = (float*)(p.ws + WS_LP16) + g * 128;
    if (tid < 64) { const int pp = tid; const double dt = exp((double)log_dt[g]); const double lr = (double)lam_re[g * 64 + pp], li = (double)lam_im[g * 64 + pp];
        for (int k = 0; k <= 16; ++k) { const double mg = exp(k * lr * dt), an = k * li * dt; const double cr = mg * cos(an), ci = mg * sin(an);
            LP[(k * 64 + pp) * 2] = (float)cr; LP[(k * 64 + pp) * 2 + 1] = (float)ci;
            if (k == 16) { lp16[pp * 2] = (float)cr; lp16[pp * 2 + 1] = (float)ci; }
            if (k == 1) { const double nr = cr - 1.0, ni = ci, dn = lr * lr + li * li; CF[pp * 2] = (float)((nr * lr + ni * li) / dn); CF[pp * 2 + 1] = (float)((ni * lr - nr * li) / dn); } } }
    __syncthreads();
    for (int e = tid; e < 1024; e += 512) { const int pp = e >> 4; const float br = b_re[(size_t)g * 1024 + e], bi = b_im[(size_t)g * 1024 + e], fr_ = CF[pp * 2], fi_ = CF[pp * 2 + 1];
        BB[e * 2] = fr_ * br - fi_ * bi; BB[e * 2 + 1] = fr_ * bi + fi_ * br; }
    __syncthreads();
    for (int e = tid; e < 4096; e += 512) { const int k = e >> 8, c = (e >> 4) & 15, cp = e & 15; float s = 0.f;
        for (int pp = 0; pp < 64; ++pp) { const float cr = c_re[(size_t)g * 1024 + c * 64 + pp], ci = c_im[(size_t)g * 1024 + c * 64 + pp];
            const float lr = LP[(k * 64 + pp) * 2], li = LP[(k * 64 + pp) * 2 + 1], br = BB[(pp * 16 + cp) * 2], bi = BB[(pp * 16 + cp) * 2 + 1];
            const float mr = lr * br - li * bi, mi = lr * bi + li * br; s += cr * mr - ci * mi; }
        KL[e] = s; }
    __syncthreads();
    for (int e = tid; e < 256 * 384; e += 512) { const int n = e / 384, k = e - n * 384, t = n >> 4, c = n & 15; float v;
        if (k < 256) { const int s = k >> 4, cp = k & 15; v = (s <= t) ? KL[((t - s) * 16 + c) * 16 + cp] : 0.f; }
        else { const int pp = (k - 256) & 63; const float cr = c_re[(size_t)g * 1024 + c * 64 + pp], ci = c_im[(size_t)g * 1024 + c * 64 + pp];
            const float lr = LP[((t + 1) * 64 + pp) * 2], li = LP[((t + 1) * 64 + pp) * 2 + 1];
            v = (k < 320) ? (cr * lr - ci * li) : -(cr * li + ci * lr); }
        kgt[e] = f2bf(v); }
    for (int e = tid; e < 256 * 256; e += 512) { const int n = e >> 8, k = e & 255; float v = 0.f;
        if (n < 128) { const int pp = n & 63, s = k >> 4, cp = k & 15; const float lr = LP[((15 - s) * 64 + pp) * 2], li = LP[((15 - s) * 64 + pp) * 2 + 1], br = BB[(pp * 16 + cp) * 2], bi = BB[(pp * 16 + cp) * 2 + 1];
            v = (n < 64) ? (lr * br - li * bi) : (lr * bi + li * br); }
        ht[e] = f2bf(v); }
    __syncthreads();
}

__device__ __forceinline__ void phase0(KPR p, LAS unsigned char* lds) {
    const int tid = ltid(), G = gridDim.x, bx = blockIdx.x, lane = tid & 63, wid = tid >> 6;
    for (int g = bx; g < 32; g += G) s5_gen_group(p, g, lds);
    {
        const float* nf = p.in[9]; const float* nm = p.in[8];
        const int shift = (bx + G - (32 % G)) % G;
        for (int it = shift; it < 5840; it += G) {
            int t = it; WDesc d;
            if (t < 656) d = WDesc{p.in[11], 2568, 1024, 2568, 0, 0, (bf16_t*)(p.ws + WS_W1T), nullptr};
            else if ((t -= 656) < 64) d = WDesc{p.in[20], 512, 512, 512, 0, 0, (bf16_t*)(p.ws + WS_WGLU), nullptr};
            else if ((t -= 64) < 256) d = WDesc{p.in[26], 1024, 1024, 1024, 0, 0, (bf16_t*)(p.ws + WS_WOUT), nullptr};
            else if ((t -= 256) < 704) d = WDesc{p.in[32], 2816, 1024, 2816, 0, 1, (bf16_t*)(p.ws + WS_WF1_0), nf};
            else if ((t -= 704) < 704) d = WDesc{p.in[33], 2816, 1024, 2816, 128, 1, (bf16_t*)(p.ws + WS_WF1_0), nf};
            else if ((t -= 704) < 704) d = WDesc{p.in[34], 1024, 2816, 1024, 0, 0, (bf16_t*)(p.ws + WS_WFD_0), nullptr};
            else if ((t -= 704) < 256) d = WDesc{p.in[27], 1024, 1024, 1024, 0, 0, (bf16_t*)(p.ws + WS_WQKV), nm + 1024};
            else if ((t -= 256) < 64) d = WDesc{p.in[28], 256, 1024, 256, 1024, 0, (bf16_t*)(p.ws + WS_WQKV), nm + 1024};
            else if ((t -= 64) < 64) d = WDesc{p.in[29], 256, 1024, 256, 1280, 0, (bf16_t*)(p.ws + WS_WQKV), nm + 1024};
            else if ((t -= 64) < 256) d = WDesc{p.in[31], 1024, 1024, 1024, 0, 0, (bf16_t*)(p.ws + WS_WO), nullptr};
            else if ((t -= 256) < 704) d = WDesc{p.in[32] + (size_t)1024 * 2816, 2816, 1024, 2816, 0, 1, (bf16_t*)(p.ws + WS_WF1_1), nf + 1024};
            else if ((t -= 704) < 704) d = WDesc{p.in[33] + (size_t)1024 * 2816, 2816, 1024, 2816, 128, 1, (bf16_t*)(p.ws + WS_WF1_1), nf + 1024};
            else { t -= 704; d = WDesc{p.in[34] + (size_t)2816 * 1024, 1024, 2816, 1024, 0, 0, (bf16_t*)(p.ws + WS_WFD_1), nullptr}; }
            wt_tile(d, t, (LAS float*)lds);
        }
    }
    {
        bf16_t* h0 = (bf16_t*)(p.ws + WS_R1); const float* nw = p.in[8];
        f32x4 wv[4];
#pragma unroll
        for (int i = 0; i < 4; ++i) wv[i] = *(const f32x4*)(nw + lane * 4 + i * 256);
        for (int r = bx * 8 + wid; r < T; r += G * 8) {
            const float* xp = (r < TP) ? p.in[0] + (size_t)r * 1024 : p.in[1] + (size_t)(r - TP) * 1024;
            f32x4 v[4]; float s = 0.f;
#pragma unroll
            for (int i = 0; i < 4; ++i) { v[i] = *(const f32x4*)(xp + lane * 4 + i * 256); s += (v[i][0] * v[i][0] + v[i][1] * v[i][1]) + (v[i][2] * v[i][2] + v[i][3] * v[i][3]); }
#pragma unroll
            for (int o = 32; o >= 1; o >>= 1) s += __shfl_xor(s, o);
            const float rs = rsqrtf(s * (1.0f / 1024.0f) + 1e-6f);
#pragma unroll
            for (int i = 0; i < 4; ++i) { const f32x4 y = v[i] * rs * wv[i]; u32x2 w; w.x = cvt_pk_bf16(y[0], y[1]); w.y = cvt_pk_bf16(y[2], y[3]); *(u32x2*)(h0 + (size_t)r * 1024 + lane * 4 + i * 256) = w; }
        }
    }
    {
        const size_t gt = (size_t)bx * 512 + tid, gs = (size_t)G * 512;
        float* sq = (float*)(p.ws + WS_SUMSQ); for (size_t i = gt; i < (size_t)4 * T; i += gs) sq[i] = 0.f;
        unsigned* wpad = (unsigned*)(p.ws + WS_W1T + (size_t)2568 * 1024 * 2); for (size_t i = gt; i < (size_t)248 * 512; i += gs) wpad[i] = 0u;
        const float* ck = p.in[6]; const float* cv = p.in[7]; float* ok = p.out + O_SK; float* ov = p.out + O_SV;
        for (size_t i = gt; i < (size_t)16 * 112 * 256; i += gs) { const size_t b = i / (112 * 256), rem = i - b * (112 * 256); ok[b * 32768 + rem] = ck[b * 32768 + 4096 + rem]; ov[b * 32768 + rem] = cv[b * 32768 + 4096 + rem]; }
    }
}

__device__ __forceinline__ void gdn_prep_item(KPR p, int ch, LAS unsigned char* lds) {
    const int tid = ltid(), lane = tid & 63, w = tid >> 6, fr = lane & 15, fq = lane >> 4;
    const bool samp = ch >= 4096; int b, h, n; int rowbase;
    if (!samp) { b = ch >> 9; h = (ch >> 7) & 3; n = ch & 127; rowbase = b * 8192 + n * 64; } else { const int s = ch - 4096; b = s >> 2; h = s & 3; n = 0; rowbase = TP + b * 16; }
    const int ntok = samp ? 16 : 64;
    LAS bf16_t* qn = (LAS bf16_t*)lds; LAS bf16_t* kn = qn + 64 * 136; LAS bf16_t* vv = kn + 64 * 136;
    LAS float* Am = (LAS float*)(lds + 3 * 17408); LAS float* gcs = Am + 4096; LAS float* betas = gcs + 64; LAS float* egc = betas + 64;
    const bf16_t* qkvraw = (const bf16_t*)(p.ws + WS_R2); const float* gates = (const float*)(p.ws + WS_GATES);
    unsigned char* cb = p.ws + WS_R3 + (size_t)ch * GDN_CH_BYTES;
    bf16_t* o_uT = (bf16_t*)cb; bf16_t* o_w = (bf16_t*)(cb + 16384); bf16_t* o_qd = (bf16_t*)(cb + 32768); bf16_t* o_kdT = (bf16_t*)(cb + 49152); bf16_t* o_attn = (bf16_t*)(cb + 65536);
#ifndef NO_S1
    {
        const int tok = tid >> 3, seg = tid & 7; const float* cw = p.in[22]; const float* cst = p.in[5];
#pragma unroll
        for (int part = 0; part < 3; ++part) {
            const int cbase = part * 512 + h * 128 + seg * 16; float y[16];
#pragma unroll
            for (int i = 0; i < 16; ++i) y[i] = 0.f;
            if (tok < ntok) {
#pragma unroll
                for (int j = 0; j < 4; ++j) { const int ti = tok - 3 + j; const int tabs = n * 64 + ti; float xv[16];
                    if (tabs >= 0) { const u32x4 a0 = *(const u32x4*)(qkvraw + (size_t)(rowbase + ti) * 1536 + cbase), a1 = *(const u32x4*)(qkvraw + (size_t)(rowbase + ti) * 1536 + cbase + 8);
                        f32x4 t0, t1, t2, t3; unpack8(a0, t0, t1); unpack8(a1, t2, t3);
#pragma unroll
                        for (int i = 0; i < 4; ++i) { xv[i] = t0[i]; xv[4 + i] = t1[i]; xv[8 + i] = t2[i]; xv[12 + i] = t3[i]; } }
                    else if (samp) { const float* sp = cst + (size_t)(b * 3 + 3 + tabs) * 1536 + cbase;
#pragma unroll
                        for (int i = 0; i < 16; ++i) xv[i] = sp[i]; }
                    else {
#pragma unroll
                        for (int i = 0; i < 16; ++i) xv[i] = 0.f; }
#pragma unroll
                    for (int i = 0; i < 16; ++i) y[i] += xv[i] * cw[j * 1536 + cbase + i]; }
#pragma unroll
                for (int i = 0; i < 16; ++i) y[i] = silu_f(y[i]);
            }
            float sc = 1.0f;
            if (part < 2) { float ss = 0.f;
#pragma unroll
                for (int i = 0; i < 16; ++i) ss += y[i] * y[i];
                ss += __shfl_xor(ss, 1); ss += __shfl_xor(ss, 2); ss += __shfl_xor(ss, 4);
                sc = rsqrtf(ss + 1e-6f); if (part == 0) sc *= 0.08838834764831845f; }
            LAS bf16_t* dst = (part == 0 ? qn : (part == 1 ? kn : vv)) + tok * 136 + seg * 16;
            u32x4 w0, w1; w0.x = cvt_pk_bf16(y[0] * sc, y[1] * sc); w0.y = cvt_pk_bf16(y[2] * sc, y[3] * sc); w0.z = cvt_pk_bf16(y[4] * sc, y[5] * sc); w0.w = cvt_pk_bf16(y[6] * sc, y[7] * sc);
            w1.x = cvt_pk_bf16(y[8] * sc, y[9] * sc); w1.y = cvt_pk_bf16(y[10] * sc, y[11] * sc); w1.z = cvt_pk_bf16(y[12] * sc, y[13] * sc); w1.w = cvt_pk_bf16(y[14] * sc, y[15] * sc);
            *(LAS u32x4*)dst = w0; *(LAS u32x4*)(dst + 8) = w1;
        }
    }
#endif
    if (tid < 64) { float gg = 0.f, be = 0.f;
        if (tid < ntok) { const float a = gates[(size_t)(rowbase + tid) * 8 + 4 + h], bb = gates[(size_t)(rowbase + tid) * 8 + h];
            const float xs = a + p.in[24][h]; const float sp = xs > 20.f ? xs : log1pf(expf(xs)); gg = -expf(p.in[23][h]) * sp; be = 1.0f / (1.0f + expf(-bb)); }
        float gc = gg;
#pragma unroll
        for (int o = 1; o < 64; o <<= 1) { const float v = __shfl_up(gc, o); if (lane >= o) gc += v; }
        gcs[tid] = gc; betas[tid] = be; egc[tid] = expf(gc);
        if (tid == 63) ((float*)(p.ws + WS_GL))[ch] = expf(gc); }
    __syncthreads();
#ifndef NO_S3
    {
        const int rt = w & 3, kind = w >> 2; LAS bf16_t* am = kind ? qn : kn;
        bf16x8 af[4];
#pragma unroll
        for (int ks = 0; ks < 4; ++ks) af[ks] = *(const LAS bf16x8*)(am + (16 * rt + fr) * 136 + 32 * ks + 8 * fq);
#pragma unroll
        for (int ct = 0; ct < 4; ++ct) {
            f32x4 acc = (f32x4){0.f, 0.f, 0.f, 0.f};
            if (ct <= rt) {
#pragma unroll
                for (int ks = 0; ks < 4; ++ks) { const bf16x8 bfr = *(const LAS bf16x8*)(kn + (16 * ct + fr) * 136 + 32 * ks + 8 * fq); acc = __builtin_amdgcn_mfma_f32_16x16x32_bf16(af[ks], bfr, acc, 0, 0, 0); } }
            const int col = 16 * ct + fr; const float gcc = gcs[col];
#pragma unroll
            for (int j = 0; j < 4; ++j) { const int row = 16 * rt + 4 * fq + j; const float dec = __expf(fminf(gcs[row] - gcc, 0.f));
                if (kind == 0) Am[row * 64 + col] = (row > col) ? betas[row] * acc[j] * dec : 0.f;
                else o_attn[row * 64 + col] = f2bf((row >= col) ? acc[j] * dec : 0.f); }
        }
    }
#endif
    __syncthreads();
#ifndef NO_S4
    int vz = 0; asm volatile("" : "+v"(vz));
    if (tid < 256) {
        const int c = tid; const bool isu = c < 128; const int cc = isu ? c : c - 128; LAS bf16_t* srcm = isu ? vv : kn;
        LAS float* AmV = Am + vz; LAS float* beV = betas + vz; LAS float* egV = egc + vz;
        float X[64];
#pragma unroll
        for (int i = 0; i < 64; ++i) {
            float r = bf2f(srcm[i * 136 + cc]) * beV[i]; if (!isu) r *= egV[i];
            float pa[4] = {0.f, 0.f, 0.f, 0.f};
#pragma unroll
            for (int j4 = 0; j4 < (i + 3) / 4; ++j4) { const f32x4 a4 = *(const LAS f32x4*)(AmV + i * 64 + j4 * 4);
#pragma unroll
                for (int jj = 0; jj < 4; ++jj) { if (j4 * 4 + jj < i) pa[jj] += a4[jj] * X[j4 * 4 + jj]; } }
            r -= (pa[0] + pa[1]) + (pa[2] + pa[3]);
            asm volatile("" : "+v"(r) :: "memory"); X[i] = r; }
        if (isu) {
#pragma unroll
            for (int i8 = 0; i8 < 8; ++i8) { u32x4 wv; wv.x = cvt_pk_bf16(X[i8 * 8], X[i8 * 8 + 1]); wv.y = cvt_pk_bf16(X[i8 * 8 + 2], X[i8 * 8 + 3]); wv.z = cvt_pk_bf16(X[i8 * 8 + 4], X[i8 * 8 + 5]); wv.w = cvt_pk_bf16(X[i8 * 8 + 6], X[i8 * 8 + 7]);
                *(u32x4*)(o_uT + cc * 64 + i8 * 8) = wv; } }
        else {
#pragma unroll
            for (int i = 0; i < 64; ++i) o_w[i * 128 + cc] = f2bf(X[i]); }
    } else {
        const int c = tid - 256;
        LAS float* gcV = gcs + vz; LAS float* egV = egc + vz;
        if (c < 128) { const float gl_ = gcV[63];
#pragma unroll
            for (int i8 = 0; i8 < 8; ++i8) { float v[8];
#pragma unroll
                for (int e = 0; e < 8; ++e) { const int tk = i8 * 8 + e; v[e] = bf2f(kn[tk * 136 + c]) * __expf(gl_ - gcV[tk]); }
                u32x4 wv; wv.x = cvt_pk_bf16(v[0], v[1]); wv.y = cvt_pk_bf16(v[2], v[3]); wv.z = cvt_pk_bf16(v[4], v[5]); wv.w = cvt_pk_bf16(v[6], v[7]);
                *(u32x4*)(o_kdT + c * 64 + i8 * 8) = wv; } }
        else { const int cc = c - 128;
#pragma unroll 8
            for (int i = 0; i < 64; ++i) o_qd[i * 128 + cc] = f2bf(bf2f(qn[i * 136 + cc]) * egV[i]); }
    }
#endif
    __syncthreads();
}

struct GFrag { bf16x8 Aw[4], Aq[4], Aa[2], Ak[2]; bf16x4 u[2]; float gl; };
__device__ __forceinline__ void gdn_load(GFrag& f, const unsigned char* ws, int ch, int w, int sl, int fr, int fq) {
    const unsigned char* cb = ws + WS_R3 + (size_t)ch * GDN_CH_BYTES;
    const bf16_t* uT = (const bf16_t*)cb; const bf16_t* wm = (const bf16_t*)(cb + 16384); const bf16_t* qd = (const bf16_t*)(cb + 32768); const bf16_t* kdT = (const bf16_t*)(cb + 49152); const bf16_t* at = (const bf16_t*)(cb + 65536);
    if (w < 4) {
#pragma unroll
        for (int ks = 0; ks < 4; ++ks) { f.Aw[ks] = *(const bf16x8*)(wm + (16 * w + fr) * 128 + 32 * ks + 8 * fq); f.Aq[ks] = *(const bf16x8*)(qd + (16 * w + fr) * 128 + 32 * ks + 8 * fq); }
#pragma unroll
        for (int k2 = 0; k2 < 2; ++k2) f.Aa[k2] = *(const bf16x8*)(at + (16 * w + fr) * 64 + 32 * k2 + 8 * fq);
#pragma unroll
        for (int dt = 0; dt < 2; ++dt) f.u[dt] = *(const bf16x4*)(uT + (sl * 32 + 16 * dt + fr) * 64 + 16 * w + 4 * fq);
    }
#pragma unroll
    for (int k2 = 0; k2 < 2; ++k2) f.Ak[k2] = *(const bf16x8*)(kdT + (16 * w + fr) * 64 + 32 * k2 + 8 * fq);
    f.gl = ((const float*)(ws + WS_GL))[ch];
}
__device__ __forceinline__ void gdn_step(const GFrag& cur, f32x4 (&accS)[2], LAS unsigned char* ST, LAS unsigned char* VN, bf16_t* gorow, int ntok, int w, int fr, int fq) {
    f32x4 accO[2];
    if (w < 4) {
        f32x4 accV[2];
#pragma unroll
        for (int dt = 0; dt < 2; ++dt) { accV[dt] = (f32x4){0.f, 0.f, 0.f, 0.f}; accO[dt] = (f32x4){0.f, 0.f, 0.f, 0.f}; }
#pragma unroll
        for (int ks = 0; ks < 4; ++ks)
#pragma unroll
            for (int dt = 0; dt < 2; ++dt) { const bf16x8 bs = *(const LAS bf16x8*)(ST + (16 * dt + fr) * 272 + (32 * ks + 8 * fq) * 2);
                accV[dt] = __builtin_amdgcn_mfma_f32_16x16x32_bf16(cur.Aw[ks], bs, accV[dt], 0, 0, 0); accO[dt] = __builtin_amdgcn_mfma_f32_16x16x32_bf16(cur.Aq[ks], bs, accO[dt], 0, 0, 0); }
#pragma unroll
        for (int dt = 0; dt < 2; ++dt) { const float v0 = bf2f((bf16_t)cur.u[dt][0]) - accV[dt][0], v1 = bf2f((bf16_t)cur.u[dt][1]) - accV[dt][1], v2 = bf2f((bf16_t)cur.u[dt][2]) - accV[dt][2], v3 = bf2f((bf16_t)cur.u[dt][3]) - accV[dt][3];
            u32x2 wv; wv.x = cvt_pk_bf16(v0, v1); wv.y = cvt_pk_bf16(v2, v3); *(LAS u32x2*)(VN + (16 * dt + fr) * 144 + (16 * w + 4 * fq) * 2) = wv; }
    }
    LDS_BARRIER();
    if (w < 4) {
#pragma unroll
        for (int dt = 0; dt < 2; ++dt) {
#pragma unroll
            for (int k2 = 0; k2 < 2; ++k2) { const bf16x8 bv = *(const LAS bf16x8*)(VN + (16 * dt + fr) * 144 + (32 * k2 + 8 * fq) * 2); accO[dt] = __builtin_amdgcn_mfma_f32_16x16x32_bf16(cur.Aa[k2], bv, accO[dt], 0, 0, 0); }
#pragma unroll
            for (int j = 0; j < 4; ++j) { const int tok = 16 * w + 4 * fq + j; if (tok < ntok) gorow[(size_t)tok * 512 + 16 * dt] = f2bf(accO[dt][j]); } }
    }
#pragma unroll
    for (int d2 = 0; d2 < 2; ++d2) { accS[d2] = accS[d2] * cur.gl;
#pragma unroll
        for (int k2 = 0; k2 < 2; ++k2) { const bf16x8 bv = *(const LAS bf16x8*)(VN + (16 * d2 + fr) * 144 + (32 * k2 + 8 * fq) * 2); accS[d2] = __builtin_amdgcn_mfma_f32_16x16x32_bf16(cur.Ak[k2], bv, accS[d2], 0, 0, 0); }
        u32x2 wv; wv.x = cvt_pk_bf16(accS[d2][0], accS[d2][1]); wv.y = cvt_pk_bf16(accS[d2][2], accS[d2][3]);
        *(LAS u32x2*)(ST + (16 * d2 + fr) * 272 + (16 * w + 4 * fq) * 2) = wv; }
    LDS_BARRIER();
}
__device__ __forceinline__ void gdn_chain_item(KPR p, int item, LAS unsigned char* lds) {
    const int tid = ltid(), lane = tid & 63, w = __builtin_amdgcn_readfirstlane(tid >> 6), fr = lane & 15, fq = lane >> 4;
    int bh, sl, nsteps, ch0, rowbase, h, ntok; float* sout; const float* sin = nullptr;
    if (item < 128) { bh = (item & 7) + 8 * (item >> 5); sl = (item >> 3) & 3; nsteps = 128;
        ch0 = bh * 128; rowbase = (bh >> 2) * 8192; h = bh & 3; ntok = 64; sout = p.out + O_PGDN + (size_t)bh * 16384; }
    else { const int j = item - 128; bh = j >> 2; sl = j & 3; nsteps = 1; ch0 = 4096 + bh; rowbase = TP + (bh >> 2) * 16; h = bh & 3; ntok = 16; sout = p.out + O_SGDN + (size_t)bh * 16384; sin = p.in[4] + (size_t)bh * 16384; }
    LAS unsigned char* ST = lds; LAS unsigned char* VN = lds + 32 * 272;
    bf16_t* go = (bf16_t*)(p.ws + WS_R4) + (size_t)rowbase * 512 + h * 128 + sl * 32 + fr;
    const unsigned char* ws = p.ws; const int last = nsteps - 1;
    f32x4 accS[2];
#pragma unroll
    for (int d2 = 0; d2 < 2; ++d2) {
#pragma unroll
        for (int j = 0; j < 4; ++j) accS[d2][j] = sin ? sin[(size_t)(16 * w + 4 * fq + j) * 128 + sl * 32 + 16 * d2 + fr] : 0.f;
        u32x2 wv; wv.x = cvt_pk_bf16(accS[d2][0], accS[d2][1]); wv.y = cvt_pk_bf16(accS[d2][2], accS[d2][3]);
        *(LAS u32x2*)(ST + (16 * d2 + fr) * 272 + (16 * w + 4 * fq) * 2) = wv; }
    GFrag f0, f1, f2;
    gdn_load(f0, ws, ch0, w, sl, fr, fq); gdn_load(f1, ws, ch0 + (1 < last ? 1 : last), w, sl, fr, fq);
    LDS_BARRIER();
#define CLAMPN(x) ((x) < last ? (x) : last)
    for (int n = 0; n < nsteps; n += 3) {
        gdn_load(f2, ws, ch0 + CLAMPN(n + 2), w, sl, fr, fq); __builtin_amdgcn_sched_barrier(0);
        gdn_step(f0, accS, ST, VN, go + (size_t)n * 64 * 512, ntok, w, fr, fq);
        if (n + 1 < nsteps) { gdn_load(f0, ws, ch0 + CLAMPN(n + 3), w, sl, fr, fq); __builtin_amdgcn_sched_barrier(0);
            gdn_step(f1, accS, ST, VN, go + (size_t)(n + 1) * 64 * 512, ntok, w, fr, fq); }
        if (n + 2 < nsteps) { gdn_load(f1, ws, ch0 + CLAMPN(n + 4), w, sl, fr, fq); __builtin_amdgcn_sched_barrier(0);
            gdn_step(f2, accS, ST, VN, go + (size_t)(n + 2) * 64 * 512, ntok, w, fr, fq); }
    }
#undef CLAMPN
#pragma unroll
    for (int d2 = 0; d2 < 2; ++d2)
#pragma unroll
        for (int j = 0; j < 4; ++j) sout[(size_t)(16 * w + 4 * fq + j) * 128 + sl * 32 + 16 * d2 + fr] = accS[d2][j];
    __syncthreads();
}

__device__ __forceinline__ void s5_scan_prompt(KPR p, int item) {
    const int idx = item * 512 + ltid(), pp = idx & 63, g = (idx >> 6) & 31, b = idx >> 11;
    const float* ss = (const float*)(p.ws + WS_R1) + ((size_t)g * CRG + b * 512) * 128; bf16_t* uc = (bf16_t*)(p.ws + WS_R5) + ((size_t)g * CRG + b * 512) * 384 + 256;
    const float* lp = (const float*)(p.ws + WS_LP16) + g * 128 + pp * 2; const float lr = lp[0], li = lp[1];
    float xr = 0.f, xi = 0.f;
    float sr[8], si[8], nr[8], ni[8];
#pragma unroll
    for (int k = 0; k < 8; ++k) { sr[k] = ss[(size_t)k * 128 + pp]; si[k] = ss[(size_t)k * 128 + 64 + pp]; }
    for (int n0 = 0; n0 < 512; n0 += 8) {
        const int nn = (n0 + 8 < 512) ? n0 + 8 : n0;
#pragma unroll
        for (int k = 0; k < 8; ++k) { nr[k] = ss[(size_t)(nn + k) * 128 + pp]; ni[k] = ss[(size_t)(nn + k) * 128 + 64 + pp]; }
#pragma unroll
        for (int k = 0; k < 8; ++k) { uc[(size_t)(n0 + k) * 384 + pp] = f2bf(xr); uc[(size_t)(n0 + k) * 384 + 64 + pp] = f2bf(xi);
            const float tr = lr * xr - li * xi + sr[k], ti = lr * xi + li * xr + si[k]; xr = tr; xi = ti; }
#pragma unroll
        for (int k = 0; k < 8; ++k) { sr[k] = nr[k]; si[k] = ni[k]; }
    }
    p.out[O_PS5RE + (size_t)(b * 32 + g) * 64 + pp] = xr; p.out[O_PS5IM + (size_t)(b * 32 + g) * 64 + pp] = xi;
}
__device__ __forceinline__ void s5_scan_sample(KPR p, int item) {
    const int idx = item * 512 + threadIdx.x, pp = idx & 63, g = (idx >> 6) & 31, b = idx >> 11;
    const size_t row = (size_t)g * CRG + 4096 + b;
    const float* ss = (const float*)(p.ws + WS_R1) + row * 128; bf16_t* uc = (bf16_t*)(p.ws + WS_R5) + row * 384 + 256;
    const float* lp = (const float*)(p.ws + WS_LP16) + g * 128 + pp * 2; const float lr = lp[0], li = lp[1];
    const float xr = p.in[2][(size_t)(b * 32 + g) * 64 + pp], xi = p.in[3][(size_t)(b * 32 + g) * 64 + pp];
    uc[pp] = f2bf(xr); uc[64 + pp] = f2bf(xi);
    p.out[O_SS5RE + (size_t)(b * 32 + g) * 64 + pp] = lr * xr - li * xi + ss[pp]; p.out[O_SS5IM + (size_t)(b * 32 + g) * 64 + pp] = lr * xi + li * xr + ss[64 + pp];
}

__device__ __forceinline__ void attn_item(KPR p, int item, LAS unsigned char* lds) {
    const int tid = ltid(), lane = tid & 63, w = __builtin_amdgcn_readfirstlane(tid >> 6), fr = lane & 15, fq = lane >> 4;
    const bf16_t* Q = (const bf16_t*)(p.ws + WS_R1); const bf16_t* KB = (const bf16_t*)(p.ws + WS_R5); const bf16_t* VB = KB + (size_t)T * 256; bf16_t* AO = (bf16_t*)(p.ws + WS_R2);
    LAS unsigned char* Ks = lds; LAS unsigned char* Vt = lds + 192 * 144;
    int kvh, qrow0, nq, nkt, nvalid; const bool samp = item >= 4096;
    if (!samp) { kvh = item & 3; const int c = (item >> 2) & 127, b = item >> 9; const int c0 = c >= 2 ? c - 2 : 0; qrow0 = b * 8192 + c * 64; nq = 64; nvalid = (c - c0 + 1) * 64; nkt = nvalid >> 4;
        const int krow0 = b * 8192 + c0 * 64;
        for (int e = tid; e < nvalid * 8; e += 512) { const int row = e >> 3, pc = e & 7;
            const u32x4 kw = *(const u32x4*)(KB + (size_t)(krow0 + row) * 256 + kvh * 64 + pc * 8); *(LAS u32x4*)(Ks + row * 144 + pc * 16) = kw;
            const u32x4 vw = *(const u32x4*)(VB + (size_t)(krow0 + row) * 256 + kvh * 64 + pc * 8);
            const unsigned vs[4] = {vw.x, vw.y, vw.z, vw.w};
#pragma unroll
            for (int jj = 0; jj < 4; ++jj) { *(LAS bf16_t*)(Vt + (pc * 8 + 2 * jj) * 400 + row * 2) = (bf16_t)(vs[jj] & 0xffffu); *(LAS bf16_t*)(Vt + (pc * 8 + 2 * jj + 1) * 400 + row * 2) = (bf16_t)(vs[jj] >> 16); } } }
    else { const int j = item - 4096; kvh = j & 3; const int b = j >> 2; qrow0 = TP + b * 16; nq = 16; nvalid = 144; nkt = 10;
        const float* ck = p.in[6]; const float* cv = p.in[7];
        for (int e = tid; e < 160 * 8; e += 512) { const int row = e >> 3, pc = e & 7; u32x4 kw = (u32x4){0u, 0u, 0u, 0u}, vw = (u32x4){0u, 0u, 0u, 0u};
            if (row < 128) { const float* kp = ck + ((size_t)(b * 128 + row) * 4 + kvh) * 64 + pc * 8; const float* vp = cv + ((size_t)(b * 128 + row) * 4 + kvh) * 64 + pc * 8;
                kw = pack8(*(const f32x4*)kp, *(const f32x4*)(kp + 4)); vw = pack8(*(const f32x4*)vp, *(const f32x4*)(vp + 4)); }
            else if (row < 144) { kw = *(const u32x4*)(KB + (size_t)(qrow0 + row - 128) * 256 + kvh * 64 + pc * 8); vw = *(const u32x4*)(VB + (size_t)(qrow0 + row - 128) * 256 + kvh * 64 + pc * 8); }
            *(LAS u32x4*)(Ks + row * 144 + pc * 16) = kw;
            const unsigned vs[4] = {vw.x, vw.y, vw.z, vw.w};
#pragma unroll
            for (int jj = 0; jj < 4; ++jj) { *(LAS bf16_t*)(Vt + (pc * 8 + 2 * jj) * 400 + row * 2) = (bf16_t)(vs[jj] & 0xffffu); *(LAS bf16_t*)(Vt + (pc * 8 + 2 * jj + 1) * 400 + row * 2) = (bf16_t)(vs[jj] >> 16); } } }
    const int hg = w >> 1, th = w & 1, head = kvh * 4 + hg;
    bf16x8 qf[2][2];
#pragma unroll
    for (int qt = 0; qt < 2; ++qt)
#pragma unroll
        for (int ks = 0; ks < 2; ++ks) { const int tok = 32 * th + 16 * qt + fr; qf[qt][ks] = (bf16x8){0, 0, 0, 0, 0, 0, 0, 0};
            if (tok < nq) qf[qt][ks] = *(const bf16x8*)(Q + (size_t)(qrow0 + tok) * 1024 + head * 64 + 32 * ks + 8 * fq); }
    const float sink = p.in[30][head];
    __syncthreads();
    f32x4 sc[12][2];
#pragma unroll
    for (int kt = 0; kt < 12; ++kt) {
#pragma unroll
        for (int qt = 0; qt < 2; ++qt) sc[kt][qt] = (f32x4){0.f, 0.f, 0.f, 0.f};
        if (kt < nkt) {
#pragma unroll
            for (int ks = 0; ks < 2; ++ks) { const bf16x8 kf = *(const LAS bf16x8*)(Ks + (16 * kt + fr) * 144 + (32 * ks + 8 * fq) * 2);
#pragma unroll
                for (int qt = 0; qt < 2; ++qt) sc[kt][qt] = __builtin_amdgcn_mfma_f32_16x16x32_bf16(kf, qf[qt][ks], sc[kt][qt], 0, 0, 0); } }
    }
    float mx[2] = {sink, sink};
#pragma unroll
    for (int kt = 0; kt < 12; ++kt)
#pragma unroll
        for (int qt = 0; qt < 2; ++qt)
#pragma unroll
            for (int j = 0; j < 4; ++j) { const bool ok = (kt < nkt) && (16 * kt + 4 * fq + j < nvalid); if (!ok) sc[kt][qt][j] = -1e30f; mx[qt] = fmaxf(mx[qt], sc[kt][qt][j]); }
    float sm[2];
#pragma unroll
    for (int qt = 0; qt < 2; ++qt) { mx[qt] = fmaxf(mx[qt], __shfl_xor(mx[qt], 16)); mx[qt] = fmaxf(mx[qt], __shfl_xor(mx[qt], 32)); sm[qt] = 0.f; }
#pragma unroll
    for (int kt = 0; kt < 12; ++kt)
#pragma unroll
        for (int qt = 0; qt < 2; ++qt)
#pragma unroll
            for (int j = 0; j < 4; ++j) { const float e = __expf(sc[kt][qt][j] - mx[qt]); sc[kt][qt][j] = e; sm[qt] += e; }
    float inv[2];
#pragma unroll
    for (int qt = 0; qt < 2; ++qt) { sm[qt] += __shfl_xor(sm[qt], 16); sm[qt] += __shfl_xor(sm[qt], 32); inv[qt] = 1.0f / (sm[qt] + __expf(sink - mx[qt])); }
    f32x4 oacc[4][2];
#pragma unroll
    for (int dd = 0; dd < 4; ++dd)
#pragma unroll
        for (int qt = 0; qt < 2; ++qt) oacc[dd][qt] = (f32x4){0.f, 0.f, 0.f, 0.f};
#pragma unroll
    for (int kp = 0; kp < 6; ++kp) {
        if (2 * kp < nkt) {
            bf16x8 pf[2];
#pragma unroll
            for (int qt = 0; qt < 2; ++qt) { const f32x4 a = sc[2 * kp][qt] * inv[qt], b2 = sc[2 * kp + 1][qt] * inv[qt]; const u32x4 pw = pack8(a, b2); pf[qt] = __builtin_bit_cast(bf16x8, pw); }
#pragma unroll
            for (int dd = 0; dd < 4; ++dd) { const bf16x4 v0 = *(const LAS bf16x4*)(Vt + (16 * dd + fr) * 400 + (32 * kp + 4 * fq) * 2), v1 = *(const LAS bf16x4*)(Vt + (16 * dd + fr) * 400 + (32 * kp + 16 + 4 * fq) * 2);
                const bf16x8 vf = (bf16x8){v0[0], v0[1], v0[2], v0[3], v1[0], v1[1], v1[2], v1[3]};
#pragma unroll
                for (int qt = 0; qt < 2; ++qt) oacc[dd][qt] = __builtin_amdgcn_mfma_f32_16x16x32_bf16(vf, pf[qt], oacc[dd][qt], 0, 0, 0); } }
    }
#pragma unroll
    for (int qt = 0; qt < 2; ++qt) { const int tok = 32 * th + 16 * qt + fr;
        if (tok < nq) {
#pragma unroll
            for (int dd = 0; dd < 4; ++dd) { u32x2 wv; wv.x = cvt_pk_bf16(oacc[dd][qt][0], oacc[dd][qt][1]); wv.y = cvt_pk_bf16(oacc[dd][qt][2], oacc[dd][qt][3]);
                *(u32x2*)(AO + (size_t)(qrow0 + tok) * 1024 + head * 64 + 16 * dd + 4 * fq) = wv; } } }
    __syncthreads();
}

__global__ void __launch_bounds__(512) fwd_kernel(Params p_arg) {
    extern __shared__ __attribute__((aligned(16))) unsigned char lds_raw[];
    LAS unsigned char* lds = (LAS unsigned char*)lds_raw;
    cg::grid_group grid = cg::this_grid();
    const int G = gridDim.x, bx = blockIdx.x, tid = threadIdx.x;
    const int lo = p_arg.ph_lo, hi = p_arg.ph_hi;
#ifndef PHMASK
#define PHMASK 0x7fff
#endif
#define IN(k) (((PHMASK >> (k)) & 1) && lo <= (k) && (k) < hi)
    unsigned* const barctr = (unsigned*)(p_arg.ws + WS_BAR); unsigned nbar = 0;
#define GRIDBAR() do { __syncthreads(); ++nbar; \
        if (tid == 0) { const unsigned target = nbar * (unsigned)G; __builtin_amdgcn_fence(__ATOMIC_RELEASE, "agent"); __hip_atomic_fetch_add(barctr, 1u, __ATOMIC_RELAXED, __HIP_MEMORY_SCOPE_AGENT); \
            while (__hip_atomic_load(barctr, __ATOMIC_RELAXED, __HIP_MEMORY_SCOPE_AGENT) < target) __builtin_amdgcn_s_sleep(1); \
            __builtin_amdgcn_fence(__ATOMIC_ACQUIRE, "agent"); } \
        __syncthreads(); } while (0)
#define SEAM(k) do { if (IN(k) && IN((k) + 1)) { if ((k) <= CG_SEAMS) grid.sync(); else GRIDBAR(); } } while (0)
#define PHASE_BEGIN(k) _Pragma("unroll 1") for (int rep_ = 0; rep_ < ((((REP_MASK) >> (k)) & 1) ? 2 : 1); ++rep_) { if (rep_) GRIDBAR();
#define PHASE_END }
#define R1 ((bf16_t*)(p.ws + WS_R1))
#define R2 ((bf16_t*)(p.ws + WS_R2))
#define ACT ((bf16_t*)(p.ws + WS_R3))
#define ZG ((bf16_t*)(p.ws + WS_R3 + GDN_BYTES))
#define XB ((bf16_t*)(p.ws + WS_R4))
#define GO XB
#define ZS5 (XB + (size_t)T * 512)
#define UCAT ((bf16_t*)(p.ws + WS_R5))
#define SUMSQ ((float*)(p.ws + WS_SUMSQ))
#define GATES ((float*)(p.ws + WS_GATES))
    PHASE_BEGIN(0)
    if (IN(0)) { KPR p = *launder_kp(); phase0(p, lds); }
    PHASE_END
    SEAM(0);
    PHASE_BEGIN(1)
    if (IN(1)) { KPR p = *launder_kp(); pg8::Gemm g{R1, (const bf16_t*)(p.ws + WS_W1T), 1024, 1024, 1024}; pg8::StaticOrder S; S.init(T, 2816, G, bx); Epi1 E{UCAT, R2, ZG, GATES}; pg8::gemm_phase(lds, g, S, E); }
    PHASE_END
    SEAM(1);
    PHASE_BEGIN(2)
    if (IN(2)) { KPR p = *launder_kp();
        { pg8::Gemm g{UCAT, (const bf16_t*)(p.ws + WS_HT), 384, 256, 256}; pg8::GroupOrder S{G, bx}; EpiS E{(float*)(p.ws + WS_R1)}; pg8::gemm_phase(lds, g, S, E); }
        __syncthreads();
        for (int ch = bx; ch < NCH; ch += G) gdn_prep_item(p, ch, lds);
        for (int i = bx * 512 + tid; i < 24 * 3 * 1536; i += G * 512) { const int c = i % 1536, j = (i / 1536) % 3, b = i / 4608;
            if (b < 8) p.out[O_PCONV + (size_t)(b * 3 + j) * 1536 + c] = bf2f(R2[(size_t)(b * 8192 + 8189 + j) * 1536 + c]);
            else p.out[O_SCONV + (size_t)((b - 8) * 3 + j) * 1536 + c] = bf2f(R2[(size_t)(TP + (b - 8) * 16 + 13 + j) * 1536 + c]); }
    }
    PHASE_END
    SEAM(2);
    PHASE_BEGIN(3)
    if (IN(3)) { KPR p = *launder_kp();
        for (int it = bx; it < 480; it += G) {
#ifdef REP_SUB
            if (rep_ == 1 && ((REP_SUB == 1) != (it < 128))) continue;
#endif
            if (it < 128) gdn_chain_item(p, it, lds);
            else if (it < 160) s5_scan_prompt(p, it - 128);
            else if (it < 416) gdn_chain_item(p, it - 160 + 128, lds);
            else s5_scan_sample(p, it - 416);
        }
    }
    PHASE_END
    SEAM(3);
    PHASE_BEGIN(4)
    if (IN(4)) { KPR p = *launder_kp();
        { pg8::Gemm g{UCAT, (const bf16_t*)(p.ws + WS_KGT), 384, 384, 384}; pg8::GroupOrder S{G, bx}; EpiY E{UCAT, p.in[19], ZS5}; pg8::gemm_phase(lds, g, S, E); }
        const float* nw = p.in[25];
        { const int l16 = tid & 15; const f32x4 w0 = *(const f32x4*)(nw + l16 * 8), w1 = *(const f32x4*)(nw + l16 * 8 + 4);
          const size_t gstride = ((size_t)G * 512) >> 4;
          for (size_t gi0 = ((size_t)bx * 512 + tid) >> 4; gi0 < (size_t)T * 4; gi0 += 4 * gstride) {
            u32x4 ow[4], zw[4];
#pragma unroll
            for (int q = 0; q < 4; ++q) { const size_t gi = gi0 + q * gstride; if (gi < (size_t)T * 4) { const size_t r = gi >> 2; const int h = (int)(gi & 3);
                ow[q] = *(const u32x4*)(GO + r * 512 + h * 128 + l16 * 8); zw[q] = *(const u32x4*)(ZG + r * 512 + h * 128 + l16 * 8); } else { ow[q] = (u32x4){0u, 0u, 0u, 0u}; zw[q] = ow[q]; } }
#pragma unroll
            for (int q = 0; q < 4; ++q) { const size_t gi = gi0 + q * gstride; const size_t r = gi >> 2; const int h = (int)(gi & 3);
                f32x4 o0, o1, z0, z1; unpack8(ow[q], o0, o1); unpack8(zw[q], z0, z1);
                float s = (o0[0] * o0[0] + o0[1] * o0[1]) + (o0[2] * o0[2] + o0[3] * o0[3]) + (o1[0] * o1[0] + o1[1] * o1[1]) + (o1[2] * o1[2] + o1[3] * o1[3]);
                s += __shfl_xor(s, 1); s += __shfl_xor(s, 2); s += __shfl_xor(s, 4); s += __shfl_xor(s, 8);
                const float rs = rsqrtf(s * (1.0f / 128.0f) + 1e-6f);
                f32x4 y0, y1;
#pragma unroll
                for (int j = 0; j < 4; ++j) { y0[j] = o0[j] * rs * w0[j] * silu_f(z0[j]); y1[j] = o1[j] * rs * w1[j] * silu_f(z1[j]); }
                if (gi < (size_t)T * 4) *(u32x4*)(R1 + r * 1024 + 512 + h * 128 + l16 * 8) = pack8(y0, y1); } } }
    }
    PHASE_END
    SEAM(4);
    PHASE_BEGIN(5)
    if (IN(5)) { KPR p = *launder_kp(); pg8::Gemm g{ZS5, (const bf16_t*)(p.ws + WS_WGLU), 512, 512, 512}; pg8::StaticOrder S; S.init(T, 512, G, bx); EpiGlu E{ZS5, p.in[21], R1}; pg8::gemm_phase(lds, g, S, E); }
    PHASE_END
    SEAM(5);
    PHASE_BEGIN(6)
    if (IN(6)) { KPR p = *launder_kp(); pg8::Gemm g{R1, (const bf16_t*)(p.ws + WS_WOUT), 1024, 1024, 1024}; pg8::StaticOrder S; S.init(T, 1024, G, bx); EpiRes E{p.in[0], p.in[1], XB, SUMSQ}; pg8::gemm_phase(lds, g, S, E); }
    PHASE_END
    SEAM(6);
    PHASE_BEGIN(7)
    if (IN(7)) { KPR p = *launder_kp(); pg8::Gemm g{XB, (const bf16_t*)(p.ws + WS_WF1_0), 1024, 1024, 1024}; pg8::StaticOrder S; S.init(T, 5632, G, bx); EpiFF E{SUMSQ, ACT}; pg8::gemm_phase(lds, g, S, E); }
    PHASE_END
    SEAM(7);
    PHASE_BEGIN(8)
    if (IN(8)) { KPR p = *launder_kp(); pg8::Gemm g{ACT, (const bf16_t*)(p.ws + WS_WFD_0), 2816, 2816, 2816}; pg8::StaticOrder S; S.init(T, 1024, G, bx); EpiRes E{nullptr, nullptr, XB, SUMSQ + T}; pg8::gemm_phase(lds, g, S, E); }
    PHASE_END
    SEAM(8);
    PHASE_BEGIN(9)
    if (IN(9)) { KPR p = *launder_kp(); pg8::Gemm g{XB, (const bf16_t*)(p.ws + WS_WQKV), 1024, 1024, 1024}; pg8::StaticOrder S; S.init(T, 1536, G, bx);
        EpiQKV E{SUMSQ + T, R1, UCAT, UCAT + (size_t)T * 256, p.out + O_PK, p.out + O_PV, p.out + O_SK, p.out + O_SV}; pg8::gemm_phase(lds, g, S, E); }
    PHASE_END
    SEAM(9);
    PHASE_BEGIN(10)
    if (IN(10)) { KPR p = *launder_kp(); for (int it = bx; it < 4160; it += G) attn_item(p, it, lds); }
    PHASE_END
    SEAM(10);
    PHASE_BEGIN(11)
    if (IN(11)) { KPR p = *launder_kp(); pg8::Gemm g{R2, (const bf16_t*)(p.ws + WS_WO), 1024, 1024, 1024}; pg8::StaticOrder S; S.init(T, 1024, G, bx); EpiRes E{nullptr, nullptr, XB, SUMSQ + 2 * T}; pg8::gemm_phase(lds, g, S, E); }
    PHASE_END
    SEAM(11);
    PHASE_BEGIN(12)
    if (IN(12)) { KPR p = *launder_kp(); pg8::Gemm g{XB, (const bf16_t*)(p.ws + WS_WF1_1), 1024, 1024, 1024}; pg8::StaticOrder S; S.init(T, 5632, G, bx); EpiFF E{SUMSQ + 2 * T, ACT}; pg8::gemm_phase(lds, g, S, E); }
    PHASE_END
    SEAM(12);
    PHASE_BEGIN(13)
    if (IN(13)) { KPR p = *launder_kp(); pg8::Gemm g{ACT, (const bf16_t*)(p.ws + WS_WFD_1), 2816, 2816, 2816}; pg8::StaticOrder S; S.init(T, 1024, G, bx); EpiRes E{nullptr, nullptr, XB, SUMSQ + 3 * T}; pg8::gemm_phase(lds, g, S, E); }
    PHASE_END
    SEAM(13);
    PHASE_BEGIN(14)
    if (IN(14)) { KPR p = *launder_kp();
        const int lane = tid & 63, wid = tid >> 6; const float* nw = p.in[10]; const float* sq = SUMSQ + 3 * T;
        f32x4 wv[4];
#pragma unroll
        for (int i = 0; i < 4; ++i) wv[i] = *(const f32x4*)(nw + lane * 4 + i * 256);
        for (int r = bx * 8 + wid; r < T; r += G * 8) { const float rs = rsqrtf(sq[r] * (1.0f / 1024.0f) + 1e-6f); float* xp = p.out + (size_t)r * 1024; const bf16_t* xs = XB + (size_t)r * 1024;
#pragma unroll
            for (int i = 0; i < 4; ++i) { const u32x2 bw = *(const u32x2*)(xs + lane * 4 + i * 256); const f32x4 v = (f32x4){bflo(bw.x), bfhi(bw.x), bflo(bw.y), bfhi(bw.y)}; *(f32x4*)(xp + lane * 4 + i * 256) = v * rs * wv[i]; } }
    }
    PHASE_END
#undef IN
#undef SEAM
}

extern "C" void kernel_launch(void* const* d_in, const int* in_sizes, int n_in, void* d_out, int out_size, void* d_ws, size_t ws_size, hipStream_t stream) {
    static int grid_blocks = 0;
    if (!grid_blocks) {
        int dev = 0, cus = 0, per_cu = 0;
        hipGetDevice(&dev);
        hipDeviceGetAttribute(&cus, hipDeviceAttributeMultiprocessorCount, dev);
        hipFuncSetAttribute((const void*)fwd_kernel, hipFuncAttributeMaxDynamicSharedMemorySize, LDS_BYTES);
        hipOccupancyMaxActiveBlocksPerMultiprocessor(&per_cu, (const void*)fwd_kernel, 512, LDS_BYTES);
        if (per_cu < 1) per_cu = 1;
        grid_blocks = cus * per_cu;
        if (ws_size < WS_END) fprintf(stderr, "kernel_launch: workspace too small: %zu < %zu\n", ws_size, (size_t)WS_END);
    }
    hipMemsetAsync((unsigned char*)d_ws + WS_BAR, 0, 256, stream);
    Params p{};
    for (int i = 0; i < 35; ++i) p.in[i] = (const float*)d_in[i];
    p.out = (float*)d_out; p.ws = (unsigned char*)d_ws; p.ph_lo = 0; p.ph_hi = PH_HI;
    void* args[] = {&p};
    hipError_t e = hipLaunchCooperativeKernel((const void*)fwd_kernel, dim3(grid_blocks), dim3(512), args, LDS_BYTES, stream);
    if (e != hipSuccess) fprintf(stderr, "cooperative launch failed: %s (grid %d)\n", hipGetErrorString(e), grid_blocks);
}
```

```cpp
#include <hip/hip_runtime.h>
#include <hip/hip_cooperative_groups.h>
#include <cstdio>
namespace cg = cooperative_groups;

#define LAS __attribute__((address_space(3)))
typedef unsigned short bf16_t;
typedef short bf16x8 __attribute__((ext_vector_type(8)));
typedef short bf16x4 __attribute__((ext_vector_type(4)));
typedef float f32x4 __attribute__((ext_vector_type(4)));
typedef unsigned u32x4 __attribute__((ext_vector_type(4)));
typedef unsigned u32x2 __attribute__((ext_vector_type(2)));

constexpr int TP = 65536;
constexpr int TS = 256;
constexpr int T = TP + TS;
constexpr int DM = 1024;
constexpr int NCH = 4160;
constexpr int CRG = 4352;
constexpr int CRV = 4112;

constexpr size_t al256(size_t x) { return (x + 255) & ~(size_t)255; }
constexpr size_t WS_W1T = 0;
constexpr size_t WS_WGLU = WS_W1T + (size_t)2816 * 1024 * 2;
constexpr size_t WS_WOUT = WS_WGLU + (size_t)512 * 512 * 2;
constexpr size_t WS_WF1_0 = WS_WOUT + (size_t)1024 * 1024 * 2;
constexpr size_t WS_WFD_0 = WS_WF1_0 + (size_t)5632 * 1024 * 2;
constexpr size_t WS_WQKV = WS_WFD_0 + (size_t)1024 * 2816 * 2;
constexpr size_t WS_WO = WS_WQKV + (size_t)1536 * 1024 * 2;
constexpr size_t WS_WF1_1 = WS_WO + (size_t)1024 * 1024 * 2;
constexpr size_t WS_WFD_1 = WS_WF1_1 + (size_t)5632 * 1024 * 2;
constexpr size_t WS_KGT = WS_WFD_1 + (size_t)1024 * 2816 * 2;
constexpr size_t WS_HT = WS_KGT + (size_t)32 * 256 * 384 * 2;
constexpr size_t WS_LP16 = WS_HT + (size_t)32 * 256 * 256 * 2;
constexpr size_t WS_SUMSQ = WS_LP16 + (size_t)32 * 64 * 2 * 4;
constexpr size_t WS_GATES = WS_SUMSQ + al256((size_t)4 * T * 4);
constexpr size_t WS_GL = WS_GATES + al256((size_t)T * 8 * 4);
constexpr size_t WS_BAR = WS_GL + al256((size_t)NCH * 4);
constexpr size_t WS_R1 = WS_BAR + 256;
constexpr size_t R1_BYTES = (size_t)T * 1024 * 2;
constexpr size_t WS_R2 = WS_R1 + R1_BYTES;
constexpr size_t R2_BYTES = (size_t)T * 1536 * 2;
constexpr size_t WS_R3 = WS_R2 + R2_BYTES;
constexpr size_t GDN_CH_BYTES = 73728;
constexpr size_t GDN_BYTES = (size_t)NCH * GDN_CH_BYTES;
constexpr size_t R3_BYTES = GDN_BYTES + (size_t)T * 512 * 2;
constexpr size_t WS_R4 = WS_R3 + R3_BYTES;
constexpr size_t R4_BYTES = (size_t)T * 1024 * 2;
constexpr size_t WS_R5 = WS_R4 + R4_BYTES;
constexpr size_t R5_BYTES = (size_t)32 * CRG * 384 * 2;
constexpr size_t WS_END = WS_R5 + R5_BYTES;
static_assert(R3_BYTES >= (size_t)T * 2816 * 2, "ACT fits R3");
static_assert((size_t)32 * CRG * 128 * 4 <= R1_BYTES, "SS fits R1");
static_assert((size_t)T * 512 * 2 <= R5_BYTES, "K|V fit R5");
static_assert(WS_END <= (size_t)1073741824, "workspace");

constexpr size_t O_Y = 0;
constexpr size_t O_PS5RE = 67371008, O_PS5IM = 67387392, O_PGDN = 67403776, O_PCONV = 67928064, O_PK = 67964928, O_PV = 68227072;
constexpr size_t O_SS5RE = 68489216, O_SS5IM = 68521984, O_SGDN = 68554752, O_SCONV = 69603328, O_SK = 69677056, O_SV = 70201344;

constexpr int LDS_BYTES = 131072;
#ifndef CG_SEAMS
#define CG_SEAMS 0
#endif
#ifndef REP_MASK
#define REP_MASK 0
#endif
#ifndef PH_HI
#define PH_HI 15
#endif

struct Params { const float* in[35]; float* out; unsigned char* ws; int ph_lo, ph_hi; };
typedef const __attribute__((address_space(4))) Params& KPR;
typedef const __attribute__((address_space(4))) Params* KPP;
__device__ __forceinline__ int ltid() { int t = threadIdx.x; asm volatile("" : "+v"(t)); return t; }
__device__ __forceinline__ KPP launder_kp() { KPP q = (KPP)__builtin_amdgcn_kernarg_segment_ptr(); asm volatile("" : "+s"(q)); return q; }

typedef float f32x2v __attribute__((ext_vector_type(2)));
typedef __bf16 bf16x2v __attribute__((ext_vector_type(2)));
__device__ __forceinline__ unsigned cvt_pk_bf16(float lo, float hi) { const f32x2v v = {lo, hi}; const bf16x2v b = __builtin_convertvector(v, bf16x2v); return __builtin_bit_cast(unsigned, b); }
__device__ __forceinline__ bf16_t f2bf(float f) { return (bf16_t)(cvt_pk_bf16(f, 0.f) & 0xffffu); }
__device__ __forceinline__ float bf2f(bf16_t b) { return __uint_as_float(((unsigned)b) << 16); }
__device__ __forceinline__ float bflo(unsigned w) { return __uint_as_float(w << 16); }
__device__ __forceinline__ float bfhi(unsigned w) { return __uint_as_float(w & 0xffff0000u); }
__device__ __forceinline__ float silu_f(float x) { return x * __builtin_amdgcn_rcpf(1.0f + __expf(-x)); }
__device__ __forceinline__ float sigmoid_f(float x) { return __builtin_amdgcn_rcpf(1.0f + __expf(-x)); }
__device__ __forceinline__ float gelu_tanh_f(float x) { const float u = 1.5957691216057308f * (x + 0.044715f * x * x * x); return x * __builtin_amdgcn_rcpf(1.0f + __expf(-u)); }
#define LDS_BARRIER() do { asm volatile("s_waitcnt lgkmcnt(0)" ::: "memory"); __builtin_amdgcn_s_barrier(); asm volatile("" ::: "memory"); } while (0)

namespace pg8 {
constexpr int BM = 256, BK = 64, HALF = 128, HTB = HALF * BK * 2, STAGE_BYTES = 8 * HTB, NXCD = 8, WGM = 8;
__device__ __forceinline__ int lds_byte(int r, int c) { const int st = (r >> 4) * 2 + (c >> 5), rr = r & 15, cc = c & 31, ob = rr * 64 + cc * 2; return st * 1024 + (ob ^ (((ob >> 9) & 1) << 5)); }
__device__ __forceinline__ void stage_rc(int b, int& R, int& C) { const int st = b / 1024, sb = b % 1024, swz = sb ^ (((sb >> 9) & 1) << 5); R = (st >> 1) * 16 + swz / 64; C = (st & 1) * 32 + (swz % 64) / 2; }
__device__ __forceinline__ int perm32(int rho) { const int n = rho >> 4, i = rho & 15; return 8 * (i >> 2) + 4 * n + (i & 3); }
struct Unit { int pm, pn; };
struct Gemm { const bf16_t* A; const bf16_t* Bt; int lda, ldb, K; };
struct StaticOrder {
    int nM, nN, nwg, G, c;
    __device__ void init(int M, int N, int G_, int c_) { nM = M / BM; nN = N / BM; nwg = nM * nN; G = G_; c = c_; }
    __device__ bool next(int i, Unit& u) const {
        const long L = (long)i * G + c; if (L >= nwg) return false;
        int wgid = (int)L; { const int q = nwg / NXCD, r = nwg % NXCD, xcd = wgid % NXCD, off = wgid / NXCD; wgid = (xcd < r ? xcd * (q + 1) : r * (q + 1) + (xcd - r) * q) + off; }
        const int nig = WGM * nN, gid = wgid / nig, fm = gid * WGM, gsz = (nM - fm) < WGM ? (nM - fm) : WGM;
        u.pm = fm + ((wgid % nig) % gsz); u.pn = (wgid % nig) / gsz; return true;
    }
};
struct GroupOrder {
    int G, c;
    __device__ bool next(int i, Unit& u) const { const int L = i * G + c; if (L >= 32 * 17) return false; u.pm = L; u.pn = L / 17; return true; }
};

template <class Epi, class Sched>
__device__ __forceinline__ void gemm_phase(LAS unsigned char* lds, const Gemm g, const Sched& S, const Epi& E) {
    const int tid = ltid(), wid = __builtin_amdgcn_readfirstlane(tid >> 6), lane = tid & 63, wr = wid >> 2, wc = wid & 3, fr = lane & 15, fq = lane >> 4;
    const int K = g.K, nt = K / BK;
    unsigned voffA[2], voffB[2];
#pragma unroll
    for (int i = 0; i < 2; ++i) { int R, C; stage_rc(tid * 16 + i * 8192, R, C); const int Rb = Epi::PERM ? ((R & ~31) + perm32(R & 31)) : R;
        voffA[i] = (unsigned)(R * g.lda + C) * 2u; voffB[i] = (unsigned)(Rb * g.ldb + C) * 2u; }
    const size_t kstep = (size_t)(BK * 2);
    const size_t hstepA = (size_t)HALF * g.lda * 2, hstepB = (size_t)HALF * g.ldb * 2;
    const size_t tstepA = 2 * hstepA, tstepB = 2 * hstepB;
    const unsigned ldsw = (unsigned)wid * 1024u;
    const int aoff = lds_byte(wr * 64 + fr, fq * 8), boff = lds_byte(wc * 32 + fr, fq * 8);
#define PG8_SA(b, h) (((b) * 2 + (h)) * HTB)
#define PG8_SB(b, h) ((4 + (b) * 2 + (h)) * HTB)
#define PG8_STAGE(bufoff, gbase, voff) do { _Pragma("unroll") for (int _i = 0; _i < 2; ++_i) \
        __builtin_amdgcn_global_load_lds((const unsigned*)((const char*)(gbase) + (voff)[_i]), (LAS unsigned*)(lds + (bufoff) + ldsw + _i * 8192), 16, 0, 0); } while (0)
#define PG8_LDA(dst, b, h) do { _Pragma("unroll") for (int m = 0; m < 4; ++m) _Pragma("unroll") for (int k = 0; k < 2; ++k) dst[m][k] = *(const LAS bf16x8*)(lds + PG8_SA(b, h) + aoff + m * 2048 + k * 1024); } while (0)
#define PG8_LDB(dst, b, h) do { _Pragma("unroll") for (int n = 0; n < 2; ++n) _Pragma("unroll") for (int k = 0; k < 2; ++k) dst[n][k] = *(const LAS bf16x8*)(lds + PG8_SB(b, h) + boff + n * 2048 + k * 1024); } while (0)
#define PG8_MMA(ai, bj, At, Bt) do { __builtin_amdgcn_s_setprio(1); _Pragma("unroll") for (int m = 0; m < 4; ++m) _Pragma("unroll") for (int n = 0; n < 2; ++n) _Pragma("unroll") for (int k = 0; k < 2; ++k) \
        acc[ai][bj][m][n] = __builtin_amdgcn_mfma_f32_16x16x32_bf16(Bt[n][k], At[m][k], acc[ai][bj][m][n], 0, 0, 0); __builtin_amdgcn_s_setprio(0); } while (0)
#define PG8_WAIT_V(n) asm volatile("s_waitcnt vmcnt(" #n ")" ::: "memory")
#define PG8_WAIT_L(n) asm volatile("s_waitcnt lgkmcnt(" #n ")" ::: "memory")
#define PG8_BAR __builtin_amdgcn_s_barrier()
#define PG8_SCHED __builtin_amdgcn_sched_barrier(0)
    Unit cur, nxt; int ui = 0;
    if (!S.next(0, cur)) return;
    f32x4 acc[2][2][4][2];
#pragma unroll
    for (int a = 0; a < 2; ++a)
#pragma unroll
        for (int b = 0; b < 2; ++b)
#pragma unroll
            for (int m = 0; m < 4; ++m)
#pragma unroll
                for (int n = 0; n < 2; ++n) acc[a][b][m][n] = (f32x4){0.f, 0.f, 0.f, 0.f};
    bf16x8 At[4][2], B0[2][2], B1[2][2];
    const char* cA = (const char*)g.A + (size_t)cur.pm * tstepA; const char* cB = (const char*)g.Bt + (size_t)cur.pn * tstepB;
    PG8_STAGE(PG8_SB(0, 0), cB, voffB); PG8_STAGE(PG8_SB(0, 1), cB + hstepB, voffB); PG8_STAGE(PG8_SA(0, 0), cA, voffA); PG8_STAGE(PG8_SA(0, 1), cA + hstepA, voffA);
    if (wr == 1) PG8_BAR;
    PG8_WAIT_V(2); PG8_BAR;
    PG8_STAGE(PG8_SB(1, 0), cB + kstep, voffB); PG8_STAGE(PG8_SA(1, 0), cA + kstep, voffA); PG8_STAGE(PG8_SB(1, 1), cB + hstepB + kstep, voffB);
    PG8_WAIT_V(6); PG8_BAR;
    for (;;) {
        const bool has_next = S.next(ui + 1, nxt);
        const char* nA = has_next ? (const char*)g.A + (size_t)nxt.pm * tstepA : cA; const char* nB = has_next ? (const char*)g.Bt + (size_t)nxt.pn * tstepB : cB;
        for (int t = 0; t < nt; t += 2) {
            const bool last = (t == nt - 2);
            const char* a1 = cA + (size_t)(t + 1) * kstep;
            const char* a2 = last ? nA : cA + (size_t)(t + 2) * kstep; const char* b2 = last ? nB : cB + (size_t)(t + 2) * kstep;
            const char* a3 = a2 + kstep; const char* b3 = b2 + kstep;
            PG8_LDB(B0, 0, 0); PG8_LDB(B1, 0, 1); PG8_SCHED; PG8_LDA(At, 0, 0); PG8_STAGE(PG8_SA(1, 1), a1 + hstepA, voffA);
            PG8_WAIT_V(8); PG8_WAIT_L(0); PG8_BAR; PG8_MMA(0, 0, At, B0); PG8_MMA(0, 1, At, B1); PG8_BAR; PG8_SCHED;
            PG8_LDA(At, 0, 1); PG8_STAGE(PG8_SB(0, 0), b2, voffB); PG8_STAGE(PG8_SB(0, 1), b2 + hstepB, voffB); PG8_STAGE(PG8_SA(0, 0), a2, voffA);
            PG8_WAIT_V(8); PG8_WAIT_L(0); PG8_BAR; PG8_MMA(1, 0, At, B0); PG8_MMA(1, 1, At, B1); PG8_BAR; PG8_SCHED;
            PG8_LDB(B0, 1, 0); PG8_LDB(B1, 1, 1); PG8_SCHED; PG8_LDA(At, 1, 0); PG8_STAGE(PG8_SA(0, 1), a2 + hstepA, voffA);
            PG8_WAIT_V(8); PG8_WAIT_L(0); PG8_BAR; PG8_MMA(0, 0, At, B0); PG8_MMA(0, 1, At, B1); PG8_BAR; PG8_SCHED;
            PG8_LDA(At, 1, 1); PG8_STAGE(PG8_SB(1, 0), b3, voffB); PG8_STAGE(PG8_SB(1, 1), b3 + hstepB, voffB); PG8_STAGE(PG8_SA(1, 0), a3, voffA);
            PG8_WAIT_V(8); PG8_WAIT_L(0); PG8_BAR; PG8_MMA(1, 0, At, B0); PG8_MMA(1, 1, At, B1); PG8_BAR; PG8_SCHED;
        }
        if (wr == 0) PG8_BAR;
        { int frE = fr, fqE = fq; asm volatile("" : "+v"(frE), "+v"(fqE)); E(acc, cur, wr, wc, frE, fqE); }
        if (!has_next) break;
#pragma unroll
        for (int a = 0; a < 2; ++a)
#pragma unroll
            for (int b = 0; b < 2; ++b)
#pragma unroll
                for (int m = 0; m < 4; ++m)
#pragma unroll
                    for (int n = 0; n < 2; ++n) acc[a][b][m][n] = (f32x4){0.f, 0.f, 0.f, 0.f};
        cur = nxt; cA = nA; cB = nB; ++ui;
        if (wr == 1) PG8_BAR;
    }
    PG8_WAIT_V(0);
    PG8_BAR;
#undef PG8_SA
#undef PG8_SB
#undef PG8_STAGE
#undef PG8_LDA
#undef PG8_LDB
#undef PG8_MMA
#undef PG8_WAIT_V
#undef PG8_WAIT_L
#undef PG8_BAR
#undef PG8_SCHED
}
}
using pg8::Unit;

__device__ __forceinline__ u32x4 pack8(const f32x4 a, const f32x4 b) { u32x4 w; w.x = cvt_pk_bf16(a[0], a[1]); w.y = cvt_pk_bf16(a[2], a[3]); w.z = cvt_pk_bf16(b[0], b[1]); w.w = cvt_pk_bf16(b[2], b[3]); return w; }
__device__ __forceinline__ void unpack8(const u32x4 w, f32x4& a, f32x4& b) { a = (f32x4){bflo(w.x), bfhi(w.x), bflo(w.y), bfhi(w.y)}; b = (f32x4){bflo(w.z), bfhi(w.z), bflo(w.w), bfhi(w.w)}; }

struct Epi1 {
    static constexpr bool PERM = true;
    bf16_t* ucat; bf16_t* qkvraw; bf16_t* zg; float* gates;
    __device__ __forceinline__ void operator()(const f32x4 (&acc)[2][2][4][2], const Unit& u, int wr, int wc, int fr, int fq) const {
        const int row0 = u.pm * 256 + wr * 64 + fr, pn = u.pn;
#pragma unroll
        for (int ai = 0; ai < 2; ++ai)
#pragma unroll
            for (int m = 0; m < 4; ++m) { const int r = row0 + ai * 128 + m * 16;
#pragma unroll
                for (int bj = 0; bj < 2; ++bj) { const int c0 = pn * 256 + bj * 128 + wc * 32 + 8 * fq;
                    if (pn == 10) { if (bj == 0 && wc == 0 && fq == 0) { *(f32x4*)(gates + (size_t)r * 8) = acc[ai][bj][m][0]; *(f32x4*)(gates + (size_t)r * 8 + 4) = acc[ai][bj][m][1]; } }
                    else { const u32x4 w = pack8(acc[ai][bj][m][0], acc[ai][bj][m][1]); bf16_t* dst;
                        if (pn < 2) dst = ucat + ((size_t)((c0 >> 4) * CRG + (r >> 4)) * 384 + (r & 15) * 16 + (c0 & 15));
                        else if (pn < 8) dst = qkvraw + (size_t)r * 1536 + (c0 - 512);
                        else dst = zg + (size_t)r * 512 + (c0 - 2048);
                        *(u32x4*)dst = w; } } }
    }
};
struct EpiS {
    static constexpr bool PERM = false;
    float* ss;
    __device__ __forceinline__ void operator()(const f32x4 (&acc)[2][2][4][2], const Unit& u, int wr, int wc, int fr, int fq) const {
        const int row0 = u.pm * 256 + wr * 64 + fr, col0 = wc * 32 + 4 * fq;
#pragma unroll
        for (int ai = 0; ai < 2; ++ai)
#pragma unroll
            for (int m = 0; m < 4; ++m) { float* rp = ss + (size_t)(row0 + ai * 128 + m * 16) * 128 + col0;
#pragma unroll
                for (int n = 0; n < 2; ++n) *(f32x4*)(rp + n * 16) = acc[ai][0][m][n]; }
    }
};
struct EpiY {
    static constexpr bool PERM = true;
    const bf16_t* ucat; const float* dvec; bf16_t* zs5;
    __device__ __forceinline__ void operator()(const f32x4 (&acc)[2][2][4][2], const Unit& u, int wr, int wc, int fr, int fq) const {
        const int g = u.pn, crow0 = u.pm * 256 + wr * 64 + fr;
#pragma unroll
        for (int ai = 0; ai < 2; ++ai)
#pragma unroll
            for (int m = 0; m < 4; ++m) { const int crow = crow0 + ai * 128 + m * 16, cr = crow - g * CRG;
                if (cr < CRV) {
#pragma unroll
                    for (int bj = 0; bj < 2; ++bj) { const int n0 = bj * 128 + wc * 32 + 8 * fq, tl = n0 >> 4, cp = n0 & 15;
                        const f32x4 d0 = *(const f32x4*)(dvec + g * 16 + cp), d1 = *(const f32x4*)(dvec + g * 16 + cp + 4);
                        const u32x4 uw = *(const u32x4*)(ucat + (size_t)crow * 384 + n0); f32x4 u0, u1; unpack8(uw, u0, u1);
                        f32x4 y0 = acc[ai][bj][m][0] + d0 * u0, y1 = acc[ai][bj][m][1] + d1 * u1;
#pragma unroll
                        for (int j = 0; j < 4; ++j) { y0[j] = gelu_tanh_f(y0[j]); y1[j] = gelu_tanh_f(y1[j]); }
                        *(u32x4*)(zs5 + (size_t)(cr * 16 + tl) * 512 + g * 16 + cp) = pack8(y0, y1); } }
                asm volatile("" ::: "memory"); }
    }
};
struct EpiGlu {
    static constexpr bool PERM = true;
    const bf16_t* zs5; const float* bglu; bf16_t* mixin;
    __device__ __forceinline__ void operator()(const f32x4 (&acc)[2][2][4][2], const Unit& u, int wr, int wc, int fr, int fq) const {
        const int row0 = u.pm * 256 + wr * 64 + fr;
#pragma unroll
        for (int bj = 0; bj < 2; ++bj) { const int c0 = u.pn * 256 + bj * 128 + wc * 32 + 8 * fq;
            const f32x4 b0 = *(const f32x4*)(bglu + c0), b1 = *(const f32x4*)(bglu + c0 + 4);
#pragma unroll
            for (int ai = 0; ai < 2; ++ai)
#pragma unroll
                for (int m = 0; m < 4; ++m) { const int r = row0 + ai * 128 + m * 16;
                    const u32x4 zw = *(const u32x4*)(zs5 + (size_t)r * 512 + c0); f32x4 z0, z1; unpack8(zw, z0, z1);
                    f32x4 o0, o1;
#pragma unroll
                    for (int j = 0; j < 4; ++j) { o0[j] = z0[j] * sigmoid_f(acc[ai][bj][m][0][j] + b0[j]); o1[j] = z1[j] * sigmoid_f(acc[ai][bj][m][1][j] + b1[j]); }
                    *(u32x4*)(mixin + (size_t)r * 1024 + c0) = pack8(o0, o1); } }
    }
};
struct EpiRes {
    static constexpr bool PERM = false;
    const float* base_p; const float* base_s; bf16_t* xb; float* sumsq;
    __device__ __forceinline__ void operator()(const f32x4 (&acc)[2][2][4][2], const Unit& u, int wr, int wc, int fr, int fq) const {
        const int row0 = u.pm * 256 + wr * 64 + fr, col0 = u.pn * 256 + wc * 32 + 4 * fq;
#pragma unroll
        for (int ai = 0; ai < 2; ++ai)
#pragma unroll
            for (int m = 0; m < 4; ++m) { const int r = row0 + ai * 128 + m * 16; float s = 0.f;
                const float* bp = base_p ? ((r < TP) ? base_p + (size_t)r * 1024 : base_s + (size_t)(r - TP) * 1024) : nullptr;
#pragma unroll
                for (int bj = 0; bj < 2; ++bj)
#pragma unroll
                    for (int n = 0; n < 2; ++n) { const int c = col0 + bj * 128 + n * 16; f32x4 b;
                        if (bp) b = *(const f32x4*)(bp + c);
                        else { const u32x2 bw = *(const u32x2*)(xb + (size_t)r * 1024 + c); b = (f32x4){bflo(bw.x), bfhi(bw.x), bflo(bw.y), bfhi(bw.y)}; }
                        const f32x4 v = b + acc[ai][bj][m][n];
                        u32x2 w; w.x = cvt_pk_bf16(v[0], v[1]); w.y = cvt_pk_bf16(v[2], v[3]); *(u32x2*)(xb + (size_t)r * 1024 + c) = w;
                        s += (v[0] * v[0] + v[1] * v[1]) + (v[2] * v[2] + v[3] * v[3]); }
                s += __shfl_xor(s, 16); s += __shfl_xor(s, 32);
                if (fq == 0) atomicAdd(sumsq + r, s);
                asm volatile("" ::: "memory"); }
    }
};
struct EpiFF {
    static constexpr bool PERM = true;
    const float* sumsq; bf16_t* act;
    __device__ __forceinline__ void operator()(const f32x4 (&acc)[2][2][4][2], const Unit& u, int wr, int wc, int fr, int fq) const {
        const int row0 = u.pm * 256 + wr * 64 + fr, c0 = u.pn * 128 + wc * 32 + 8 * fq;
#pragma unroll
        for (int ai = 0; ai < 2; ++ai)
#pragma unroll
            for (int m = 0; m < 4; ++m) { const int r = row0 + ai * 128 + m * 16; const float rs = rsqrtf(sumsq[r] * (1.0f / 1024.0f) + 1e-6f);
                f32x4 o0, o1;
#pragma unroll
                for (int j = 0; j < 4; ++j) { o0[j] = silu_f(acc[ai][0][m][0][j] * rs) * (acc[ai][1][m][0][j] * rs); o1[j] = silu_f(acc[ai][0][m][1][j] * rs) * (acc[ai][1][m][1][j] * rs); }
                *(u32x4*)(act + (size_t)r * 2816 + c0) = pack8(o0, o1); }
    }
};
struct EpiQKV {
    static constexpr bool PERM = true;
    const float* sumsq; bf16_t* q; bf16_t* kb; bf16_t* vb; float* opk; float* opv; float* osk; float* osv;
    __device__ __forceinline__ void operator()(const f32x4 (&acc)[2][2][4][2], const Unit& u, int wr, int wc, int fr, int fq) const {
        const int row0 = u.pm * 256 + wr * 64 + fr, pn = u.pn;
#pragma unroll
        for (int ai = 0; ai < 2; ++ai)
#pragma unroll
            for (int m = 0; m < 4; ++m) { const int r = row0 + ai * 128 + m * 16; const float rs = rsqrtf(sumsq[r] * (1.0f / 1024.0f) + 1e-6f);
#pragma unroll
                for (int bj = 0; bj < 2; ++bj) { const int cl = bj * 128 + wc * 32 + 8 * fq;
                    if (pn < 4) { const float sc = rs * 0.125f; *(u32x4*)(q + (size_t)r * 1024 + pn * 256 + cl) = pack8(acc[ai][bj][m][0] * sc, acc[ai][bj][m][1] * sc); }
                    else { const f32x4 v0 = acc[ai][bj][m][0] * rs, v1 = acc[ai][bj][m][1] * rs;
                        bf16_t* dst = (pn == 4 ? kb : vb) + (size_t)r * 256 + cl; *(u32x4*)dst = pack8(v0, v1);
                        float* od = nullptr;
                        if (r < TP) { const int t = r & 8191; if (t >= 8064) od = (pn == 4 ? opk : opv) + ((size_t)((r >> 13) * 128 + (t - 8064)) * 256 + cl); }
                        else { const int rr = r - TP; od = (pn == 4 ? osk : osv) + ((size_t)((rr >> 4) * 128 + 112 + (rr & 15)) * 256 + cl); }
                        if (od) { *(f32x4*)od = v0; *(f32x4*)(od + 4) = v1; } } } }
    }
};

struct WDesc { const float* src; int ld, K, N, rowoff, mode; bf16_t* dst; const float* fold; };
__device__ __forceinline__ void wt_tile(const WDesc& d, int tile, LAS float* tl) {
    const int ntn = (d.N + 63) >> 6, kt = tile / ntn, ntile = tile - kt * ntn, k0 = kt * 64, n0 = ntile * 64, tid = ltid();
#pragma unroll
    for (int ps = 0; ps < 8; ++ps) { const int k = ps * 8 + (tid >> 6), n = tid & 63; float v = 0.f;
        if (n0 + n < d.N) v = d.src[(size_t)(k0 + k) * d.ld + n0 + n];
        if (d.fold) v *= d.fold[k0 + k];
        tl[k * 65 + n] = v; }
    __syncthreads();
#pragma unroll
    for (int ps = 0; ps < 8; ++ps) { const int n = ps * 8 + (tid >> 6), k = tid & 63, gn = n0 + n;
        if (gn < d.N) { const int drow = (d.mode ? ((gn >> 7) * 256 + (gn & 127)) : gn) + d.rowoff; d.dst[(size_t)drow * d.K + k0 + k] = f2bf(tl[k * 65 + n]); } }
    __syncthreads();
}

__device__ __forceinline__ void s5_gen_group(KPR p, int g, LAS unsigned char* lds) {
    LAS float* LP = (LAS float*)lds;
    LAS float* BB = LP + 17 * 64 * 2;
    LAS float* KL = BB + 64 * 16 * 2;
    LAS float* CF = KL + 4096;
    const int tid = ltid();
    const float* lam_re = p.in[12]; const float* lam_im = p.in[13]; const float* log_dt = p.in[14];
    const float* b_re = p.in[15]; const float* b_im = p.in[16]; const float* c_re = p.in[17]; const float* c_im = p.in[18];
    bf16_t* kgt = (bf16_t*)(p.ws + WS_KGT) + (size_t)g * 256 * 384; bf16_t* ht = (bf16_t*)(p.ws + WS_HT) + (size_t)g * 256 * 256; float* lp16 = (float*)(p.ws + WS_LP16) + g * 128;
    if (tid < 64) { const int pp = tid; const double dt = exp((double)log_dt[g]); const double lr = (double)lam_re[g * 64 + pp], li = (double)lam_im[g * 64 + pp];
        for (int k = 0; k <= 16; ++k) { const double mg = exp(k * lr * dt), an = k * li * dt; const double cr = mg * cos(an), ci = mg * sin(an);
            LP[(k * 64 + pp) * 2] = (float)cr; LP[(k * 64 + pp) * 2 + 1] = (float)ci;
            if (k == 16) { lp16[pp * 2] = (float)cr; lp16[pp * 2 + 1] = (float)ci; }
            if (k == 1) { const double nr = cr - 1.0, ni = ci, dn = lr * lr + li * li; CF[pp * 2] = (float)((nr * lr + ni * li) / dn); CF[pp * 2 + 1] = (float)((ni * lr - nr * li) / dn); } } }
    __syncthreads();
    for (int e = tid; e < 1024; e += 512) { const int pp = e >> 4; const float br = b_re[(size_t)g * 1024 + e], bi = b_im[(size_t)g * 1024 + e], fr_ = CF[pp * 2], fi_ = CF[pp * 2 + 1];
        BB[e * 2] = fr_ * br - fi_ * bi; BB[e * 2 + 1] = fr_ * bi + fi_ * br; }
    __syncthreads();
    for (int e = tid; e < 4096; e += 512) { const int k = e >> 8, c = (e >> 4) & 15, cp = e & 15; float s = 0.f;
        for (int pp = 0; pp < 64; ++pp) { const float cr = c_re[(size_t)g * 1024 + c * 64 + pp], ci = c_im[(size_t)g * 1024 + c * 64 + pp];
            const float lr = LP[(k * 64 + pp) * 2], li = LP[(k * 64 + pp) * 2 + 1], br = BB[(pp * 16 + cp) * 2], bi = BB[(pp * 16 + cp) * 2 + 1];
            const float mr = lr * br - li * bi, mi = lr * bi + li * br; s += cr * mr - ci * mi; }
        KL[e] = s; }
    __syncthreads();
    for (int e = tid; e < 256 * 384; e += 512) { const int n = e / 384, k = e - n * 384, t = n >> 4, c = n & 15; float v;
        if (k < 256) { const int s = k >> 4, cp = k & 15; v = (s <= t) ? KL[((t - s) * 16 + c) * 16 + cp] : 0.f; }
        else { const int pp = (k - 256) & 63; const float cr = c_re[(size_t)g * 1024 + c * 64 + pp], ci = c_im[(size_t)g * 1024 + c * 64 + pp];
            const float lr = LP[((t + 1) * 64 + pp) * 2], li = LP[((t + 1) * 64 + pp) * 2 + 1];
            v = (k < 320) ? (cr * lr - ci * li) : -(cr * li + ci * lr); }
        kgt[e] = f2bf(v); }
    for (int e = tid; e < 256 * 256; e += 512) { const int n = e >> 8, k = e & 255; float v = 0.f;
        if (n < 128) { const int pp = n & 63, s = k >> 4, cp = k & 15; const float lr = LP[((15 - s) * 64 + pp) * 2], li = LP[((15 - s) * 64 + pp) * 2 + 1], br = BB[(pp * 16 + cp) * 2], bi = BB[(pp * 16 + cp) * 2 + 1];
            v = (n < 64) ? (lr * br - li * bi) : (lr * bi + li * br); }
        ht[e] = f2bf(v); }
    __syncthreads();
}

__device__ __forceinline__ void phase0(KPR p, LAS unsigned char* lds) {
    const int tid = ltid(), G = gridDim.x, bx = blockIdx.x, lane = tid & 63, wid = tid >> 6;
    for (int g = bx; g < 32; g += G) s5_gen_group(p, g, lds);
    {
        const float* nf = p.in[9]; const float* nm = p.in[8];
        const int shift = (bx + G - (32 % G)) % G;
        for (int it = shift; it < 5840; it += G) {
            int t = it; WDesc d;
            if (t < 656) d = WDesc{p.in[11], 2568, 1024, 2568, 0, 0, (bf16_t*)(p.ws + WS_W1T), nullptr};
            else if ((t -= 656) < 64) d = WDesc{p.in[20], 512, 512, 512, 0, 0, (bf16_t*)(p.ws + WS_WGLU), nullptr};
            else if ((t -= 64) < 256) d = WDesc{p.in[26], 1024, 1024, 1024, 0, 0, (bf16_t*)(p.ws + WS_WOUT), nullptr};
            else if ((t -= 256) < 704) d = WDesc{p.in[32], 2816, 1024, 2816, 0, 1, (bf16_t*)(p.ws + WS_WF1_0), nf};
            else if ((t -= 704) < 704) d = WDesc{p.in[33], 2816, 1024, 2816, 128, 1, (bf16_t*)(p.ws + WS_WF1_0), nf};
            else if ((t -= 704) < 704) d = WDesc{p.in[34], 1024, 2816, 1024, 0, 0, (bf16_t*)(p.ws + WS_WFD_0), nullptr};
            else if ((t -= 704) < 256) d = WDesc{p.in[27], 1024, 1024, 1024, 0, 0, (bf16_t*)(p.ws + WS_WQKV), nm + 1024};
            else if ((t -= 256) < 64) d = WDesc{p.in[28], 256, 1024, 256, 1024, 0, (bf16_t*)(p.ws + WS_WQKV), nm + 1024};
            else if ((t -= 64) < 64) d = WDesc{p.in[29], 256, 1024, 256, 1280, 0, (bf16_t*)(p.ws + WS_WQKV), nm + 1024};
            else if ((t -= 64) < 256) d = WDesc{p.in[31], 1024, 1024, 1024, 0, 0, (bf16_t*)(p.ws + WS_WO), nullptr};
            else if ((t -= 256) < 704) d = WDesc{p.in[32] + (size_t)1024 * 2816, 2816, 1024, 2816, 0, 1, (bf16_t*)(p.ws + WS_WF1_1), nf + 1024};
            else if ((t -= 704) < 704) d = WDesc{p.in[33] + (size_t)1024 * 2816, 2816, 1024, 2816, 128, 1, (bf16_t*)(p.ws + WS_WF1_1), nf + 1024};
            else { t -= 704; d = WDesc{p.in[34] + (size_t)2816 * 1024, 1024, 2816, 1024, 0, 0, (bf16_t*)(p.ws + WS_WFD_1), nullptr}; }
            wt_tile(d, t, (LAS float*)lds);
        }
    }
    {
        bf16_t* h0 = (bf16_t*)(p.ws + WS_R1); const float* nw = p.in[8];
        f32x4 wv[4];
#pragma unroll
        for (int i = 0; i < 4; ++i) wv[i] = *(const f32x4*)(nw + lane * 4 + i * 256);
        for (int r = bx * 8 + wid; r < T; r += G * 8) {
            const float* xp = (r < TP) ? p.in[0] + (size_t)r * 1024 : p.in[1] + (size_t)(r - TP) * 1024;
            f32x4 v[4]; float s = 0.f;
#pragma unroll
            for (int i = 0; i < 4; ++i) { v[i] = *(const f32x4*)(xp + lane * 4 + i * 256); s += (v[i][0] * v[i][0] + v[i][1] * v[i][1]) + (v[i][2] * v[i][2] + v[i][3] * v[i][3]); }
#pragma unroll
            for (int o = 32; o >= 1; o >>= 1) s += __shfl_xor(s, o);
            const float rs = rsqrtf(s * (1.0f / 1024.0f) + 1e-6f);
#pragma unroll
            for (int i = 0; i < 4; ++i) { const f32x4 y = v[i] * rs * wv[i]; u32x2 w; w.x = cvt_pk_bf16(y[0], y[1]); w.y = cvt_pk_bf16(y[2], y[3]); *(u32x2*)(h0 + (size_t)r * 1024 + lane * 4 + i * 256) = w; }
        }
    }
    {
        const size_t gt = (size_t)bx * 512 + tid, gs = (size_t)G * 512;
        float* sq = (float*)(p.ws + WS_SUMSQ); for (size_t i = gt; i < (size_t)4 * T; i += gs) sq[i] = 0.f;
        unsigned* wpad = (unsigned*)(p.ws + WS_W1T + (size_t)2568 * 1024 * 2); for (size_t i = gt; i < (size_t)248 * 512; i += gs) wpad[i] = 0u;
        const float* ck = p.in[6]; const float* cv = p.in[7]; float* ok = p.out + O_SK; float* ov = p.out + O_SV;
        for (size_t i = gt; i < (size_t)16 * 112 * 256; i += gs) { const size_t b = i / (112 * 256), rem = i - b * (112 * 256); ok[b * 32768 + rem] = ck[b * 32768 + 4096 + rem]; ov[b * 32768 + rem] = cv[b * 32768 + 4096 + rem]; }
    }
}

struct GdnItem { int b, h, n, rowbase, ntok; bool samp; };
__device__ __forceinline__ GdnItem gdn_decode(int ch) { GdnItem it; it.samp = ch >= 4096;
    if (!it.samp) { it.b = ch >> 9; it.h = (ch >> 7) & 3; it.n = ch & 127; it.rowbase = it.b * 8192 + it.n * 64; it.ntok = 64; } else { const int s = ch - 4096; it.b = s >> 2; it.h = s & 3; it.n = 0; it.rowbase = TP + it.b * 16; it.ntok = 16; }
    return it; }
__device__ __forceinline__ void gdn_s1(KPR p, int ch, LAS unsigned char* buf, int t) {
    const GdnItem it = gdn_decode(ch); const int h = it.h, b = it.b, n = it.n, rowbase = it.rowbase, ntok = it.ntok; const bool samp = it.samp;
    LAS bf16_t* qn = (LAS bf16_t*)buf; LAS bf16_t* kn = qn + 64 * 136; LAS bf16_t* vv = kn + 64 * 136;
    const bf16_t* qkvraw = (const bf16_t*)(p.ws + WS_R2); const float* cw = p.in[22]; const float* cst = p.in[5];
    const int cg = t & 31, t0 = (t >> 5) * 8;
    u32x2 raw[3][11];
#pragma unroll
    for (int part = 0; part < 3; ++part) { const int cbase = part * 512 + h * 128 + cg * 4;
#pragma unroll
        for (int jj = 0; jj < 11; ++jj) { const int ti = t0 - 3 + jj, tabs = n * 64 + ti; raw[part][jj] = (u32x2){0u, 0u};
            if (ti < ntok) {
                if (tabs >= 0) raw[part][jj] = *(const u32x2*)(qkvraw + (size_t)(rowbase + ti) * 1536 + cbase);
                else if (samp) { const f32x4 f = *(const f32x4*)(cst + (size_t)(b * 3 + 3 + tabs) * 1536 + cbase); raw[part][jj].x = cvt_pk_bf16(f[0], f[1]); raw[part][jj].y = cvt_pk_bf16(f[2], f[3]); } } }
    }
#pragma unroll
    for (int part = 0; part < 3; ++part) {
        f32x4 xr[11]; f32x4 cwp[4];
#pragma unroll
        for (int j = 0; j < 4; ++j) cwp[j] = *(const f32x4*)(cw + j * 1536 + part * 512 + h * 128 + cg * 4);
#pragma unroll
        for (int jj = 0; jj < 11; ++jj) xr[jj] = (f32x4){bflo(raw[part][jj].x), bfhi(raw[part][jj].x), bflo(raw[part][jj].y), bfhi(raw[part][jj].y)};
        LAS bf16_t* dstm = (part == 0 ? qn : (part == 1 ? kn : vv)) + cg * 4;
        f32x4 y[8]; float ss[8];
#pragma unroll
        for (int tk = 0; tk < 8; ++tk) { const int tok = t0 + tk;
            y[tk] = xr[tk] * cwp[0] + xr[tk + 1] * cwp[1] + xr[tk + 2] * cwp[2] + xr[tk + 3] * cwp[3];
            if (tok >= ntok) y[tk] = (f32x4){0.f, 0.f, 0.f, 0.f};
#pragma unroll
            for (int e = 0; e < 4; ++e) y[tk][e] = silu_f(y[tk][e]);
            ss[tk] = (y[tk][0] * y[tk][0] + y[tk][1] * y[tk][1]) + (y[tk][2] * y[tk][2] + y[tk][3] * y[tk][3]); }
        if (part < 2) {
#pragma unroll
            for (int o = 1; o < 32; o <<= 1)
#pragma unroll
                for (int tk = 0; tk < 8; ++tk) ss[tk] += __shfl_xor(ss[tk], o); }
#pragma unroll
        for (int tk = 0; tk < 8; ++tk) { float sc = 1.0f;
            if (part < 2) { sc = rsqrtf(ss[tk] + 1e-6f); if (part == 0) sc *= 0.08838834764831845f; }
            u32x2 wv; wv.x = cvt_pk_bf16(y[tk][0] * sc, y[tk][1] * sc); wv.y = cvt_pk_bf16(y[tk][2] * sc, y[tk][3] * sc);
            *(LAS u32x2*)(dstm + (t0 + tk) * 136) = wv; }
    }
}
__device__ __forceinline__ void gdn_prep_phase(KPR p, LAS unsigned char* lds, int bx, int G) {
    const int tid = ltid(), lane = tid & 63, w = tid >> 6, fr = lane & 15, fq = lane >> 4;
    LAS float* Am = (LAS float*)(lds + 2 * 52224); LAS float* gcs = Am + 4096; LAS float* betas = gcs + 64; LAS float* egc = betas + 64;
    const float* gates = (const float*)(p.ws + WS_GATES);
    int ch = bx; if (ch >= NCH) return;
    if (tid >= 256) gdn_s1(p, ch, lds, tid - 256);
    for (int k = 0;; ++k) {
        LAS unsigned char* cur = lds + (k & 1) * 52224; LAS unsigned char* nxt = lds + ((k + 1) & 1) * 52224;
        LAS bf16_t* qn = (LAS bf16_t*)cur; LAS bf16_t* kn = qn + 64 * 136; LAS bf16_t* vv = kn + 64 * 136;
        const GdnItem it = gdn_decode(ch); const int h = it.h, rowbase = it.rowbase, ntok = it.ntok;
        unsigned char* cb = p.ws + WS_R3 + (size_t)ch * GDN_CH_BYTES;
        bf16_t* o_uT = (bf16_t*)cb; bf16_t* o_w = (bf16_t*)(cb + 16384); bf16_t* o_qd = (bf16_t*)(cb + 32768); bf16_t* o_kdT = (bf16_t*)(cb + 49152); bf16_t* o_attn = (bf16_t*)(cb + 65536);
        __syncthreads();
        if (tid < 64) { float gg = 0.f, be = 0.f;
            if (tid < ntok) { const float a = gates[(size_t)(rowbase + tid) * 8 + 4 + h], bb = gates[(size_t)(rowbase + tid) * 8 + h];
                const float xs = a + p.in[24][h]; const float sp = xs > 20.f ? xs : log1pf(expf(xs)); gg = -expf(p.in[23][h]) * sp; be = 1.0f / (1.0f + expf(-bb)); }
            float gc = gg;
#pragma unroll
            for (int o = 1; o < 64; o <<= 1) { const float v = __shfl_up(gc, o); if (lane >= o) gc += v; }
            gcs[tid] = gc; betas[tid] = be; egc[tid] = expf(gc);
            if (tid == 63) ((float*)(p.ws + WS_GL))[ch] = expf(gc); }
        __syncthreads();
        {
            const int rt = w & 3, kind = w >> 2; LAS bf16_t* am = kind ? qn : kn;
            bf16x8 af[4];
#pragma unroll
            for (int ks = 0; ks < 4; ++ks) af[ks] = *(const LAS bf16x8*)(am + (16 * rt + fr) * 136 + 32 * ks + 8 * fq);
#pragma unroll
            for (int ct = 0; ct < 4; ++ct) {
                f32x4 acc = (f32x4){0.f, 0.f, 0.f, 0.f};
                if (ct <= rt) {
#pragma unroll
                    for (int ks = 0; ks < 4; ++ks) { const bf16x8 bfr = *(const LAS bf16x8*)(kn + (16 * ct + fr) * 136 + 32 * ks + 8 * fq); acc = __builtin_amdgcn_mfma_f32_16x16x32_bf16(af[ks], bfr, acc, 0, 0, 0); } }
                const int col = 16 * ct + fr; const float gcc = gcs[col];
#pragma unroll
                for (int j = 0; j < 4; ++j) { const int row = 16 * rt + 4 * fq + j; const float dec = __expf(fminf(gcs[row] - gcc, 0.f));
                    if (kind == 0) Am[row * 64 + col] = (row > col) ? betas[row] * acc[j] * dec : 0.f;
                    else o_attn[row * 64 + col] = f2bf((row >= col) ? acc[j] * dec : 0.f); }
            }
        }
        __syncthreads();
        const int chn = ch + G;
        int vz = 0; asm volatile("" : "+v"(vz));
        if (tid < 256) {
            const int c = tid; const bool isu = c < 128; const int cc = isu ? c : c - 128; LAS bf16_t* srcm = isu ? vv : kn;
            LAS float* AmV = Am + vz; LAS float* beV = betas + vz; LAS float* egV = egc + vz;
            float X[64];
#pragma unroll
            for (int i = 0; i < 64; ++i) {
                float r = bf2f(srcm[i * 136 + cc]) * beV[i]; if (!isu) r *= egV[i];
                float pa[4] = {0.f, 0.f, 0.f, 0.f};
#pragma unroll
                for (int j4 = 0; j4 < (i + 3) / 4; ++j4) { const f32x4 a4 = *(const LAS f32x4*)(AmV + i * 64 + j4 * 4);
#pragma unroll
                    for (int jj = 0; jj < 4; ++jj) { if (j4 * 4 + jj < i) pa[jj] += a4[jj] * X[j4 * 4 + jj]; } }
                r -= (pa[0] + pa[1]) + (pa[2] + pa[3]);
                asm volatile("" : "+v"(r) :: "memory"); X[i] = r; }
            if (isu) {
#pragma unroll
                for (int i8 = 0; i8 < 8; ++i8) { u32x4 wv; wv.x = cvt_pk_bf16(X[i8 * 8], X[i8 * 8 + 1]); wv.y = cvt_pk_bf16(X[i8 * 8 + 2], X[i8 * 8 + 3]); wv.z = cvt_pk_bf16(X[i8 * 8 + 4], X[i8 * 8 + 5]); wv.w = cvt_pk_bf16(X[i8 * 8 + 6], X[i8 * 8 + 7]);
                    *(u32x4*)(o_uT + cc * 64 + i8 * 8) = wv; } }
            else {
#pragma unroll
                for (int i = 0; i < 64; ++i) o_w[i * 128 + cc] = f2bf(X[i]); }
        } else {
            const int c = tid - 256;
            LAS float* gcV = gcs + vz; LAS float* egV = egc + vz;
            if (c < 128) { const float gl_ = gcV[63];
#pragma unroll
                for (int i8 = 0; i8 < 8; ++i8) { float v[8];
#pragma unroll
                    for (int e = 0; e < 8; ++e) { const int tk = i8 * 8 + e; v[e] = bf2f(kn[tk * 136 + c]) * __expf(gl_ - gcV[tk]); }
                    u32x4 wv; wv.x = cvt_pk_bf16(v[0], v[1]); wv.y = cvt_pk_bf16(v[2], v[3]); wv.z = cvt_pk_bf16(v[4], v[5]); wv.w = cvt_pk_bf16(v[6], v[7]);
                    *(u32x4*)(o_kdT + c * 64 + i8 * 8) = wv; } }
            else { const int cc = c - 128;
#pragma unroll 8
                for (int i = 0; i < 64; ++i) o_qd[i * 128 + cc] = f2bf(bf2f(qn[i * 136 + cc]) * egV[i]); }
            if (chn < NCH) gdn_s1(p, chn, nxt, c);
        }
        if (chn >= NCH) break;
        ch = chn;
    }
    __syncthreads();
}

struct GFrag { bf16x8 Aw[4], Aq[4], Aa[2], Ak[2]; bf16x4 u[2]; float gl; };
__device__ __forceinline__ void gdn_load(GFrag& f, const unsigned char* ws, int ch, int w, int sl, int fr, int fq) {
    const unsigned char* cb = ws + WS_R3 + (size_t)ch * GDN_CH_BYTES;
    const bf16_t* uT = (const bf16_t*)cb; const bf16_t* wm = (const bf16_t*)(cb + 16384); const bf16_t* qd = (const bf16_t*)(cb + 32768); const bf16_t* kdT = (const bf16_t*)(cb + 49152); const bf16_t* at = (const bf16_t*)(cb + 65536);
    if (w < 4) {
#pragma unroll
        for (int ks = 0; ks < 4; ++ks) { f.Aw[ks] = *(const bf16x8*)(wm + (16 * w + fr) * 128 + 32 * ks + 8 * fq); f.Aq[ks] = *(const bf16x8*)(qd + (16 * w + fr) * 128 + 32 * ks + 8 * fq); }
#pragma unroll
        for (int k2 = 0; k2 < 2; ++k2) f.Aa[k2] = *(const bf16x8*)(at + (16 * w + fr) * 64 + 32 * k2 + 8 * fq);
#pragma unroll
        for (int dt = 0; dt < 2; ++dt) f.u[dt] = *(const bf16x4*)(uT + (sl * 32 + 16 * dt + fr) * 64 + 16 * w + 4 * fq);
    }
#pragma unroll
    for (int k2 = 0; k2 < 2; ++k2) f.Ak[k2] = *(const bf16x8*)(kdT + (16 * w + fr) * 64 + 32 * k2 + 8 * fq);
    f.gl = ((const float*)(ws + WS_GL))[ch];
}
__device__ __forceinline__ void gdn_step(const GFrag& cur, f32x4 (&accS)[2], LAS unsigned char* ST, LAS unsigned char* VN, bf16_t* gorow, int ntok, int w, int fr, int fq) {
    f32x4 accO[2];
    if (w < 4) {
        f32x4 accV[2];
#pragma unroll
        for (int dt = 0; dt < 2; ++dt) { accV[dt] = (f32x4){0.f, 0.f, 0.f, 0.f}; accO[dt] = (f32x4){0.f, 0.f, 0.f, 0.f}; }
#pragma unroll
        for (int ks = 0; ks < 4; ++ks)
#pragma unroll
            for (int dt = 0; dt < 2; ++dt) { const bf16x8 bs = *(const LAS bf16x8*)(ST + (16 * dt + fr) * 272 + (32 * ks + 8 * fq) * 2);
                accV[dt] = __builtin_amdgcn_mfma_f32_16x16x32_bf16(cur.Aw[ks], bs, accV[dt], 0, 0, 0); accO[dt] = __builtin_amdgcn_mfma_f32_16x16x32_bf16(cur.Aq[ks], bs, accO[dt], 0, 0, 0); }
#pragma unroll
        for (int dt = 0; dt < 2; ++dt) { const float v0 = bf2f((bf16_t)cur.u[dt][0]) - accV[dt][0], v1 = bf2f((bf16_t)cur.u[dt][1]) - accV[dt][1], v2 = bf2f((bf16_t)cur.u[dt][2]) - accV[dt][2], v3 = bf2f((bf16_t)cur.u[dt][3]) - accV[dt][3];
            u32x2 wv; wv.x = cvt_pk_bf16(v0, v1); wv.y = cvt_pk_bf16(v2, v3); *(LAS u32x2*)(VN + (16 * dt + fr) * 144 + (16 * w + 4 * fq) * 2) = wv; }
    }
    LDS_BARRIER();
    if (w < 4) {
#pragma unroll
        for (int dt = 0; dt < 2; ++dt) {
#pragma unroll
            for (int k2 = 0; k2 < 2; ++k2) { const bf16x8 bv = *(const LAS bf16x8*)(VN + (16 * dt + fr) * 144 + (32 * k2 + 8 * fq) * 2); accO[dt] = __builtin_amdgcn_mfma_f32_16x16x32_bf16(cur.Aa[k2], bv, accO[dt], 0, 0, 0); }
#pragma unroll
            for (int j = 0; j < 4; ++j) { const int tok = 16 * w + 4 * fq + j; if (tok < ntok) gorow[(size_t)tok * 512 + 16 * dt] = f2bf(accO[dt][j]); } }
    }
#pragma unroll
    for (int d2 = 0; d2 < 2; ++d2) { accS[d2] = accS[d2] * cur.gl;
#pragma unroll
        for (int k2 = 0; k2 < 2; ++k2) { const bf16x8 bv = *(const LAS bf16x8*)(VN + (16 * d2 + fr) * 144 + (32 * k2 + 8 * fq) * 2); accS[d2] = __builtin_amdgcn_mfma_f32_16x16x32_bf16(cur.Ak[k2], bv, accS[d2], 0, 0, 0); }
        u32x2 wv; wv.x = cvt_pk_bf16(accS[d2][0], accS[d2][1]); wv.y = cvt_pk_bf16(accS[d2][2], accS[d2][3]);
        *(LAS u32x2*)(ST + (16 * d2 + fr) * 272 + (16 * w + 4 * fq) * 2) = wv; }
    LDS_BARRIER();
}
__device__ __forceinline__ void gdn_chain_item(KPR p, int item, LAS unsigned char* lds) {
    const int tid = ltid(), lane = tid & 63, w = __builtin_amdgcn_readfirstlane(tid >> 6), fr = lane & 15, fq = lane >> 4;
    int bh, sl, nsteps, ch0, rowbase, h, ntok; float* sout; const float* sin = nullptr;
    if (item < 128) { bh = (item & 7) + 8 * (item >> 5); sl = (item >> 3) & 3; nsteps = 128;
        ch0 = bh * 128; rowbase = (bh >> 2) * 8192; h = bh & 3; ntok = 64; sout = p.out + O_PGDN + (size_t)bh * 16384; }
    else { const int j = item - 128; bh = j >> 2; sl = j & 3; nsteps = 1; ch0 = 4096 + bh; rowbase = TP + (bh >> 2) * 16; h = bh & 3; ntok = 16; sout = p.out + O_SGDN + (size_t)bh * 16384; sin = p.in[4] + (size_t)bh * 16384; }
    LAS unsigned char* ST = lds; LAS unsigned char* VN = lds + 32 * 272;
    bf16_t* go = (bf16_t*)(p.ws + WS_R4) + (size_t)rowbase * 512 + h * 128 + sl * 32 + fr;
    const unsigned char* ws = p.ws; const int last = nsteps - 1;
    f32x4 accS[2];
#pragma unroll
    for (int d2 = 0; d2 < 2; ++d2) {
#pragma unroll
        for (int j = 0; j < 4; ++j) accS[d2][j] = sin ? sin[(size_t)(16 * w + 4 * fq + j) * 128 + sl * 32 + 16 * d2 + fr] : 0.f;
        u32x2 wv; wv.x = cvt_pk_bf16(accS[d2][0], accS[d2][1]); wv.y = cvt_pk_bf16(accS[d2][2], accS[d2][3]);
        *(LAS u32x2*)(ST + (16 * d2 + fr) * 272 + (16 * w + 4 * fq) * 2) = wv; }
    GFrag f0, f1, f2;
    gdn_load(f0, ws, ch0, w, sl, fr, fq); gdn_load(f1, ws, ch0 + (1 < last ? 1 : last), w, sl, fr, fq);
    LDS_BARRIER();
#define CLAMPN(x) ((x) < last ? (x) : last)
    for (int n = 0; n < nsteps; n += 3) {
        gdn_load(f2, ws, ch0 + CLAMPN(n + 2), w, sl, fr, fq); __builtin_amdgcn_sched_barrier(0);
        gdn_step(f0, accS, ST, VN, go + (size_t)n * 64 * 512, ntok, w, fr, fq);
        if (n + 1 < nsteps) { gdn_load(f0, ws, ch0 + CLAMPN(n + 3), w, sl, fr, fq); __builtin_amdgcn_sched_barrier(0);
            gdn_step(f1, accS, ST, VN, go + (size_t)(n + 1) * 64 * 512, ntok, w, fr, fq); }
        if (n + 2 < nsteps) { gdn_load(f1, ws, ch0 + CLAMPN(n + 4), w, sl, fr, fq); __builtin_amdgcn_sched_barrier(0);
            gdn_step(f2, accS, ST, VN, go + (size_t)(n + 2) * 64 * 512, ntok, w, fr, fq); }
    }
#undef CLAMPN
#pragma unroll
    for (int d2 = 0; d2 < 2; ++d2)
#pragma unroll
        for (int j = 0; j < 4; ++j) sout[(size_t)(16 * w + 4 * fq + j) * 128 + sl * 32 + 16 * d2 + fr] = accS[d2][j];
    __syncthreads();
}

__device__ __forceinline__ void s5_scan_prompt(KPR p, int item) {
    const int idx = item * 512 + ltid(), pp = idx & 63, g = (idx >> 6) & 31, b = idx >> 11;
    const float* ss = (const float*)(p.ws + WS_R1) + ((size_t)g * CRG + b * 512) * 128; bf16_t* uc = (bf16_t*)(p.ws + WS_R5) + ((size_t)g * CRG + b * 512) * 384 + 256;
    const float* lp = (const float*)(p.ws + WS_LP16) + g * 128 + pp * 2; const float lr = lp[0], li = lp[1];
    float xr = 0.f, xi = 0.f;
    float sr[8], si[8], nr[8], ni[8];
#pragma unroll
    for (int k = 0; k < 8; ++k) { sr[k] = ss[(size_t)k * 128 + pp]; si[k] = ss[(size_t)k * 128 + 64 + pp]; }
    for (int n0 = 0; n0 < 512; n0 += 8) {
        const int nn = (n0 + 8 < 512) ? n0 + 8 : n0;
#pragma unroll
        for (int k = 0; k < 8; ++k) { nr[k] = ss[(size_t)(nn + k) * 128 + pp]; ni[k] = ss[(size_t)(nn + k) * 128 + 64 + pp]; }
#pragma unroll
        for (int k = 0; k < 8; ++k) { uc[(size_t)(n0 + k) * 384 + pp] = f2bf(xr); uc[(size_t)(n0 + k) * 384 + 64 + pp] = f2bf(xi);
            const float tr = lr * xr - li * xi + sr[k], ti = lr * xi + li * xr + si[k]; xr = tr; xi = ti; }
#pragma unroll
        for (int k = 0; k < 8; ++k) { sr[k] = nr[k]; si[k] = ni[k]; }
    }
    p.out[O_PS5RE + (size_t)(b * 32 + g) * 64 + pp] = xr; p.out[O_PS5IM + (size_t)(b * 32 + g) * 64 + pp] = xi;
}
__device__ __forceinline__ void s5_scan_sample(KPR p, int item) {
    const int idx = item * 512 + threadIdx.x, pp = idx & 63, g = (idx >> 6) & 31, b = idx >> 11;
    const size_t row = (size_t)g * CRG + 4096 + b;
    const float* ss = (const float*)(p.ws + WS_R1) + row * 128; bf16_t* uc = (bf16_t*)(p.ws + WS_R5) + row * 384 + 256;
    const float* lp = (const float*)(p.ws + WS_LP16) + g * 128 + pp * 2; const float lr = lp[0], li = lp[1];
    const float xr = p.in[2][(size_t)(b * 32 + g) * 64 + pp], xi = p.in[3][(size_t)(b * 32 + g) * 64 + pp];
    uc[pp] = f2bf(xr); uc[64 + pp] = f2bf(xi);
    p.out[O_SS5RE + (size_t)(b * 32 + g) * 64 + pp] = lr * xr - li * xi + ss[pp]; p.out[O_SS5IM + (size_t)(b * 32 + g) * 64 + pp] = lr * xi + li * xr + ss[64 + pp];
}

__device__ __forceinline__ void attn_item(KPR p, int item, LAS unsigned char* lds) {
    const int tid = ltid(), lane = tid & 63, w = __builtin_amdgcn_readfirstlane(tid >> 6), fr = lane & 15, fq = lane >> 4;
    const bf16_t* Q = (const bf16_t*)(p.ws + WS_R1); const bf16_t* KB = (const bf16_t*)(p.ws + WS_R5); const bf16_t* VB = KB + (size_t)T * 256; bf16_t* AO = (bf16_t*)(p.ws + WS_R2);
    LAS unsigned char* Ks = lds; LAS unsigned char* Vt = lds + 192 * 144;
    int kvh, qrow0, nq, nkt, nvalid; const bool samp = item >= 4096;
    if (!samp) { kvh = item & 3; const int c = (item >> 2) & 127, b = item >> 9; const int c0 = c >= 2 ? c - 2 : 0; qrow0 = b * 8192 + c * 64; nq = 64; nvalid = (c - c0 + 1) * 64; nkt = nvalid >> 4;
        const int krow0 = b * 8192 + c0 * 64;
        for (int e = tid; e < nvalid * 8; e += 512) { const int row = e >> 3, pc = e & 7;
            const u32x4 kw = *(const u32x4*)(KB + (size_t)(krow0 + row) * 256 + kvh * 64 + pc * 8); *(LAS u32x4*)(Ks + row * 144 + pc * 16) = kw;
            const u32x4 vw = *(const u32x4*)(VB + (size_t)(krow0 + row) * 256 + kvh * 64 + pc * 8);
            const unsigned vs[4] = {vw.x, vw.y, vw.z, vw.w};
#pragma unroll
            for (int jj = 0; jj < 4; ++jj) { *(LAS bf16_t*)(Vt + (pc * 8 + 2 * jj) * 400 + row * 2) = (bf16_t)(vs[jj] & 0xffffu); *(LAS bf16_t*)(Vt + (pc * 8 + 2 * jj + 1) * 400 + row * 2) = (bf16_t)(vs[jj] >> 16); } } }
    else { const int j = item - 4096; kvh = j & 3; const int b = j >> 2; qrow0 = TP + b * 16; nq = 16; nvalid = 144; nkt = 10;
        const float* ck = p.in[6]; const float* cv = p.in[7];
        for (int e = tid; e < 160 * 8; e += 512) { const int row = e >> 3, pc = e & 7; u32x4 kw = (u32x4){0u, 0u, 0u, 0u}, vw = (u32x4){0u, 0u, 0u, 0u};
            if (row < 128) { const float* kp = ck + ((size_t)(b * 128 + row) * 4 + kvh) * 64 + pc * 8; const float* vp = cv + ((size_t)(b * 128 + row) * 4 + kvh) * 64 + pc * 8;
                kw = pack8(*(const f32x4*)kp, *(const f32x4*)(kp + 4)); vw = pack8(*(const f32x4*)vp, *(const f32x4*)(vp + 4)); }
            else if (row < 144) { kw = *(const u32x4*)(KB + (size_t)(qrow0 + row - 128) * 256 + kvh * 64 + pc * 8); vw = *(const u32x4*)(VB + (size_t)(qrow0 + row - 128) * 256 + kvh * 64 + pc * 8); }
            *(LAS u32x4*)(Ks + row * 144 + pc * 16) = kw;
            const unsigned vs[4] = {vw.x, vw.y, vw.z, vw.w};
#pragma unroll
            for (int jj = 0; jj < 4; ++jj) { *(LAS bf16_t*)(Vt + (pc * 8 + 2 * jj) * 400 + row * 2) = (bf16_t)(vs[jj] & 0xffffu); *(LAS bf16_t*)(Vt + (pc * 8 + 2 * jj + 1) * 400 + row * 2) = (bf16_t)(vs[jj] >> 16); } } }
    const int hg = w >> 1, th = w & 1, head = kvh * 4 + hg;
    bf16x8 qf[2][2];
#pragma unroll
    for (int qt = 0; qt < 2; ++qt)
#pragma unroll
        for (int ks = 0; ks < 2; ++ks) { const int tok = 32 * th + 16 * qt + fr; qf[qt][ks] = (bf16x8){0, 0, 0, 0, 0, 0, 0, 0};
            if (tok < nq) qf[qt][ks] = *(const bf16x8*)(Q + (size_t)(qrow0 + tok) * 1024 + head * 64 + 32 * ks + 8 * fq); }
    const float sink = p.in[30][head];
    __syncthreads();
    f32x4 sc[12][2];
#pragma unroll
    for (int kt = 0; kt < 12; ++kt) {
#pragma unroll
        for (int qt = 0; qt < 2; ++qt) sc[kt][qt] = (f32x4){0.f, 0.f, 0.f, 0.f};
        if (kt < nkt) {
#pragma unroll
            for (int ks = 0; ks < 2; ++ks) { const bf16x8 kf = *(const LAS bf16x8*)(Ks + (16 * kt + fr) * 144 + (32 * ks + 8 * fq) * 2);
#pragma unroll
                for (int qt = 0; qt < 2; ++qt) sc[kt][qt] = __builtin_amdgcn_mfma_f32_16x16x32_bf16(kf, qf[qt][ks], sc[kt][qt], 0, 0, 0); } }
    }
    float mx[2] = {sink, sink};
#pragma unroll
    for (int kt = 0; kt < 12; ++kt)
#pragma unroll
        for (int qt = 0; qt < 2; ++qt)
#pragma unroll
            for (int j = 0; j < 4; ++j) { const bool ok = (kt < nkt) && (16 * kt + 4 * fq + j < nvalid); if (!ok) sc[kt][qt][j] = -1e30f; mx[qt] = fmaxf(mx[qt], sc[kt][qt][j]); }
    float sm[2];
#pragma unroll
    for (int qt = 0; qt < 2; ++qt) { mx[qt] = fmaxf(mx[qt], __shfl_xor(mx[qt], 16)); mx[qt] = fmaxf(mx[qt], __shfl_xor(mx[qt], 32)); sm[qt] = 0.f; }
#pragma unroll
    for (int kt = 0; kt < 12; ++kt)
#pragma unroll
        for (int qt = 0; qt < 2; ++qt)
#pragma unroll
            for (int j = 0; j < 4; ++j) { const float e = __expf(sc[kt][qt][j] - mx[qt]); sc[kt][qt][j] = e; sm[qt] += e; }
    float inv[2];
#pragma unroll
    for (int qt = 0; qt < 2; ++qt) { sm[qt] += __shfl_xor(sm[qt], 16); sm[qt] += __shfl_xor(sm[qt], 32); inv[qt] = 1.0f / (sm[qt] + __expf(sink - mx[qt])); }
    f32x4 oacc[4][2];
#pragma unroll
    for (int dd = 0; dd < 4; ++dd)
#pragma unroll
        for (int qt = 0; qt < 2; ++qt) oacc[dd][qt] = (f32x4){0.f, 0.f, 0.f, 0.f};
#pragma unroll
    for (int kp = 0; kp < 6; ++kp) {
        if (2 * kp < nkt) {
            bf16x8 pf[2];
#pragma unroll
            for (int qt = 0; qt < 2; ++qt) { const f32x4 a = sc[2 * kp][qt] * inv[qt], b2 = sc[2 * kp + 1][qt] * inv[qt]; const u32x4 pw = pack8(a, b2); pf[qt] = __builtin_bit_cast(bf16x8, pw); }
#pragma unroll
            for (int dd = 0; dd < 4; ++dd) { const bf16x4 v0 = *(const LAS bf16x4*)(Vt + (16 * dd + fr) * 400 + (32 * kp + 4 * fq) * 2), v1 = *(const LAS bf16x4*)(Vt + (16 * dd + fr) * 400 + (32 * kp + 16 + 4 * fq) * 2);
                const bf16x8 vf = (bf16x8){v0[0], v0[1], v0[2], v0[3], v1[0], v1[1], v1[2], v1[3]};
#pragma unroll
                for (int qt = 0; qt < 2; ++qt) oacc[dd][qt] = __builtin_amdgcn_mfma_f32_16x16x32_bf16(vf, pf[qt], oacc[dd][qt], 0, 0, 0); } }
    }
#pragma unroll
    for (int qt = 0; qt < 2; ++qt) { const int tok = 32 * th + 16 * qt + fr;
        if (tok < nq) {
#pragma unroll
            for (int dd = 0; dd < 4; ++dd) { u32x2 wv; wv.x = cvt_pk_bf16(oacc[dd][qt][0], oacc[dd][qt][1]); wv.y = cvt_pk_bf16(oacc[dd][qt][2], oacc[dd][qt][3]);
                *(u32x2*)(AO + (size_t)(qrow0 + tok) * 1024 + head * 64 + 16 * dd + 4 * fq) = wv; } } }
    __syncthreads();
}

__global__ void __launch_bounds__(512) fwd_kernel(Params p_arg) {
    extern __shared__ __attribute__((aligned(16))) unsigned char lds_raw[];
    LAS unsigned char* lds = (LAS unsigned char*)lds_raw;
    cg::grid_group grid = cg::this_grid();
    const int G = gridDim.x, bx = blockIdx.x, tid = threadIdx.x;
    const int lo = p_arg.ph_lo, hi = p_arg.ph_hi;
#ifndef PHMASK
#define PHMASK 0x7fff
#endif
#define IN(k) (((PHMASK >> (k)) & 1) && lo <= (k) && (k) < hi)
    unsigned* const barctr = (unsigned*)(p_arg.ws + WS_BAR); unsigned nbar = 0;
#define GRIDBAR() do { __syncthreads(); ++nbar; \
        if (tid == 0) { const unsigned target = nbar * (unsigned)G; __builtin_amdgcn_fence(__ATOMIC_RELEASE, "agent"); __hip_atomic_fetch_add(barctr, 1u, __ATOMIC_RELAXED, __HIP_MEMORY_SCOPE_AGENT); \
            while (__hip_atomic_load(barctr, __ATOMIC_RELAXED, __HIP_MEMORY_SCOPE_AGENT) < target) __builtin_amdgcn_s_sleep(1); \
            __builtin_amdgcn_fence(__ATOMIC_ACQUIRE, "agent"); } \
        __syncthreads(); } while (0)
#define SEAM(k) do { if (IN(k) && IN((k) + 1)) { if ((k) <= CG_SEAMS) grid.sync(); else GRIDBAR(); } } while (0)
#define PHASE_BEGIN(k) _Pragma("unroll 1") for (int rep_ = 0; rep_ < ((((REP_MASK) >> (k)) & 1) ? 2 : 1); ++rep_) { if (rep_) GRIDBAR();
#define PHASE_END }
#define R1 ((bf16_t*)(p.ws + WS_R1))
#define R2 ((bf16_t*)(p.ws + WS_R2))
#define ACT ((bf16_t*)(p.ws + WS_R3))
#define ZG ((bf16_t*)(p.ws + WS_R3 + GDN_BYTES))
#define XB ((bf16_t*)(p.ws + WS_R4))
#define GO XB
#define ZS5 (XB + (size_t)T * 512)
#define UCAT ((bf16_t*)(p.ws + WS_R5))
#define SUMSQ ((float*)(p.ws + WS_SUMSQ))
#define GATES ((float*)(p.ws + WS_GATES))
    PHASE_BEGIN(0)
    if (IN(0)) { KPR p = *launder_kp(); phase0(p, lds); }
    PHASE_END
    SEAM(0);
    PHASE_BEGIN(1)
    if (IN(1)) { KPR p = *launder_kp(); pg8::Gemm g{R1, (const bf16_t*)(p.ws + WS_W1T), 1024, 1024, 1024}; pg8::StaticOrder S; S.init(T, 2816, G, bx); Epi1 E{UCAT, R2, ZG, GATES}; pg8::gemm_phase(lds, g, S, E); }
    PHASE_END
    SEAM(1);
    PHASE_BEGIN(2)
    if (IN(2)) { KPR p = *launder_kp();
        { pg8::Gemm g{UCAT, (const bf16_t*)(p.ws + WS_HT), 384, 256, 256}; pg8::GroupOrder S{G, bx}; EpiS E{(float*)(p.ws + WS_R1)}; pg8::gemm_phase(lds, g, S, E); }
        __syncthreads();
        gdn_prep_phase(p, lds, bx, G);
        for (int i = bx * 512 + tid; i < 24 * 3 * 1536; i += G * 512) { const int c = i % 1536, j = (i / 1536) % 3, b = i / 4608;
            if (b < 8) p.out[O_PCONV + (size_t)(b * 3 + j) * 1536 + c] = bf2f(R2[(size_t)(b * 8192 + 8189 + j) * 1536 + c]);
            else p.out[O_SCONV + (size_t)((b - 8) * 3 + j) * 1536 + c] = bf2f(R2[(size_t)(TP + (b - 8) * 16 + 13 + j) * 1536 + c]); }
    }
    PHASE_END
    SEAM(2);
    PHASE_BEGIN(3)
    if (IN(3)) { KPR p = *launder_kp();
        for (int it = bx; it < 480; it += G) {
#ifdef REP_SUB
            if (rep_ == 1 && ((REP_SUB == 1) != (it < 128))) continue;
#endif
            if (it < 128) gdn_chain_item(p, it, lds);
            else if (it < 160) s5_scan_prompt(p, it - 128);
            else if (it < 416) gdn_chain_item(p, it - 160 + 128, lds);
            else s5_scan_sample(p, it - 416);
        }
    }
    PHASE_END
    SEAM(3);
    PHASE_BEGIN(4)
    if (IN(4)) { KPR p = *launder_kp();
        { pg8::Gemm g{UCAT, (const bf16_t*)(p.ws + WS_KGT), 384, 384, 384}; pg8::GroupOrder S{G, bx}; EpiY E{UCAT, p.in[19], ZS5}; pg8::gemm_phase(lds, g, S, E); }
        const float* nw = p.in[25];
        { const int l16 = tid & 15; const f32x4 w0 = *(const f32x4*)(nw + l16 * 8), w1 = *(const f32x4*)(nw + l16 * 8 + 4);
          const size_t gstride = ((size_t)G * 512) >> 4;
          for (size_t gi0 = ((size_t)bx * 512 + tid) >> 4; gi0 < (size_t)T * 4; gi0 += 4 * gstride) {
            u32x4 ow[4], zw[4];
#pragma unroll
            for (int q = 0; q < 4; ++q) { const size_t gi = gi0 + q * gstride; if (gi < (size_t)T * 4) { const size_t r = gi >> 2; const int h = (int)(gi & 3);
                ow[q] = *(const u32x4*)(GO + r * 512 + h * 128 + l16 * 8); zw[q] = *(const u32x4*)(ZG + r * 512 + h * 128 + l16 * 8); } else { ow[q] = (u32x4){0u, 0u, 0u, 0u}; zw[q] = ow[q]; } }
#pragma unroll
            for (int q = 0; q < 4; ++q) { const size_t gi = gi0 + q * gstride; const size_t r = gi >> 2; const int h = (int)(gi & 3);
                f32x4 o0, o1, z0, z1; unpack8(ow[q], o0, o1); unpack8(zw[q], z0, z1);
                float s = (o0[0] * o0[0] + o0[1] * o0[1]) + (o0[2] * o0[2] + o0[3] * o0[3]) + (o1[0] * o1[0] + o1[1] * o1[1]) + (o1[2] * o1[2] + o1[3] * o1[3]);
                s += __shfl_xor(s, 1); s += __shfl_xor(s, 2); s += __shfl_xor(s, 4); s += __shfl_xor(s, 8);
                const float rs = rsqrtf(s * (1.0f / 128.0f) + 1e-6f);
                f32x4 y0, y1;
#pragma unroll
                for (int j = 0; j < 4; ++j) { y0[j] = o0[j] * rs * w0[j] * silu_f(z0[j]); y1[j] = o1[j] * rs * w1[j] * silu_f(z1[j]); }
                if (gi < (size_t)T * 4) *(u32x4*)(R1 + r * 1024 + 512 + h * 128 + l16 * 8) = pack8(y0, y1); } } }
    }
    PHASE_END
    SEAM(4);
    PHASE_BEGIN(5)
    if (IN(5)) { KPR p = *launder_kp(); pg8::Gemm g{ZS5, (const bf16_t*)(p.ws + WS_WGLU), 512, 512, 512}; pg8::StaticOrder S; S.init(T, 512, G, bx); EpiGlu E{ZS5, p.in[21], R1}; pg8::gemm_phase(lds, g, S, E); }
    PHASE_END
    SEAM(5);
    PHASE_BEGIN(6)
    if (IN(6)) { KPR p = *launder_kp(); pg8::Gemm g{R1, (const bf16_t*)(p.ws + WS_WOUT), 1024, 1024, 1024}; pg8::StaticOrder S; S.init(T, 1024, G, bx); EpiRes E{p.in[0], p.in[1], XB, SUMSQ}; pg8::gemm_phase(lds, g, S, E); }
    PHASE_END
    SEAM(6);
    PHASE_BEGIN(7)
    if (IN(7)) { KPR p = *launder_kp(); pg8::Gemm g{XB, (const bf16_t*)(p.ws + WS_WF1_0), 1024, 1024, 1024}; pg8::StaticOrder S; S.init(T, 5632, G, bx); EpiFF E{SUMSQ, ACT}; pg8::gemm_phase(lds, g, S, E); }
    PHASE_END
    SEAM(7);
    PHASE_BEGIN(8)
    if (IN(8)) { KPR p = *launder_kp(); pg8::Gemm g{ACT, (const bf16_t*)(p.ws + WS_WFD_0), 2816, 2816, 2816}; pg8::StaticOrder S; S.init(T, 1024, G, bx); EpiRes E{nullptr, nullptr, XB, SUMSQ + T}; pg8::gemm_phase(lds, g, S, E); }
    PHASE_END
    SEAM(8);
    PHASE_BEGIN(9)
    if (IN(9)) { KPR p = *launder_kp(); pg8::Gemm g{XB, (const bf16_t*)(p.ws + WS_WQKV), 1024, 1024, 1024}; pg8::StaticOrder S; S.init(T, 1536, G, bx);
        EpiQKV E{SUMSQ + T, R1, UCAT, UCAT + (size_t)T * 256, p.out + O_PK, p.out + O_PV, p.out + O_SK, p.out + O_SV}; pg8::gemm_phase(lds, g, S, E); }
    PHASE_END
    SEAM(9);
    PHASE_BEGIN(10)
    if (IN(10)) { KPR p = *launder_kp(); for (int it = bx; it < 4160; it += G) attn_item(p, it, lds); }
    PHASE_END
    SEAM(10);
    PHASE_BEGIN(11)
    if (IN(11)) { KPR p = *launder_kp(); pg8::Gemm g{R2, (const bf16_t*)(p.ws + WS_WO), 1024, 1024, 1024}; pg8::StaticOrder S; S.init(T, 1024, G, bx); EpiRes E{nullptr, nullptr, XB, SUMSQ + 2 * T}; pg8::gemm_phase(lds, g, S, E); }
    PHASE_END
    SEAM(11);
    PHASE_BEGIN(12)
    if (IN(12)) { KPR p = *launder_kp(); pg8::Gemm g{XB, (const bf16_t*)(p.ws + WS_WF1_1), 1024, 1024, 1024}; pg8::StaticOrder S; S.init(T, 5632, G, bx); EpiFF E{SUMSQ + 2 * T, ACT}; pg8::gemm_phase(lds, g, S, E); }
    PHASE_END
    SEAM(12);
    PHASE_BEGIN(13)
    if (IN(13)) { KPR p = *launder_kp(); pg8::Gemm g{ACT, (const bf16_t*)(p.ws + WS_WFD_1), 2816, 2816, 2816}; pg8::StaticOrder S; S.init(T, 1024, G, bx); EpiRes E{nullptr, nullptr, XB, SUMSQ + 3 * T}; pg8::gemm_phase(lds, g, S, E); }
    PHASE_END
    SEAM(13);
    PHASE_BEGIN(14)
    if (IN(14)) { KPR p = *launder_kp();
        const int lane = tid & 63, wid = tid >> 6; const float* nw = p.in[10]; const float* sq = SUMSQ + 3 * T;
        f32x4 wv[4];
#pragma unroll
        for (int i = 0; i < 4; ++i) wv[i] = *(const f32x4*)(nw + lane * 4 + i * 256);
        for (int r = bx * 8 + wid; r < T; r += G * 8) { const float rs = rsqrtf(sq[r] * (1.0f / 1024.0f) + 1e-6f); float* xp = p.out + (size_t)r * 1024; const bf16_t* xs = XB + (size_t)r * 1024;
#pragma unroll
            for (int i = 0; i < 4; ++i) { const u32x2 bw = *(const u32x2*)(xs + lane * 4 + i * 256); const f32x4 v = (f32x4){bflo(bw.x), bfhi(bw.x), bflo(bw.y), bfhi(bw.y)}; *(f32x4*)(xp + lane * 4 + i * 256) = v * rs * wv[i]; } }
    }
    PHASE_END
#undef IN
#undef SEAM
}

extern "C" void kernel_launch(void* const* d_in, const int* in_sizes, int n_in, void* d_out, int out_size, void* d_ws, size_t ws_size, hipStream_t stream) {
    static int grid_blocks = 0;
    if (!grid_blocks) {
        int dev = 0, cus = 0, per_cu = 0;
        hipGetDevice(&dev);
        hipDeviceGetAttribute(&cus, hipDeviceAttributeMultiprocessorCount, dev);
        hipFuncSetAttribute((const void*)fwd_kernel, hipFuncAttributeMaxDynamicSharedMemorySize, LDS_BYTES);
        hipOccupancyMaxActiveBlocksPerMultiprocessor(&per_cu, (const void*)fwd_kernel, 512, LDS_BYTES);
        if (per_cu < 1) per_cu = 1;
        grid_blocks = cus * per_cu;
        if (ws_size < WS_END) fprintf(stderr, "kernel_launch: workspace too small: %zu < %zu\n", ws_size, (size_t)WS_END);
    }
    hipMemsetAsync((unsigned char*)d_ws + WS_BAR, 0, 256, stream);
    Params p{};
    for (int i = 0; i < 35; ++i) p.in[i] = (const float*)d_in[i];
    p.out = (float*)d_out; p.ws = (unsigned char*)d_ws; p.ph_lo = 0; p.ph_hi = PH_HI;
    void* args[] = {&p};
    hipError_t e = hipLaunchCooperativeKernel((const void*)fwd_kernel, dim3(grid_blocks), dim3(512), args, LDS_BYTES, stream);
    if (e != hipSuccess) fprintf(stderr, "cooperative launch failed: %s (grid %d)\n", hipGetErrorString(e), grid_blocks);
}
```

```cpp
#include <hip/hip_runtime.h>
#include <hip/hip_cooperative_groups.h>
#include <cstdio>
namespace cg = cooperative_groups;

#define LAS __attribute__((address_space(3)))
typedef unsigned short bf16_t;
typedef short bf16x8 __attribute__((ext_vector_type(8)));
typedef short bf16x4 __attribute__((ext_vector_type(4)));
typedef float f32x4 __attribute__((ext_vector_type(4)));
typedef unsigned u32x4 __attribute__((ext_vector_type(4)));
typedef unsigned u32x2 __attribute__((ext_vector_type(2)));

constexpr int TP = 65536;
constexpr int TS = 256;
constexpr int T = TP + TS;
constexpr int DM = 1024;
constexpr int NCH = 4160;
constexpr int CRG = 4352;
constexpr int CRV = 4112;

constexpr size_t al256(size_t x) { return (x + 255) & ~(size_t)255; }
constexpr size_t WS_W1T = 0;
constexpr size_t WS_WGLU = WS_W1T + (size_t)2816 * 1024 * 2;
constexpr size_t WS_WOUT = WS_WGLU + (size_t)512 * 512 * 2;
constexpr size_t WS_WF1_0 = WS_WOUT + (size_t)1024 * 1024 * 2;
constexpr size_t WS_WFD_0 = WS_WF1_0 + (size_t)5632 * 1024 * 2;
constexpr size_t WS_WQKV = WS_WFD_0 + (size_t)1024 * 2816 * 2;
constexpr size_t WS_WO = WS_WQKV + (size_t)1536 * 1024 * 2;
constexpr size_t WS_WF1_1 = WS_WO + (size_t)1024 * 1024 * 2;
constexpr size_t WS_WFD_1 = WS_WF1_1 + (size_t)5632 * 1024 * 2;
constexpr size_t WS_KGT = WS_WFD_1 + (size_t)1024 * 2816 * 2;
constexpr size_t WS_HT = WS_KGT + (size_t)32 * 256 * 384 * 2;
constexpr size_t WS_LP16 = WS_HT + (size_t)32 * 256 * 256 * 2;
constexpr size_t WS_SUMSQ = WS_LP16 + (size_t)32 * 64 * 2 * 4;
constexpr size_t WS_GATES = WS_SUMSQ + al256((size_t)4 * T * 4);
constexpr size_t WS_GL = WS_GATES + al256((size_t)T * 8 * 4);
constexpr size_t WS_BAR = WS_GL + al256((size_t)NCH * 4);
constexpr size_t WS_R1 = WS_BAR + 256;
constexpr size_t R1_BYTES = (size_t)T * 1024 * 2;
constexpr size_t WS_R2 = WS_R1 + R1_BYTES;
constexpr size_t R2_BYTES = (size_t)T * 1536 * 2;
constexpr size_t WS_R3 = WS_R2 + R2_BYTES;
constexpr size_t GDN_CH_BYTES = 73728;
constexpr size_t GDN_BYTES = (size_t)NCH * GDN_CH_BYTES;
constexpr size_t R3_BYTES = GDN_BYTES + (size_t)T * 512 * 2;
constexpr size_t WS_R4 = WS_R3 + R3_BYTES;
constexpr size_t R4_BYTES = (size_t)T * 1024 * 2;
constexpr size_t WS_R5 = WS_R4 + R4_BYTES;
constexpr size_t R5_BYTES = (size_t)32 * CRG * 384 * 2;
constexpr size_t WS_END = WS_R5 + R5_BYTES;
static_assert(R3_BYTES >= (size_t)T * 2816 * 2, "ACT fits R3");
static_assert((size_t)32 * CRG * 128 * 4 <= R1_BYTES, "SS fits R1");
static_assert((size_t)T * 512 * 2 <= R5_BYTES, "K|V fit R5");
static_assert(WS_END <= (size_t)1073741824, "workspace");

constexpr size_t O_Y = 0;
constexpr size_t O_PS5RE = 67371008, O_PS5IM = 67387392, O_PGDN = 67403776, O_PCONV = 67928064, O_PK = 67964928, O_PV = 68227072;
constexpr size_t O_SS5RE = 68489216, O_SS5IM = 68521984, O_SGDN = 68554752, O_SCONV = 69603328, O_SK = 69677056, O_SV = 70201344;

constexpr int LDS_BYTES = 131072;
#ifndef CG_SEAMS
#define CG_SEAMS 0
#endif
#ifndef REP_MASK
#define REP_MASK 0
#endif
#ifndef PH_HI
#define PH_HI 15
#endif

struct Params { const float* in[35]; float* out; unsigned char* ws; int ph_lo, ph_hi; };
typedef const __attribute__((address_space(4))) Params& KPR;
typedef const __attribute__((address_space(4))) Params* KPP;
__device__ __forceinline__ int ltid() { int t = threadIdx.x; asm volatile("" : "+v"(t)); return t; }
__device__ __forceinline__ KPP launder_kp() { KPP q = (KPP)__builtin_amdgcn_kernarg_segment_ptr(); asm volatile("" : "+s"(q)); return q; }

typedef float f32x2v __attribute__((ext_vector_type(2)));
typedef __bf16 bf16x2v __attribute__((ext_vector_type(2)));
__device__ __forceinline__ unsigned cvt_pk_bf16(float lo, float hi) { const f32x2v v = {lo, hi}; const bf16x2v b = __builtin_convertvector(v, bf16x2v); return __builtin_bit_cast(unsigned, b); }
__device__ __forceinline__ bf16_t f2bf(float f) { return (bf16_t)(cvt_pk_bf16(f, 0.f) & 0xffffu); }
__device__ __forceinline__ float bf2f(bf16_t b) { return __uint_as_float(((unsigned)b) << 16); }
__device__ __forceinline__ float bflo(unsigned w) { return __uint_as_float(w << 16); }
__device__ __forceinline__ float bfhi(unsigned w) { return __uint_as_float(w & 0xffff0000u); }
__device__ __forceinline__ float silu_f(float x) { return x * __builtin_amdgcn_rcpf(1.0f + __expf(-x)); }
__device__ __forceinline__ float sigmoid_f(float x) { return __builtin_amdgcn_rcpf(1.0f + __expf(-x)); }
__device__ __forceinline__ float gelu_tanh_f(float x) { const float u = 1.5957691216057308f * (x + 0.044715f * x * x * x); return x * __builtin_amdgcn_rcpf(1.0f + __expf(-u)); }
#define LDS_BARRIER() do { asm volatile("s_waitcnt lgkmcnt(0)" ::: "memory"); __builtin_amdgcn_s_barrier(); asm volatile("" ::: "memory"); } while (0)

namespace pg8 {
constexpr int BM = 256, BK = 64, HALF = 128, HTB = HALF * BK * 2, STAGE_BYTES = 8 * HTB, NXCD = 8, WGM = 8;
__device__ __forceinline__ int lds_byte(int r, int c) { const int st = (r >> 4) * 2 + (c >> 5), rr = r & 15, cc = c & 31, ob = rr * 64 + cc * 2; return st * 1024 + (ob ^ (((ob >> 9) & 1) << 5)); }
__device__ __forceinline__ void stage_rc(int b, int& R, int& C) { const int st = b / 1024, sb = b % 1024, swz = sb ^ (((sb >> 9) & 1) << 5); R = (st >> 1) * 16 + swz / 64; C = (st & 1) * 32 + (swz % 64) / 2; }
__device__ __forceinline__ int perm32(int rho) { const int n = rho >> 4, i = rho & 15; return 8 * (i >> 2) + 4 * n + (i & 3); }
struct Unit { int pm, pn; };
struct Gemm { const bf16_t* A; const bf16_t* Bt; int lda, ldb, K; };
struct StaticOrder {
    int nM, nN, nwg, G, c;
    __device__ void init(int M, int N, int G_, int c_) { nM = M / BM; nN = N / BM; nwg = nM * nN; G = G_; c = c_; }
    __device__ bool next(int i, Unit& u) const {
        const long L = (long)i * G + c; if (L >= nwg) return false;
        int wgid = (int)L; { const int q = nwg / NXCD, r = nwg % NXCD, xcd = wgid % NXCD, off = wgid / NXCD; wgid = (xcd < r ? xcd * (q + 1) : r * (q + 1) + (xcd - r) * q) + off; }
        const int nig = WGM * nN, gid = wgid / nig, fm = gid * WGM, gsz = (nM - fm) < WGM ? (nM - fm) : WGM;
        u.pm = fm + ((wgid % nig) % gsz); u.pn = (wgid % nig) / gsz; return true;
    }
};
struct GroupOrder {
    int G, c;
    __device__ bool next(int i, Unit& u) const { const int L = i * G + c; if (L >= 32 * 17) return false; u.pm = L; u.pn = L / 17; return true; }
};

template <class Epi, class Sched>
__device__ __forceinline__ void gemm_phase(LAS unsigned char* lds, const Gemm g, const Sched& S, const Epi& E) {
    const int tid = ltid(), wid = __builtin_amdgcn_readfirstlane(tid >> 6), lane = tid & 63, wr = wid >> 2, wc = wid & 3, fr = lane & 15, fq = lane >> 4;
    const int K = g.K, nt = K / BK;
    unsigned voffA[2], voffB[2];
#pragma unroll
    for (int i = 0; i < 2; ++i) { int R, C; stage_rc(tid * 16 + i * 8192, R, C); const int Rb = Epi::PERM ? ((R & ~31) + perm32(R & 31)) : R;
        voffA[i] = (unsigned)(R * g.lda + C) * 2u; voffB[i] = (unsigned)(Rb * g.ldb + C) * 2u; }
    const size_t kstep = (size_t)(BK * 2);
    const size_t hstepA = (size_t)HALF * g.lda * 2, hstepB = (size_t)HALF * g.ldb * 2;
    const size_t tstepA = 2 * hstepA, tstepB = 2 * hstepB;
    const unsigned ldsw = (unsigned)wid * 1024u;
    const int aoff = lds_byte(wr * 64 + fr, fq * 8), boff = lds_byte(wc * 32 + fr, fq * 8);
#define PG8_SA(b, h) (((b) * 2 + (h)) * HTB)
#define PG8_SB(b, h) ((4 + (b) * 2 + (h)) * HTB)
#define PG8_STAGE(bufoff, gbase, voff) do { _Pragma("unroll") for (int _i = 0; _i < 2; ++_i) \
        __builtin_amdgcn_global_load_lds((const unsigned*)((const char*)(gbase) + (voff)[_i]), (LAS unsigned*)(lds + (bufoff) + ldsw + _i * 8192), 16, 0, 0); } while (0)
#define PG8_LDA(dst, b, h) do { _Pragma("unroll") for (int m = 0; m < 4; ++m) _Pragma("unroll") for (int k = 0; k < 2; ++k) dst[m][k] = *(const LAS bf16x8*)(lds + PG8_SA(b, h) + aoff + m * 2048 + k * 1024); } while (0)
#define PG8_LDB(dst, b, h) do { _Pragma("unroll") for (int n = 0; n < 2; ++n) _Pragma("unroll") for (int k = 0; k < 2; ++k) dst[n][k] = *(const LAS bf16x8*)(lds + PG8_SB(b, h) + boff + n * 2048 + k * 1024); } while (0)
#define PG8_MMA(ai, bj, At, Bt) do { __builtin_amdgcn_s_setprio(1); _Pragma("unroll") for (int m = 0; m < 4; ++m) _Pragma("unroll") for (int n = 0; n < 2; ++n) _Pragma("unroll") for (int k = 0; k < 2; ++k) \
        acc[ai][bj][m][n] = __builtin_amdgcn_mfma_f32_16x16x32_bf16(Bt[n][k], At[m][k], acc[ai][bj][m][n], 0, 0, 0); __builtin_amdgcn_s_setprio(0); } while (0)
#define PG8_WAIT_V(n) asm volatile("s_waitcnt vmcnt(" #n ")" ::: "memory")
#define PG8_WAIT_L(n) asm volatile("s_waitcnt lgkmcnt(" #n ")" ::: "memory")
#define PG8_BAR __builtin_amdgcn_s_barrier()
#define PG8_SCHED __builtin_amdgcn_sched_barrier(0)
    Unit cur, nxt; int ui = 0;
    if (!S.next(0, cur)) return;
    f32x4 acc[2][2][4][2];
#pragma unroll
    for (int a = 0; a < 2; ++a)
#pragma unroll
        for (int b = 0; b < 2; ++b)
#pragma unroll
            for (int m = 0; m < 4; ++m)
#pragma unroll
                for (int n = 0; n < 2; ++n) acc[a][b][m][n] = (f32x4){0.f, 0.f, 0.f, 0.f};
    bf16x8 At[4][2], B0[2][2], B1[2][2];
    const char* cA = (const char*)g.A + (size_t)cur.pm * tstepA; const char* cB = (const char*)g.Bt + (size_t)cur.pn * tstepB;
    PG8_STAGE(PG8_SB(0, 0), cB, voffB); PG8_STAGE(PG8_SB(0, 1), cB + hstepB, voffB); PG8_STAGE(PG8_SA(0, 0), cA, voffA); PG8_STAGE(PG8_SA(0, 1), cA + hstepA, voffA);
    if (wr == 1) PG8_BAR;
    PG8_WAIT_V(2); PG8_BAR;
    PG8_STAGE(PG8_SB(1, 0), cB + kstep, voffB); PG8_STAGE(PG8_SA(1, 0), cA + kstep, voffA); PG8_STAGE(PG8_SB(1, 1), cB + hstepB + kstep, voffB);
    PG8_WAIT_V(6); PG8_BAR;
    for (;;) {
        const bool has_next = S.next(ui + 1, nxt);
        const char* nA = has_next ? (const char*)g.A + (size_t)nxt.pm * tstepA : cA; const char* nB = has_next ? (const char*)g.Bt + (size_t)nxt.pn * tstepB : cB;
        for (int t = 0; t < nt; t += 2) {
            const bool last = (t == nt - 2);
            const char* a1 = cA + (size_t)(t + 1) * kstep;
            const char* a2 = last ? nA : cA + (size_t)(t + 2) * kstep; const char* b2 = last ? nB : cB + (size_t)(t + 2) * kstep;
            const char* a3 = a2 + kstep; const char* b3 = b2 + kstep;
            PG8_LDB(B0, 0, 0); PG8_LDB(B1, 0, 1); PG8_SCHED; PG8_LDA(At, 0, 0); PG8_STAGE(PG8_SA(1, 1), a1 + hstepA, voffA);
            PG8_WAIT_V(8); PG8_WAIT_L(0); PG8_BAR; PG8_MMA(0, 0, At, B0); PG8_MMA(0, 1, At, B1); PG8_BAR; PG8_SCHED;
            PG8_LDA(At, 0, 1); PG8_STAGE(PG8_SB(0, 0), b2, voffB); PG8_STAGE(PG8_SB(0, 1), b2 + hstepB, voffB); PG8_STAGE(PG8_SA(0, 0), a2, voffA);
            PG8_WAIT_V(8); PG8_WAIT_L(0); PG8_BAR; PG8_MMA(1, 0, At, B0); PG8_MMA(1, 1, At, B1); PG8_BAR; PG8_SCHED;
            PG8_LDB(B0, 1, 0); PG8_LDB(B1, 1, 1); PG8_SCHED; PG8_LDA(At, 1, 0); PG8_STAGE(PG8_SA(0, 1), a2 + hstepA, voffA);
            PG8_WAIT_V(8); PG8_WAIT_L(0); PG8_BAR; PG8_MMA(0, 0, At, B0); PG8_MMA(0, 1, At, B1); PG8_BAR; PG8_SCHED;
            PG8_LDA(At, 1, 1); PG8_STAGE(PG8_SB(1, 0), b3, voffB); PG8_STAGE(PG8_SB(1, 1), b3 + hstepB, voffB); PG8_STAGE(PG8_SA(1, 0), a3, voffA);
            PG8_WAIT_V(8); PG8_WAIT_L(0); PG8_BAR; PG8_MMA(1, 0, At, B0); PG8_MMA(1, 1, At, B1); PG8_BAR; PG8_SCHED;
        }
        if (wr == 0) PG8_BAR;
        { const int lE = ltid() & 63; E(acc, cur, wr, wc, lE & 15, lE >> 4); }
        if (!has_next) break;
#pragma unroll
        for (int a = 0; a < 2; ++a)
#pragma unroll
            for (int b = 0; b < 2; ++b)
#pragma unroll
                for (int m = 0; m < 4; ++m)
#pragma unroll
                    for (int n = 0; n < 2; ++n) acc[a][b][m][n] = (f32x4){0.f, 0.f, 0.f, 0.f};
        cur = nxt; cA = nA; cB = nB; ++ui;
        if (wr == 1) PG8_BAR;
    }
    PG8_WAIT_V(0);
    PG8_BAR;
#undef PG8_SA
#undef PG8_SB
#undef PG8_STAGE
#undef PG8_LDA
#undef PG8_LDB
#undef PG8_MMA
#undef PG8_WAIT_V
#undef PG8_WAIT_L
#undef PG8_BAR
#undef PG8_SCHED
}
}
using pg8::Unit;

__device__ __forceinline__ u32x4 pack8(const f32x4 a, const f32x4 b) { u32x4 w; w.x = cvt_pk_bf16(a[0], a[1]); w.y = cvt_pk_bf16(a[2], a[3]); w.z = cvt_pk_bf16(b[0], b[1]); w.w = cvt_pk_bf16(b[2], b[3]); return w; }
__device__ __forceinline__ void unpack8(const u32x4 w, f32x4& a, f32x4& b) { a = (f32x4){bflo(w.x), bfhi(w.x), bflo(w.y), bfhi(w.y)}; b = (f32x4){bflo(w.z), bfhi(w.z), bflo(w.w), bfhi(w.w)}; }

struct Epi1 {
    static constexpr bool PERM = true;
    bf16_t* ucat; bf16_t* qkvraw; bf16_t* zg; float* gates;
    __device__ __forceinline__ void operator()(const f32x4 (&acc)[2][2][4][2], const Unit& u, int wr, int wc, int fr, int fq) const {
        const int row0 = u.pm * 256 + wr * 64 + fr, pn = u.pn;
#pragma unroll
        for (int ai = 0; ai < 2; ++ai)
#pragma unroll
            for (int m = 0; m < 4; ++m) { const int r = row0 + ai * 128 + m * 16;
#pragma unroll
                for (int bj = 0; bj < 2; ++bj) { const int c0 = pn * 256 + bj * 128 + wc * 32 + 8 * fq;
                    if (pn == 10) { if (bj == 0 && wc == 0 && fq == 0) { *(f32x4*)(gates + (size_t)r * 8) = acc[ai][bj][m][0]; *(f32x4*)(gates + (size_t)r * 8 + 4) = acc[ai][bj][m][1]; } }
                    else { const u32x4 w = pack8(acc[ai][bj][m][0], acc[ai][bj][m][1]); bf16_t* dst;
                        if (pn < 2) dst = ucat + ((size_t)((c0 >> 4) * CRG + (r >> 4)) * 384 + (r & 15) * 16 + (c0 & 15));
                        else if (pn < 8) dst = qkvraw + (size_t)r * 1536 + (c0 - 512);
                        else dst = zg + (size_t)r * 512 + (c0 - 2048);
                        *(u32x4*)dst = w; } } }
    }
};
struct EpiS {
    static constexpr bool PERM = false;
    float* ss;
    __device__ __forceinline__ void operator()(const f32x4 (&acc)[2][2][4][2], const Unit& u, int wr, int wc, int fr, int fq) const {
        const int row0 = u.pm * 256 + wr * 64 + fr, col0 = wc * 32 + 4 * fq;
#pragma unroll
        for (int ai = 0; ai < 2; ++ai)
#pragma unroll
            for (int m = 0; m < 4; ++m) { float* rp = ss + (size_t)(row0 + ai * 128 + m * 16) * 128 + col0;
#pragma unroll
                for (int n = 0; n < 2; ++n) *(f32x4*)(rp + n * 16) = acc[ai][0][m][n]; }
    }
};
struct EpiY {
    static constexpr bool PERM = true;
    const bf16_t* ucat; const float* dvec; bf16_t* zs5;
    __device__ __forceinline__ void operator()(const f32x4 (&acc)[2][2][4][2], const Unit& u, int wr, int wc, int fr, int fq) const {
        const int g = u.pn, crow0 = u.pm * 256 + wr * 64 + fr;
        f32x4 dd[2][2];
#pragma unroll
        for (int bj = 0; bj < 2; ++bj) { const int cp = (bj * 128 + wc * 32 + 8 * fq) & 15; dd[bj][0] = *(const f32x4*)(dvec + g * 16 + cp); dd[bj][1] = *(const f32x4*)(dvec + g * 16 + cp + 4); }
#pragma unroll
        for (int ai = 0; ai < 2; ++ai) {
            u32x4 uw[4][2];
#pragma unroll
            for (int m = 0; m < 4; ++m) { const int crow = crow0 + ai * 128 + m * 16, cr = crow - g * CRG;
#pragma unroll
                for (int bj = 0; bj < 2; ++bj) { const int n0 = bj * 128 + wc * 32 + 8 * fq; uw[m][bj] = (u32x4){0u, 0u, 0u, 0u}; if (cr < CRV) uw[m][bj] = *(const u32x4*)(ucat + (size_t)crow * 384 + n0); } }
#pragma unroll
            for (int m = 0; m < 4; ++m) { const int crow = crow0 + ai * 128 + m * 16, cr = crow - g * CRG;
                if (cr < CRV) {
#pragma unroll
                    for (int bj = 0; bj < 2; ++bj) { const int n0 = bj * 128 + wc * 32 + 8 * fq, tl = n0 >> 4, cp = n0 & 15;
                        f32x4 u0, u1; unpack8(uw[m][bj], u0, u1);
                        f32x4 y0 = acc[ai][bj][m][0] + dd[bj][0] * u0, y1 = acc[ai][bj][m][1] + dd[bj][1] * u1;
#pragma unroll
                        for (int j = 0; j < 4; ++j) { y0[j] = gelu_tanh_f(y0[j]); y1[j] = gelu_tanh_f(y1[j]); }
                        *(u32x4*)(zs5 + (size_t)(cr * 16 + tl) * 512 + g * 16 + cp) = pack8(y0, y1); } } }
            asm volatile("" ::: "memory"); }
    }
};
struct EpiGlu {
    static constexpr bool PERM = true;
    const bf16_t* zs5; const float* bglu; bf16_t* mixin;
    __device__ __forceinline__ void operator()(const f32x4 (&acc)[2][2][4][2], const Unit& u, int wr, int wc, int fr, int fq) const {
        const int row0 = u.pm * 256 + wr * 64 + fr;
#pragma unroll
        for (int bj = 0; bj < 2; ++bj) { const int c0 = u.pn * 256 + bj * 128 + wc * 32 + 8 * fq;
            const f32x4 b0 = *(const f32x4*)(bglu + c0), b1 = *(const f32x4*)(bglu + c0 + 4);
#pragma unroll
            for (int ai = 0; ai < 2; ++ai)
#pragma unroll
                for (int m = 0; m < 4; ++m) { const int r = row0 + ai * 128 + m * 16;
                    const u32x4 zw = *(const u32x4*)(zs5 + (size_t)r * 512 + c0); f32x4 z0, z1; unpack8(zw, z0, z1);
                    f32x4 o0, o1;
#pragma unroll
                    for (int j = 0; j < 4; ++j) { o0[j] = z0[j] * sigmoid_f(acc[ai][bj][m][0][j] + b0[j]); o1[j] = z1[j] * sigmoid_f(acc[ai][bj][m][1][j] + b1[j]); }
                    *(u32x4*)(mixin + (size_t)r * 1024 + c0) = pack8(o0, o1); } }
    }
};
template <bool F32BASE> struct EpiRes {
    static constexpr bool PERM = false;
    const float* base_p; const float* base_s; bf16_t* xb; float* sumsq;
    __device__ __forceinline__ void operator()(const f32x4 (&acc)[2][2][4][2], const Unit& u, int wr, int wc, int fr, int fq) const {
        const int row0 = u.pm * 256 + wr * 64 + fr, col0 = u.pn * 256 + wc * 32 + 4 * fq;
        constexpr int MB = F32BASE ? 2 : 4;
#pragma unroll
        for (int ai = 0; ai < 2; ++ai)
#pragma unroll
            for (int m0 = 0; m0 < 4; m0 += MB) {
                f32x4 b[MB][2][2];
#pragma unroll
                for (int mm = 0; mm < MB; ++mm) { const int r = row0 + ai * 128 + (m0 + mm) * 16;
                    const float* bp = F32BASE ? ((r < TP) ? base_p + (size_t)r * 1024 : base_s + (size_t)(r - TP) * 1024) : nullptr;
#pragma unroll
                    for (int bj = 0; bj < 2; ++bj)
#pragma unroll
                        for (int n = 0; n < 2; ++n) { const int c = col0 + bj * 128 + n * 16;
                            if (F32BASE) b[mm][bj][n] = *(const f32x4*)(bp + c);
                            else { const u32x2 bw = *(const u32x2*)(xb + (size_t)r * 1024 + c); b[mm][bj][n] = (f32x4){bflo(bw.x), bfhi(bw.x), bflo(bw.y), bfhi(bw.y)}; } } }
#pragma unroll
                for (int mm = 0; mm < MB; ++mm) { const int m = m0 + mm, r = row0 + ai * 128 + m * 16; float s = 0.f;
#pragma unroll
                    for (int bj = 0; bj < 2; ++bj)
#pragma unroll
                        for (int n = 0; n < 2; ++n) { const int c = col0 + bj * 128 + n * 16; const f32x4 v = b[mm][bj][n] + acc[ai][bj][m][n];
                            u32x2 w; w.x = cvt_pk_bf16(v[0], v[1]); w.y = cvt_pk_bf16(v[2], v[3]); *(u32x2*)(xb + (size_t)r * 1024 + c) = w;
                            s += (v[0] * v[0] + v[1] * v[1]) + (v[2] * v[2] + v[3] * v[3]); }
                    s += __shfl_xor(s, 16); s += __shfl_xor(s, 32);
                    if (fq == 0) atomicAdd(sumsq + r, s); }
                asm volatile("" ::: "memory"); }
    }
};
struct EpiFF {
    static constexpr bool PERM = true;
    const float* sumsq; bf16_t* act;
    __device__ __forceinline__ void operator()(const f32x4 (&acc)[2][2][4][2], const Unit& u, int wr, int wc, int fr, int fq) const {
        const int row0 = u.pm * 256 + wr * 64 + fr, c0 = u.pn * 128 + wc * 32 + 8 * fq;
        float rsv[2][4];
#pragma unroll
        for (int ai = 0; ai < 2; ++ai)
#pragma unroll
            for (int m = 0; m < 4; ++m) rsv[ai][m] = sumsq[row0 + ai * 128 + m * 16];
#pragma unroll
        for (int ai = 0; ai < 2; ++ai)
#pragma unroll
            for (int m = 0; m < 4; ++m) { const int r = row0 + ai * 128 + m * 16; const float rs = rsqrtf(rsv[ai][m] * (1.0f / 1024.0f) + 1e-6f);
                f32x4 o0, o1;
#pragma unroll
                for (int j = 0; j < 4; ++j) { o0[j] = silu_f(acc[ai][0][m][0][j] * rs) * (acc[ai][1][m][0][j] * rs); o1[j] = silu_f(acc[ai][0][m][1][j] * rs) * (acc[ai][1][m][1][j] * rs); }
                *(u32x4*)(act + (size_t)r * 2816 + c0) = pack8(o0, o1); }
    }
};
struct EpiQKV {
    static constexpr bool PERM = true;
    const float* sumsq; bf16_t* q; bf16_t* kb; bf16_t* vb; float* opk; float* opv; float* osk; float* osv;
    __device__ __forceinline__ void operator()(const f32x4 (&acc)[2][2][4][2], const Unit& u, int wr, int wc, int fr, int fq) const {
        const int row0 = u.pm * 256 + wr * 64 + fr, pn = u.pn;
        float rsv[2][4];
#pragma unroll
        for (int ai = 0; ai < 2; ++ai)
#pragma unroll
            for (int m = 0; m < 4; ++m) rsv[ai][m] = sumsq[row0 + ai * 128 + m * 16];
#pragma unroll
        for (int ai = 0; ai < 2; ++ai)
#pragma unroll
            for (int m = 0; m < 4; ++m) { const int r = row0 + ai * 128 + m * 16; const float rs = rsqrtf(rsv[ai][m] * (1.0f / 1024.0f) + 1e-6f);
#pragma unroll
                for (int bj = 0; bj < 2; ++bj) { const int cl = bj * 128 + wc * 32 + 8 * fq;
                    if (pn < 4) { const float sc = rs * 0.125f; *(u32x4*)(q + (size_t)r * 1024 + pn * 256 + cl) = pack8(acc[ai][bj][m][0] * sc, acc[ai][bj][m][1] * sc); }
                    else { const f32x4 v0 = acc[ai][bj][m][0] * rs, v1 = acc[ai][bj][m][1] * rs;
                        bf16_t* dst = (pn == 4 ? kb : vb) + (size_t)r * 256 + cl; *(u32x4*)dst = pack8(v0, v1);
                        float* od = nullptr;
                        if (r < TP) { const int t = r & 8191; if (t >= 8064) od = (pn == 4 ? opk : opv) + ((size_t)((r >> 13) * 128 + (t - 8064)) * 256 + cl); }
                        else { const int rr = r - TP; od = (pn == 4 ? osk : osv) + ((size_t)((rr >> 4) * 128 + 112 + (rr & 15)) * 256 + cl); }
                        if (od) { *(f32x4*)od = v0; *(f32x4*)(od + 4) = v1; } } } }
    }
};

struct WDesc { const float* src; int ld, K, N, rowoff, mode; bf16_t* dst; const float* fold; };
__device__ __forceinline__ void wt_tile(const WDesc& d, int tile, LAS float* tl) {
    const int ntn = (d.N + 63) >> 6, kt = tile / ntn, ntile = tile - kt * ntn, k0 = kt * 64, n0 = ntile * 64, tid = ltid();
#pragma unroll
    for (int ps = 0; ps < 8; ++ps) { const int k = ps * 8 + (tid >> 6), n = tid & 63; float v = 0.f;
        if (n0 + n < d.N) v = d.src[(size_t)(k0 + k) * d.ld + n0 + n];
        if (d.fold) v *= d.fold[k0 + k];
        tl[k * 65 + n] = v; }
    __syncthreads();
#pragma unroll
    for (int ps = 0; ps < 8; ++ps) { const int n = ps * 8 + (tid >> 6), k = tid & 63, gn = n0 + n;
        if (gn < d.N) { const int drow = (d.mode ? ((gn >> 7) * 256 + (gn & 127)) : gn) + d.rowoff; d.dst[(size_t)drow * d.K + k0 + k] = f2bf(tl[k * 65 + n]); } }
    __syncthreads();
}

__device__ __forceinline__ void s5_gen_group(KPR p, int g, LAS unsigned char* lds) {
    LAS float* LP = (LAS float*)lds;
    LAS float* BB = LP + 17 * 64 * 2;
    LAS float* KL = BB + 64 * 16 * 2;
    LAS float* CF = KL + 4096;
    LAS float* CR = CF + 128; LAS float* CI = CR + 1024;
    const int tid = ltid();
    const float* lam_re = p.in[12]; const float* lam_im = p.in[13]; const float* log_dt = p.in[14];
    const float* b_re = p.in[15]; const float* b_im = p.in[16]; const float* c_re = p.in[17]; const float* c_im = p.in[18];
    bf16_t* kgt = (bf16_t*)(p.ws + WS_KGT) + (size_t)g * 256 * 384; bf16_t* ht = (bf16_t*)(p.ws + WS_HT) + (size_t)g * 256 * 256; float* lp16 = (float*)(p.ws + WS_LP16) + g * 128;
    if (tid < 64) { const int pp = tid; const double dt = exp((double)log_dt[g]); const double lr = (double)lam_re[g * 64 + pp], li = (double)lam_im[g * 64 + pp];
        for (int k = 0; k <= 16; ++k) { const double mg = exp(k * lr * dt), an = k * li * dt; const double cr = mg * cos(an), ci = mg * sin(an);
            LP[(k * 64 + pp) * 2] = (float)cr; LP[(k * 64 + pp) * 2 + 1] = (float)ci;
            if (k == 16) { lp16[pp * 2] = (float)cr; lp16[pp * 2 + 1] = (float)ci; }
            if (k == 1) { const double nr = cr - 1.0, ni = ci, dn = lr * lr + li * li; CF[pp * 2] = (float)((nr * lr + ni * li) / dn); CF[pp * 2 + 1] = (float)((ni * lr - nr * li) / dn); } } }
    __syncthreads();
    for (int e = tid; e < 1024; e += 512) { CR[e] = c_re[(size_t)g * 1024 + e]; CI[e] = c_im[(size_t)g * 1024 + e]; }
    for (int e = tid; e < 1024; e += 512) { const int pp = e >> 4; const float br = b_re[(size_t)g * 1024 + e], bi = b_im[(size_t)g * 1024 + e], fr_ = CF[pp * 2], fi_ = CF[pp * 2 + 1];
        BB[e * 2] = fr_ * br - fi_ * bi; BB[e * 2 + 1] = fr_ * bi + fi_ * br; }
    __syncthreads();
    for (int e = tid; e < 4096; e += 512) { const int k = e >> 8, c = (e >> 4) & 15, cp = e & 15; float s = 0.f;
#pragma unroll 8
        for (int pp = 0; pp < 64; ++pp) { const float cr = CR[c * 64 + pp], ci = CI[c * 64 + pp];
            const float lr = LP[(k * 64 + pp) * 2], li = LP[(k * 64 + pp) * 2 + 1], br = BB[(pp * 16 + cp) * 2], bi = BB[(pp * 16 + cp) * 2 + 1];
            const float mr = lr * br - li * bi, mi = lr * bi + li * br; s += cr * mr - ci * mi; }
        KL[e] = s; }
    __syncthreads();
    for (int e = tid; e < 256 * 384; e += 512) { const int n = e / 384, k = e - n * 384, t = n >> 4, c = n & 15; float v;
        if (k < 256) { const int s = k >> 4, cp = k & 15; v = (s <= t) ? KL[((t - s) * 16 + c) * 16 + cp] : 0.f; }
        else { const int pp = (k - 256) & 63; const float cr = CR[c * 64 + pp], ci = CI[c * 64 + pp];
            const float lr = LP[((t + 1) * 64 + pp) * 2], li = LP[((t + 1) * 64 + pp) * 2 + 1];
            v = (k < 320) ? (cr * lr - ci * li) : -(cr * li + ci * lr); }
        kgt[e] = f2bf(v); }
    for (int e = tid; e < 256 * 256; e += 512) { const int n = e >> 8, k = e & 255; float v = 0.f;
        if (n < 128) { const int pp = n & 63, s = k >> 4, cp = k & 15; const float lr = LP[((15 - s) * 64 + pp) * 2], li = LP[((15 - s) * 64 + pp) * 2 + 1], br = BB[(pp * 16 + cp) * 2], bi = BB[(pp * 16 + cp) * 2 + 1];
            v = (n < 64) ? (lr * br - li * bi) : (lr * bi + li * br); }
        ht[e] = f2bf(v); }
    __syncthreads();
}

__device__ __forceinline__ void phase0(KPR p, LAS unsigned char* lds) {
    const int tid = ltid(), G = gridDim.x, bx = blockIdx.x, lane = tid & 63, wid = tid >> 6;
    for (int g = bx; g < 32; g += G) s5_gen_group(p, g, lds);
    {
        const float* nf = p.in[9]; const float* nm = p.in[8];
        const int shift = (bx + G - (32 % G)) % G;
        for (int it = shift; it < 5840; it += G) {
            int t = it; WDesc d;
            if (t < 656) d = WDesc{p.in[11], 2568, 1024, 2568, 0, 0, (bf16_t*)(p.ws + WS_W1T), nullptr};
            else if ((t -= 656) < 64) d = WDesc{p.in[20], 512, 512, 512, 0, 0, (bf16_t*)(p.ws + WS_WGLU), nullptr};
            else if ((t -= 64) < 256) d = WDesc{p.in[26], 1024, 1024, 1024, 0, 0, (bf16_t*)(p.ws + WS_WOUT), nullptr};
            else if ((t -= 256) < 704) d = WDesc{p.in[32], 2816, 1024, 2816, 0, 1, (bf16_t*)(p.ws + WS_WF1_0), nf};
            else if ((t -= 704) < 704) d = WDesc{p.in[33], 2816, 1024, 2816, 128, 1, (bf16_t*)(p.ws + WS_WF1_0), nf};
            else if ((t -= 704) < 704) d = WDesc{p.in[34], 1024, 2816, 1024, 0, 0, (bf16_t*)(p.ws + WS_WFD_0), nullptr};
            else if ((t -= 704) < 256) d = WDesc{p.in[27], 1024, 1024, 1024, 0, 0, (bf16_t*)(p.ws + WS_WQKV), nm + 1024};
            else if ((t -= 256) < 64) d = WDesc{p.in[28], 256, 1024, 256, 1024, 0, (bf16_t*)(p.ws + WS_WQKV), nm + 1024};
            else if ((t -= 64) < 64) d = WDesc{p.in[29], 256, 1024, 256, 1280, 0, (bf16_t*)(p.ws + WS_WQKV), nm + 1024};
            else if ((t -= 64) < 256) d = WDesc{p.in[31], 1024, 1024, 1024, 0, 0, (bf16_t*)(p.ws + WS_WO), nullptr};
            else if ((t -= 256) < 704) d = WDesc{p.in[32] + (size_t)1024 * 2816, 2816, 1024, 2816, 0, 1, (bf16_t*)(p.ws + WS_WF1_1), nf + 1024};
            else if ((t -= 704) < 704) d = WDesc{p.in[33] + (size_t)1024 * 2816, 2816, 1024, 2816, 128, 1, (bf16_t*)(p.ws + WS_WF1_1), nf + 1024};
            else { t -= 704; d = WDesc{p.in[34] + (size_t)2816 * 1024, 1024, 2816, 1024, 0, 0, (bf16_t*)(p.ws + WS_WFD_1), nullptr}; }
            wt_tile(d, t, (LAS float*)lds);
        }
    }
    {
        bf16_t* h0 = (bf16_t*)(p.ws + WS_R1); const float* nw = p.in[8];
        f32x4 wv[4];
#pragma unroll
        for (int i = 0; i < 4; ++i) wv[i] = *(const f32x4*)(nw + lane * 4 + i * 256);
        for (int r0 = bx * 8 + wid; r0 < T; r0 += G * 8 * 4) {
            f32x4 v[4][4];
#pragma unroll
            for (int q = 0; q < 4; ++q) { const int r = r0 + q * G * 8; if (r < T) { const float* xp = (r < TP) ? p.in[0] + (size_t)r * 1024 : p.in[1] + (size_t)(r - TP) * 1024;
#pragma unroll
                for (int i = 0; i < 4; ++i) v[q][i] = *(const f32x4*)(xp + lane * 4 + i * 256); } else {
#pragma unroll
                for (int i = 0; i < 4; ++i) v[q][i] = (f32x4){0.f, 0.f, 0.f, 0.f}; } }
#pragma unroll
            for (int q = 0; q < 4; ++q) { const int r = r0 + q * G * 8; float s = 0.f;
#pragma unroll
                for (int i = 0; i < 4; ++i) s += (v[q][i][0] * v[q][i][0] + v[q][i][1] * v[q][i][1]) + (v[q][i][2] * v[q][i][2] + v[q][i][3] * v[q][i][3]);
#pragma unroll
                for (int o = 32; o >= 1; o >>= 1) s += __shfl_xor(s, o);
                const float rs = rsqrtf(s * (1.0f / 1024.0f) + 1e-6f);
                if (r < T) {
#pragma unroll
                    for (int i = 0; i < 4; ++i) { const f32x4 y = v[q][i] * rs * wv[i]; u32x2 w; w.x = cvt_pk_bf16(y[0], y[1]); w.y = cvt_pk_bf16(y[2], y[3]); *(u32x2*)(h0 + (size_t)r * 1024 + lane * 4 + i * 256) = w; } } }
        }
    }
    {
        const size_t gt = (size_t)bx * 512 + tid, gs = (size_t)G * 512;
        float* sq = (float*)(p.ws + WS_SUMSQ); for (size_t i = gt; i < (size_t)4 * T; i += gs) sq[i] = 0.f;
        unsigned* wpad = (unsigned*)(p.ws + WS_W1T + (size_t)2568 * 1024 * 2); for (size_t i = gt; i < (size_t)248 * 512; i += gs) wpad[i] = 0u;
        const float* ck = p.in[6]; const float* cv = p.in[7]; float* ok = p.out + O_SK; float* ov = p.out + O_SV;
        for (size_t i = gt; i < (size_t)16 * 112 * 256; i += gs) { const size_t b = i / (112 * 256), rem = i - b * (112 * 256); ok[b * 32768 + rem] = ck[b * 32768 + 4096 + rem]; ov[b * 32768 + rem] = cv[b * 32768 + 4096 + rem]; }
    }
}

struct GdnItem { int b, h, n, rowbase, ntok; bool samp; };
__device__ __forceinline__ GdnItem gdn_decode(int ch) { GdnItem it; it.samp = ch >= 4096;
    if (!it.samp) { it.b = ch >> 9; it.h = (ch >> 7) & 3; it.n = ch & 127; it.rowbase = it.b * 8192 + it.n * 64; it.ntok = 64; } else { const int s = ch - 4096; it.b = s >> 2; it.h = s & 3; it.n = 0; it.rowbase = TP + it.b * 16; it.ntok = 16; }
    return it; }
__device__ __forceinline__ void gdn_s1(KPR p, int ch, LAS unsigned char* buf, int t) {
    const GdnItem it = gdn_decode(ch); const int h = it.h, b = it.b, n = it.n, rowbase = it.rowbase, ntok = it.ntok; const bool samp = it.samp;
    LAS bf16_t* qn = (LAS bf16_t*)buf; LAS bf16_t* kn = qn + 64 * 136; LAS bf16_t* vv = kn + 64 * 136;
    const bf16_t* qkvraw = (const bf16_t*)(p.ws + WS_R2); const float* cw = p.in[22]; const float* cst = p.in[5];
    const int cg = t & 31, t0 = (t >> 5) * 8;
    u32x2 raw[3][11];
#pragma unroll
    for (int part = 0; part < 3; ++part) { const int cbase = part * 512 + h * 128 + cg * 4;
#pragma unroll
        for (int jj = 0; jj < 11; ++jj) { const int ti = t0 - 3 + jj, tabs = n * 64 + ti; raw[part][jj] = (u32x2){0u, 0u};
            if (ti < ntok) {
                if (tabs >= 0) raw[part][jj] = *(const u32x2*)(qkvraw + (size_t)(rowbase + ti) * 1536 + cbase);
                else if (samp) { const f32x4 f = *(const f32x4*)(cst + (size_t)(b * 3 + 3 + tabs) * 1536 + cbase); raw[part][jj].x = cvt_pk_bf16(f[0], f[1]); raw[part][jj].y = cvt_pk_bf16(f[2], f[3]); } } }
    }
#pragma unroll
    for (int part = 0; part < 3; ++part) {
        f32x4 xr[11]; f32x4 cwp[4];
#pragma unroll
        for (int j = 0; j < 4; ++j) cwp[j] = *(const f32x4*)(cw + j * 1536 + part * 512 + h * 128 + cg * 4);
#pragma unroll
        for (int jj = 0; jj < 11; ++jj) xr[jj] = (f32x4){bflo(raw[part][jj].x), bfhi(raw[part][jj].x), bflo(raw[part][jj].y), bfhi(raw[part][jj].y)};
        LAS bf16_t* dstm = (part == 0 ? qn : (part == 1 ? kn : vv)) + cg * 4;
        f32x4 y[8]; float ss[8];
#pragma unroll
        for (int tk = 0; tk < 8; ++tk) { const int tok = t0 + tk;
            y[tk] = xr[tk] * cwp[0] + xr[tk + 1] * cwp[1] + xr[tk + 2] * cwp[2] + xr[tk + 3] * cwp[3];
            if (tok >= ntok) y[tk] = (f32x4){0.f, 0.f, 0.f, 0.f};
#pragma unroll
            for (int e = 0; e < 4; ++e) y[tk][e] = silu_f(y[tk][e]);
            ss[tk] = (y[tk][0] * y[tk][0] + y[tk][1] * y[tk][1]) + (y[tk][2] * y[tk][2] + y[tk][3] * y[tk][3]); }
        if (part < 2) {
#pragma unroll
            for (int o = 1; o < 32; o <<= 1)
#pragma unroll
                for (int tk = 0; tk < 8; ++tk) ss[tk] += __shfl_xor(ss[tk], o); }
#pragma unroll
        for (int tk = 0; tk < 8; ++tk) { float sc = 1.0f;
            if (part < 2) { sc = rsqrtf(ss[tk] + 1e-6f); if (part == 0) sc *= 0.08838834764831845f; }
            u32x2 wv; wv.x = cvt_pk_bf16(y[tk][0] * sc, y[tk][1] * sc); wv.y = cvt_pk_bf16(y[tk][2] * sc, y[tk][3] * sc);
            *(LAS u32x2*)(dstm + (t0 + tk) * 136) = wv; }
    }
}
__device__ __forceinline__ void gdn_prep_phase(KPR p, LAS unsigned char* lds, int bx, int G) {
    const int tid = ltid(), lane = tid & 63, w = tid >> 6, fr = lane & 15, fq = lane >> 4;
    LAS float* Am = (LAS float*)(lds + 2 * 52224); LAS float* gcs = Am + 4096; LAS float* betas = gcs + 64; LAS float* egc = betas + 64;
    const float* gates = (const float*)(p.ws + WS_GATES);
    int ch = bx; if (ch >= NCH) return;
    if (tid >= 256) gdn_s1(p, ch, lds, tid - 256);
    for (int k = 0;; ++k) {
        LAS unsigned char* cur = lds + (k & 1) * 52224; LAS unsigned char* nxt = lds + ((k + 1) & 1) * 52224;
        LAS bf16_t* qn = (LAS bf16_t*)cur; LAS bf16_t* kn = qn + 64 * 136; LAS bf16_t* vv = kn + 64 * 136;
        const GdnItem it = gdn_decode(ch); const int h = it.h, rowbase = it.rowbase, ntok = it.ntok;
        unsigned char* cb = p.ws + WS_R3 + (size_t)ch * GDN_CH_BYTES;
        bf16_t* o_uT = (bf16_t*)cb; bf16_t* o_w = (bf16_t*)(cb + 16384); bf16_t* o_qd = (bf16_t*)(cb + 32768); bf16_t* o_kdT = (bf16_t*)(cb + 49152); bf16_t* o_attn = (bf16_t*)(cb + 65536);
        __syncthreads();
        if (tid < 64) { float gg = 0.f, be = 0.f;
            if (tid < ntok) { const float a = gates[(size_t)(rowbase + tid) * 8 + 4 + h], bb = gates[(size_t)(rowbase + tid) * 8 + h];
                const float xs = a + p.in[24][h]; const float sp = xs > 20.f ? xs : log1pf(expf(xs)); gg = -expf(p.in[23][h]) * sp; be = 1.0f / (1.0f + expf(-bb)); }
            float gc = gg;
#pragma unroll
            for (int o = 1; o < 64; o <<= 1) { const float v = __shfl_up(gc, o); if (lane >= o) gc += v; }
            gcs[tid] = gc; betas[tid] = be; egc[tid] = expf(gc);
            if (tid == 63) ((float*)(p.ws + WS_GL))[ch] = expf(gc); }
        __syncthreads();
        {
            const int rt = w & 3, kind = w >> 2; LAS bf16_t* am = kind ? qn : kn;
            bf16x8 af[4];
#pragma unroll
            for (int ks = 0; ks < 4; ++ks) af[ks] = *(const LAS bf16x8*)(am + (16 * rt + fr) * 136 + 32 * ks + 8 * fq);
#pragma unroll
            for (int ct = 0; ct < 4; ++ct) {
                f32x4 acc = (f32x4){0.f, 0.f, 0.f, 0.f};
                if (ct <= rt) {
#pragma unroll
                    for (int ks = 0; ks < 4; ++ks) { const bf16x8 bfr = *(const LAS bf16x8*)(kn + (16 * ct + fr) * 136 + 32 * ks + 8 * fq); acc = __builtin_amdgcn_mfma_f32_16x16x32_bf16(af[ks], bfr, acc, 0, 0, 0); } }
                const int col = 16 * ct + fr; const float gcc = gcs[col];
#pragma unroll
                for (int j = 0; j < 4; ++j) { const int row = 16 * rt + 4 * fq + j; const float dec = __expf(fminf(gcs[row] - gcc, 0.f));
                    if (kind == 0) Am[row * 64 + col] = (row > col) ? betas[row] * acc[j] * dec : 0.f;
                    else o_attn[row * 64 + col] = f2bf((row >= col) ? acc[j] * dec : 0.f); }
            }
        }
        __syncthreads();
        const int chn = ch + G;
        int vz = 0; asm volatile("" : "+v"(vz));
        if (tid < 256) {
            const int c = tid; const bool isu = c < 128; const int cc = isu ? c : c - 128; LAS bf16_t* srcm = isu ? vv : kn;
            LAS float* AmV = Am + vz; LAS float* beV = betas + vz; LAS float* egV = egc + vz;
            float X[64];
#pragma unroll
            for (int i = 0; i < 64; ++i) {
                float r = bf2f(srcm[i * 136 + cc]) * beV[i]; if (!isu) r *= egV[i];
                float pa[4] = {0.f, 0.f, 0.f, 0.f};
#pragma unroll
                for (int j4 = 0; j4 < (i + 3) / 4; ++j4) { const f32x4 a4 = *(const LAS f32x4*)(AmV + i * 64 + j4 * 4);
#pragma unroll
                    for (int jj = 0; jj < 4; ++jj) { if (j4 * 4 + jj < i) pa[jj] += a4[jj] * X[j4 * 4 + jj]; } }
                r -= (pa[0] + pa[1]) + (pa[2] + pa[3]);
                asm volatile("" : "+v"(r) :: "memory"); X[i] = r; }
            if (isu) {
#pragma unroll
                for (int i8 = 0; i8 < 8; ++i8) { u32x4 wv; wv.x = cvt_pk_bf16(X[i8 * 8], X[i8 * 8 + 1]); wv.y = cvt_pk_bf16(X[i8 * 8 + 2], X[i8 * 8 + 3]); wv.z = cvt_pk_bf16(X[i8 * 8 + 4], X[i8 * 8 + 5]); wv.w = cvt_pk_bf16(X[i8 * 8 + 6], X[i8 * 8 + 7]);
                    *(u32x4*)(o_uT + cc * 64 + i8 * 8) = wv; } }
            else {
#pragma unroll
                for (int i = 0; i < 64; ++i) o_w[i * 128 + cc] = f2bf(X[i]); }
        } else {
            const int c = tid - 256;
            LAS float* gcV = gcs + vz; LAS float* egV = egc + vz;
            if (c < 128) { const float gl_ = gcV[63];
#pragma unroll
                for (int i8 = 0; i8 < 8; ++i8) { float v[8];
#pragma unroll
                    for (int e = 0; e < 8; ++e) { const int tk = i8 * 8 + e; v[e] = bf2f(kn[tk * 136 + c]) * __expf(gl_ - gcV[tk]); }
                    u32x4 wv; wv.x = cvt_pk_bf16(v[0], v[1]); wv.y = cvt_pk_bf16(v[2], v[3]); wv.z = cvt_pk_bf16(v[4], v[5]); wv.w = cvt_pk_bf16(v[6], v[7]);
                    *(u32x4*)(o_kdT + c * 64 + i8 * 8) = wv; } }
            else { const int cc = c - 128;
#pragma unroll 8
                for (int i = 0; i < 64; ++i) o_qd[i * 128 + cc] = f2bf(bf2f(qn[i * 136 + cc]) * egV[i]); }
            if (chn < NCH) gdn_s1(p, chn, nxt, c);
        }
        if (chn >= NCH) break;
        ch = chn;
    }
    __syncthreads();
}

struct GFrag { bf16x8 Aw[4], Aq[4], Aa[2], Ak[2]; bf16x4 u[2]; float gl; };
__device__ __forceinline__ void gdn_load(GFrag& f, const unsigned char* ws, int ch, int w, int sl, int fr, int fq) {
    const unsigned char* cb = ws + WS_R3 + (size_t)ch * GDN_CH_BYTES;
    const bf16_t* uT = (const bf16_t*)cb; const bf16_t* wm = (const bf16_t*)(cb + 16384); const bf16_t* qd = (const bf16_t*)(cb + 32768); const bf16_t* kdT = (const bf16_t*)(cb + 49152); const bf16_t* at = (const bf16_t*)(cb + 65536);
    if (w < 4) {
#pragma unroll
        for (int ks = 0; ks < 4; ++ks) { f.Aw[ks] = *(const bf16x8*)(wm + (16 * w + fr) * 128 + 32 * ks + 8 * fq); f.Aq[ks] = *(const bf16x8*)(qd + (16 * w + fr) * 128 + 32 * ks + 8 * fq); }
#pragma unroll
        for (int k2 = 0; k2 < 2; ++k2) f.Aa[k2] = *(const bf16x8*)(at + (16 * w + fr) * 64 + 32 * k2 + 8 * fq);
#pragma unroll
        for (int dt = 0; dt < 2; ++dt) f.u[dt] = *(const bf16x4*)(uT + (sl * 32 + 16 * dt + fr) * 64 + 16 * w + 4 * fq);
    }
#pragma unroll
    for (int k2 = 0; k2 < 2; ++k2) f.Ak[k2] = *(const bf16x8*)(kdT + (16 * w + fr) * 64 + 32 * k2 + 8 * fq);
    f.gl = ((const float*)(ws + WS_GL))[ch];
}
__device__ __forceinline__ void gdn_step(const GFrag& cur, f32x4 (&accS)[2], LAS unsigned char* ST, LAS unsigned char* VN, bf16_t* gorow, int ntok, int w, int fr, int fq) {
    f32x4 accO[2];
    if (w < 4) {
        f32x4 accV[2];
#pragma unroll
        for (int dt = 0; dt < 2; ++dt) { accV[dt] = (f32x4){0.f, 0.f, 0.f, 0.f}; accO[dt] = (f32x4){0.f, 0.f, 0.f, 0.f}; }
#pragma unroll
        for (int ks = 0; ks < 4; ++ks)
#pragma unroll
            for (int dt = 0; dt < 2; ++dt) { const bf16x8 bs = *(const LAS bf16x8*)(ST + (16 * dt + fr) * 272 + (32 * ks + 8 * fq) * 2);
                accV[dt] = __builtin_amdgcn_mfma_f32_16x16x32_bf16(cur.Aw[ks], bs, accV[dt], 0, 0, 0); accO[dt] = __builtin_amdgcn_mfma_f32_16x16x32_bf16(cur.Aq[ks], bs, accO[dt], 0, 0, 0); }
#pragma unroll
        for (int dt = 0; dt < 2; ++dt) { const float v0 = bf2f((bf16_t)cur.u[dt][0]) - accV[dt][0], v1 = bf2f((bf16_t)cur.u[dt][1]) - accV[dt][1], v2 = bf2f((bf16_t)cur.u[dt][2]) - accV[dt][2], v3 = bf2f((bf16_t)cur.u[dt][3]) - accV[dt][3];
            u32x2 wv; wv.x = cvt_pk_bf16(v0, v1); wv.y = cvt_pk_bf16(v2, v3); *(LAS u32x2*)(VN + (16 * dt + fr) * 144 + (16 * w + 4 * fq) * 2) = wv; }
    }
    LDS_BARRIER();
    if (w < 4) {
#pragma unroll
        for (int dt = 0; dt < 2; ++dt) {
#pragma unroll
            for (int k2 = 0; k2 < 2; ++k2) { const bf16x8 bv = *(const LAS bf16x8*)(VN + (16 * dt + fr) * 144 + (32 * k2 + 8 * fq) * 2); accO[dt] = __builtin_amdgcn_mfma_f32_16x16x32_bf16(cur.Aa[k2], bv, accO[dt], 0, 0, 0); }
#pragma unroll
            for (int j = 0; j < 4; ++j) { const int tok = 16 * w + 4 * fq + j; if (tok < ntok) gorow[(size_t)tok * 512 + 16 * dt] = f2bf(accO[dt][j]); } }
    }
#pragma unroll
    for (int d2 = 0; d2 < 2; ++d2) { accS[d2] = accS[d2] * cur.gl;
#pragma unroll
        for (int k2 = 0; k2 < 2; ++k2) { const bf16x8 bv = *(const LAS bf16x8*)(VN + (16 * d2 + fr) * 144 + (32 * k2 + 8 * fq) * 2); accS[d2] = __builtin_amdgcn_mfma_f32_16x16x32_bf16(cur.Ak[k2], bv, accS[d2], 0, 0, 0); }
        u32x2 wv; wv.x = cvt_pk_bf16(accS[d2][0], accS[d2][1]); wv.y = cvt_pk_bf16(accS[d2][2], accS[d2][3]);
        *(LAS u32x2*)(ST + (16 * d2 + fr) * 272 + (16 * w + 4 * fq) * 2) = wv; }
    LDS_BARRIER();
}
__device__ __forceinline__ void gdn_chain_item(KPR p, int item, LAS unsigned char* lds) {
    const int tid = ltid(), lane = tid & 63, w = __builtin_amdgcn_readfirstlane(tid >> 6), fr = lane & 15, fq = lane >> 4;
    int bh, sl, nsteps, ch0, rowbase, h, ntok; float* sout; const float* sin = nullptr;
    if (item < 128) { bh = (item & 7) + 8 * (item >> 5); sl = (item >> 3) & 3; nsteps = 128;
        ch0 = bh * 128; rowbase = (bh >> 2) * 8192; h = bh & 3; ntok = 64; sout = p.out + O_PGDN + (size_t)bh * 16384; }
    else { const int j = item - 128; bh = j >> 2; sl = j & 3; nsteps = 1; ch0 = 4096 + bh; rowbase = TP + (bh >> 2) * 16; h = bh & 3; ntok = 16; sout = p.out + O_SGDN + (size_t)bh * 16384; sin = p.in[4] + (size_t)bh * 16384; }
    LAS unsigned char* ST = lds; LAS unsigned char* VN = lds + 32 * 272;
    bf16_t* go = (bf16_t*)(p.ws + WS_R4) + (size_t)rowbase * 512 + h * 128 + sl * 32 + fr;
    const unsigned char* ws = p.ws; const int last = nsteps - 1;
    f32x4 accS[2];
#pragma unroll
    for (int d2 = 0; d2 < 2; ++d2) {
#pragma unroll
        for (int j = 0; j < 4; ++j) accS[d2][j] = sin ? sin[(size_t)(16 * w + 4 * fq + j) * 128 + sl * 32 + 16 * d2 + fr] : 0.f;
        u32x2 wv; wv.x = cvt_pk_bf16(accS[d2][0], accS[d2][1]); wv.y = cvt_pk_bf16(accS[d2][2], accS[d2][3]);
        *(LAS u32x2*)(ST + (16 * d2 + fr) * 272 + (16 * w + 4 * fq) * 2) = wv; }
    GFrag f0, f1, f2;
    gdn_load(f0, ws, ch0, w, sl, fr, fq); gdn_load(f1, ws, ch0 + (1 < last ? 1 : last), w, sl, fr, fq);
    LDS_BARRIER();
#define CLAMPN(x) ((x) < last ? (x) : last)
    for (int n = 0; n < nsteps; n += 3) {
        gdn_load(f2, ws, ch0 + CLAMPN(n + 2), w, sl, fr, fq); __builtin_amdgcn_sched_barrier(0);
        gdn_step(f0, accS, ST, VN, go + (size_t)n * 64 * 512, ntok, w, fr, fq);
        if (n + 1 < nsteps) { gdn_load(f0, ws, ch0 + CLAMPN(n + 3), w, sl, fr, fq); __builtin_amdgcn_sched_barrier(0);
            gdn_step(f1, accS, ST, VN, go + (size_t)(n + 1) * 64 * 512, ntok, w, fr, fq); }
        if (n + 2 < nsteps) { gdn_load(f1, ws, ch0 + CLAMPN(n + 4), w, sl, fr, fq); __builtin_amdgcn_sched_barrier(0);
            gdn_step(f2, accS, ST, VN, go + (size_t)(n + 2) * 64 * 512, ntok, w, fr, fq); }
    }
#undef CLAMPN
#pragma unroll
    for (int d2 = 0; d2 < 2; ++d2)
#pragma unroll
        for (int j = 0; j < 4; ++j) sout[(size_t)(16 * w + 4 * fq + j) * 128 + sl * 32 + 16 * d2 + fr] = accS[d2][j];
    __syncthreads();
}

__device__ __forceinline__ void s5_scan_prompt(KPR p, int item) {
    const int idx = item * 512 + ltid(), pp = idx & 63, g = (idx >> 6) & 31, b = idx >> 11;
    const float* ss = (const float*)(p.ws + WS_R1) + ((size_t)g * CRG + b * 512) * 128; bf16_t* uc = (bf16_t*)(p.ws + WS_R5) + ((size_t)g * CRG + b * 512) * 384 + 256;
    const float* lp = (const float*)(p.ws + WS_LP16) + g * 128 + pp * 2; const float lr = lp[0], li = lp[1];
    float xr = 0.f, xi = 0.f;
    float sr[8], si[8], nr[8], ni[8];
#pragma unroll
    for (int k = 0; k < 8; ++k) { sr[k] = ss[(size_t)k * 128 + pp]; si[k] = ss[(size_t)k * 128 + 64 + pp]; }
    for (int n0 = 0; n0 < 512; n0 += 8) {
        const int nn = (n0 + 8 < 512) ? n0 + 8 : n0;
#pragma unroll
        for (int k = 0; k < 8; ++k) { nr[k] = ss[(size_t)(nn + k) * 128 + pp]; ni[k] = ss[(size_t)(nn + k) * 128 + 64 + pp]; }
#pragma unroll
        for (int k = 0; k < 8; ++k) { uc[(size_t)(n0 + k) * 384 + pp] = f2bf(xr); uc[(size_t)(n0 + k) * 384 + 64 + pp] = f2bf(xi);
            const float tr = lr * xr - li * xi + sr[k], ti = lr * xi + li * xr + si[k]; xr = tr; xi = ti; }
#pragma unroll
        for (int k = 0; k < 8; ++k) { sr[k] = nr[k]; si[k] = ni[k]; }
    }
    p.out[O_PS5RE + (size_t)(b * 32 + g) * 64 + pp] = xr; p.out[O_PS5IM + (size_t)(b * 32 + g) * 64 + pp] = xi;
}
__device__ __forceinline__ void s5_scan_sample(KPR p, int item) {
    const int idx = item * 512 + threadIdx.x, pp = idx & 63, g = (idx >> 6) & 31, b = idx >> 11;
    const size_t row = (size_t)g * CRG + 4096 + b;
    const float* ss = (const float*)(p.ws + WS_R1) + row * 128; bf16_t* uc = (bf16_t*)(p.ws + WS_R5) + row * 384 + 256;
    const float* lp = (const float*)(p.ws + WS_LP16) + g * 128 + pp * 2; const float lr = lp[0], li = lp[1];
    const float xr = p.in[2][(size_t)(b * 32 + g) * 64 + pp], xi = p.in[3][(size_t)(b * 32 + g) * 64 + pp];
    uc[pp] = f2bf(xr); uc[64 + pp] = f2bf(xi);
    p.out[O_SS5RE + (size_t)(b * 32 + g) * 64 + pp] = lr * xr - li * xi + ss[pp]; p.out[O_SS5IM + (size_t)(b * 32 + g) * 64 + pp] = lr * xi + li * xr + ss[64 + pp];
}

__device__ __forceinline__ void attn_item(KPR p, int item, LAS unsigned char* lds) {
    const int tid = ltid(), lane = tid & 63, w = __builtin_amdgcn_readfirstlane(tid >> 6), fr = lane & 15, fq = lane >> 4;
    const bf16_t* Q = (const bf16_t*)(p.ws + WS_R1); const bf16_t* KB = (const bf16_t*)(p.ws + WS_R5); const bf16_t* VB = KB + (size_t)T * 256; bf16_t* AO = (bf16_t*)(p.ws + WS_R2);
    LAS unsigned char* Ks = lds; LAS unsigned char* Vt = lds + 192 * 144;
    int kvh, qrow0, nq, nkt, nvalid; const bool samp = item >= 4096;
    if (!samp) { kvh = item & 3; const int c = (item >> 2) & 127, b = item >> 9; const int c0 = c >= 2 ? c - 2 : 0; qrow0 = b * 8192 + c * 64; nq = 64; nvalid = (c - c0 + 1) * 64; nkt = nvalid >> 4;
        const int krow0 = b * 8192 + c0 * 64;
        for (int e = tid; e < nvalid * 8; e += 512) { const int row = e >> 3, pc = e & 7;
            const u32x4 kw = *(const u32x4*)(KB + (size_t)(krow0 + row) * 256 + kvh * 64 + pc * 8); *(LAS u32x4*)(Ks + row * 144 + pc * 16) = kw;
            const u32x4 vw = *(const u32x4*)(VB + (size_t)(krow0 + row) * 256 + kvh * 64 + pc * 8);
            const unsigned vs[4] = {vw.x, vw.y, vw.z, vw.w};
#pragma unroll
            for (int jj = 0; jj < 4; ++jj) { *(LAS bf16_t*)(Vt + (pc * 8 + 2 * jj) * 400 + row * 2) = (bf16_t)(vs[jj] & 0xffffu); *(LAS bf16_t*)(Vt + (pc * 8 + 2 * jj + 1) * 400 + row * 2) = (bf16_t)(vs[jj] >> 16); } } }
    else { const int j = item - 4096; kvh = j & 3; const int b = j >> 2; qrow0 = TP + b * 16; nq = 16; nvalid = 144; nkt = 10;
        const float* ck = p.in[6]; const float* cv = p.in[7];
        for (int e = tid; e < 160 * 8; e += 512) { const int row = e >> 3, pc = e & 7; u32x4 kw = (u32x4){0u, 0u, 0u, 0u}, vw = (u32x4){0u, 0u, 0u, 0u};
            if (row < 128) { const float* kp = ck + ((size_t)(b * 128 + row) * 4 + kvh) * 64 + pc * 8; const float* vp = cv + ((size_t)(b * 128 + row) * 4 + kvh) * 64 + pc * 8;
                kw = pack8(*(const f32x4*)kp, *(const f32x4*)(kp + 4)); vw = pack8(*(const f32x4*)vp, *(const f32x4*)(vp + 4)); }
            else if (row < 144) { kw = *(const u32x4*)(KB + (size_t)(qrow0 + row - 128) * 256 + kvh * 64 + pc * 8); vw = *(const u32x4*)(VB + (size_t)(qrow0 + row - 128) * 256 + kvh * 64 + pc * 8); }
            *(LAS u32x4*)(Ks + row * 144 + pc * 16) = kw;
            const unsigned vs[4] = {vw.x, vw.y, vw.z, vw.w};
#pragma unroll
            for (int jj = 0; jj < 4; ++jj) { *(LAS bf16_t*)(Vt + (pc * 8 + 2 * jj) * 400 + row * 2) = (bf16_t)(vs[jj] & 0xffffu); *(LAS bf16_t*)(Vt + (pc * 8 + 2 * jj + 1) * 400 + row * 2) = (bf16_t)(vs[jj] >> 16); } } }
    const int hg = w >> 1, th = w & 1, head = kvh * 4 + hg;
    bf16x8 qf[2][2];
#pragma unroll
    for (int qt = 0; qt < 2; ++qt)
#pragma unroll
        for (int ks = 0; ks < 2; ++ks) { const int tok = 32 * th + 16 * qt + fr; qf[qt][ks] = (bf16x8){0, 0, 0, 0, 0, 0, 0, 0};
            if (tok < nq) qf[qt][ks] = *(const bf16x8*)(Q + (size_t)(qrow0 + tok) * 1024 + head * 64 + 32 * ks + 8 * fq); }
    const float sink = p.in[30][head];
    __syncthreads();
    f32x4 sc[12][2];
#pragma unroll
    for (int kt = 0; kt < 12; ++kt) {
#pragma unroll
        for (int qt = 0; qt < 2; ++qt) sc[kt][qt] = (f32x4){0.f, 0.f, 0.f, 0.f};
        if (kt < nkt) {
#pragma unroll
            for (int ks = 0; ks < 2; ++ks) { const bf16x8 kf = *(const LAS bf16x8*)(Ks + (16 * kt + fr) * 144 + (32 * ks + 8 * fq) * 2);
#pragma unroll
                for (int qt = 0; qt < 2; ++qt) sc[kt][qt] = __builtin_amdgcn_mfma_f32_16x16x32_bf16(kf, qf[qt][ks], sc[kt][qt], 0, 0, 0); } }
    }
    float mx[2] = {sink, sink};
#pragma unroll
    for (int kt = 0; kt < 12; ++kt)
#pragma unroll
        for (int qt = 0; qt < 2; ++qt)
#pragma unroll
            for (int j = 0; j < 4; ++j) { const bool ok = (kt < nkt) && (16 * kt + 4 * fq + j < nvalid); if (!ok) sc[kt][qt][j] = -1e30f; mx[qt] = fmaxf(mx[qt], sc[kt][qt][j]); }
    float sm[2];
#pragma unroll
    for (int qt = 0; qt < 2; ++qt) { mx[qt] = fmaxf(mx[qt], __shfl_xor(mx[qt], 16)); mx[qt] = fmaxf(mx[qt], __shfl_xor(mx[qt], 32)); sm[qt] = 0.f; }
#pragma unroll
    for (int kt = 0; kt < 12; ++kt)
#pragma unroll
        for (int qt = 0; qt < 2; ++qt)
#pragma unroll
            for (int j = 0; j < 4; ++j) { const float e = __expf(sc[kt][qt][j] - mx[qt]); sc[kt][qt][j] = e; sm[qt] += e; }
    float inv[2];
#pragma unroll
    for (int qt = 0; qt < 2; ++qt) { sm[qt] += __shfl_xor(sm[qt], 16); sm[qt] += __shfl_xor(sm[qt], 32); inv[qt] = 1.0f / (sm[qt] + __expf(sink - mx[qt])); }
    f32x4 oacc[4][2];
#pragma unroll
    for (int dd = 0; dd < 4; ++dd)
#pragma unroll
        for (int qt = 0; qt < 2; ++qt) oacc[dd][qt] = (f32x4){0.f, 0.f, 0.f, 0.f};
#pragma unroll
    for (int kp = 0; kp < 6; ++kp) {
        if (2 * kp < nkt) {
            bf16x8 pf[2];
#pragma unroll
            for (int qt = 0; qt < 2; ++qt) { const f32x4 a = sc[2 * kp][qt] * inv[qt], b2 = sc[2 * kp + 1][qt] * inv[qt]; const u32x4 pw = pack8(a, b2); pf[qt] = __builtin_bit_cast(bf16x8, pw); }
#pragma unroll
            for (int dd = 0; dd < 4; ++dd) { const bf16x4 v0 = *(const LAS bf16x4*)(Vt + (16 * dd + fr) * 400 + (32 * kp + 4 * fq) * 2), v1 = *(const LAS bf16x4*)(Vt + (16 * dd + fr) * 400 + (32 * kp + 16 + 4 * fq) * 2);
                const bf16x8 vf = (bf16x8){v0[0], v0[1], v0[2], v0[3], v1[0], v1[1], v1[2], v1[3]};
#pragma unroll
                for (int qt = 0; qt < 2; ++qt) oacc[dd][qt] = __builtin_amdgcn_mfma_f32_16x16x32_bf16(vf, pf[qt], oacc[dd][qt], 0, 0, 0); } }
    }
#pragma unroll
    for (int qt = 0; qt < 2; ++qt) { const int tok = 32 * th + 16 * qt + fr;
        if (tok < nq) {
#pragma unroll
            for (int dd = 0; dd < 4; ++dd) { u32x2 wv; wv.x = cvt_pk_bf16(oacc[dd][qt][0], oacc[dd][qt][1]); wv.y = cvt_pk_bf16(oacc[dd][qt][2], oacc[dd][qt][3]);
                *(u32x2*)(AO + (size_t)(qrow0 + tok) * 1024 + head * 64 + 16 * dd + 4 * fq) = wv; } } }
    __syncthreads();
}

__global__ void __launch_bounds__(512) fwd_kernel(Params p_arg) {
    extern __shared__ __attribute__((aligned(16))) unsigned char lds_raw[];
    LAS unsigned char* lds = (LAS unsigned char*)lds_raw;
    cg::grid_group grid = cg::this_grid();
    const int G = gridDim.x, bx = blockIdx.x, tid = threadIdx.x;
    const int lo = p_arg.ph_lo, hi = p_arg.ph_hi;
#ifndef PHMASK
#define PHMASK 0x7fff
#endif
#define IN(k) (((PHMASK >> (k)) & 1) && lo <= (k) && (k) < hi)
    unsigned* const barctr = (unsigned*)(p_arg.ws + WS_BAR); unsigned nbar = 0;
#define GRIDBAR() do { __syncthreads(); ++nbar; \
        if (tid == 0) { const unsigned target = nbar * (unsigned)G; __builtin_amdgcn_fence(__ATOMIC_RELEASE, "agent"); __hip_atomic_fetch_add(barctr, 1u, __ATOMIC_RELAXED, __HIP_MEMORY_SCOPE_AGENT); \
            while (__hip_atomic_load(barctr, __ATOMIC_RELAXED, __HIP_MEMORY_SCOPE_AGENT) < target) __builtin_amdgcn_s_sleep(1); \
            __builtin_amdgcn_fence(__ATOMIC_ACQUIRE, "agent"); } \
        __syncthreads(); } while (0)
#define SEAM(k) do { if (IN(k) && IN((k) + 1)) { if ((k) <= CG_SEAMS) grid.sync(); else GRIDBAR(); } } while (0)
#define PHASE_BEGIN(k) _Pragma("unroll 1") for (int rep_ = 0; rep_ < ((((REP_MASK) >> (k)) & 1) ? 2 : 1); ++rep_) { if (rep_) GRIDBAR();
#define PHASE_END }
#define R1 ((bf16_t*)(p.ws + WS_R1))
#define R2 ((bf16_t*)(p.ws + WS_R2))
#define ACT ((bf16_t*)(p.ws + WS_R3))
#define ZG ((bf16_t*)(p.ws + WS_R3 + GDN_BYTES))
#define XB ((bf16_t*)(p.ws + WS_R4))
#define GO XB
#define ZS5 (XB + (size_t)T * 512)
#define UCAT ((bf16_t*)(p.ws + WS_R5))
#define SUMSQ ((float*)(p.ws + WS_SUMSQ))
#define GATES ((float*)(p.ws + WS_GATES))
    PHASE_BEGIN(0)
    if (IN(0)) { KPR p = *launder_kp(); phase0(p, lds); }
    PHASE_END
    SEAM(0);
    PHASE_BEGIN(1)
    if (IN(1)) { KPR p = *launder_kp(); pg8::Gemm g{R1, (const bf16_t*)(p.ws + WS_W1T), 1024, 1024, 1024}; pg8::StaticOrder S; S.init(T, 2816, G, bx); Epi1 E{UCAT, R2, ZG, GATES}; pg8::gemm_phase(lds, g, S, E); }
    PHASE_END
    SEAM(1);
    PHASE_BEGIN(2)
    if (IN(2)) { KPR p = *launder_kp();
        { pg8::Gemm g{UCAT, (const bf16_t*)(p.ws + WS_HT), 384, 256, 256}; pg8::GroupOrder S{G, bx}; EpiS E{(float*)(p.ws + WS_R1)}; pg8::gemm_phase(lds, g, S, E); }
        __syncthreads();
        gdn_prep_phase(p, lds, bx, G);
        for (int i = bx * 512 + tid; i < 24 * 3 * 1536; i += G * 512) { const int c = i % 1536, j = (i / 1536) % 3, b = i / 4608;
            if (b < 8) p.out[O_PCONV + (size_t)(b * 3 + j) * 1536 + c] = bf2f(R2[(size_t)(b * 8192 + 8189 + j) * 1536 + c]);
            else p.out[O_SCONV + (size_t)((b - 8) * 3 + j) * 1536 + c] = bf2f(R2[(size_t)(TP + (b - 8) * 16 + 13 + j) * 1536 + c]); }
    }
    PHASE_END
    SEAM(2);
    PHASE_BEGIN(3)
    if (IN(3)) { KPR p = *launder_kp();
        for (int it = bx; it < 480; it += G) {
#ifdef REP_SUB
            if (rep_ == 1 && ((REP_SUB == 1) != (it < 128))) continue;
#endif
            if (it < 128) gdn_chain_item(p, it, lds);
            else if (it < 160) s5_scan_prompt(p, it - 128);
            else if (it < 416) gdn_chain_item(p, it - 160 + 128, lds);
            else s5_scan_sample(p, it - 416);
        }
    }
    PHASE_END
    SEAM(3);
    PHASE_BEGIN(4)
    if (IN(4)) { KPR p = *launder_kp();
        { pg8::Gemm g{UCAT, (const bf16_t*)(p.ws + WS_KGT), 384, 384, 384}; pg8::GroupOrder S{G, bx}; EpiY E{UCAT, p.in[19], ZS5}; pg8::gemm_phase(lds, g, S, E); }
        const float* nw = p.in[25];
        { const int tl_ = ltid(); const int l16 = tl_ & 15; const f32x4 w0 = *(const f32x4*)(nw + l16 * 8), w1 = *(const f32x4*)(nw + l16 * 8 + 4);
          const size_t gstride = ((size_t)G * 512) >> 4;
          for (size_t gi0 = ((size_t)bx * 512 + tl_) >> 4; gi0 < (size_t)T * 4; gi0 += 4 * gstride) {
            u32x4 ow[4], zw[4];
#pragma unroll
            for (int q = 0; q < 4; ++q) { const size_t gi = gi0 + q * gstride; if (gi < (size_t)T * 4) { const size_t r = gi >> 2; const int h = (int)(gi & 3);
                ow[q] = *(const u32x4*)(GO + r * 512 + h * 128 + l16 * 8); zw[q] = *(const u32x4*)(ZG + r * 512 + h * 128 + l16 * 8); } else { ow[q] = (u32x4){0u, 0u, 0u, 0u}; zw[q] = ow[q]; } }
#pragma unroll
            for (int q = 0; q < 4; ++q) { const size_t gi = gi0 + q * gstride; const size_t r = gi >> 2; const int h = (int)(gi & 3);
                f32x4 o0, o1, z0, z1; unpack8(ow[q], o0, o1); unpack8(zw[q], z0, z1);
                float s = (o0[0] * o0[0] + o0[1] * o0[1]) + (o0[2] * o0[2] + o0[3] * o0[3]) + (o1[0] * o1[0] + o1[1] * o1[1]) + (o1[2] * o1[2] + o1[3] * o1[3]);
                s += __shfl_xor(s, 1); s += __shfl_xor(s, 2); s += __shfl_xor(s, 4); s += __shfl_xor(s, 8);
                const float rs = rsqrtf(s * (1.0f / 128.0f) + 1e-6f);
                f32x4 y0, y1;
#pragma unroll
                for (int j = 0; j < 4; ++j) { y0[j] = o0[j] * rs * w0[j] * silu_f(z0[j]); y1[j] = o1[j] * rs * w1[j] * silu_f(z1[j]); }
                if (gi < (size_t)T * 4) *(u32x4*)(R1 + r * 1024 + 512 + h * 128 + l16 * 8) = pack8(y0, y1); } } }
    }
    PHASE_END
    SEAM(4);
    PHASE_BEGIN(5)
    if (IN(5)) { KPR p = *launder_kp(); pg8::Gemm g{ZS5, (const bf16_t*)(p.ws + WS_WGLU), 512, 512, 512}; pg8::StaticOrder S; S.init(T, 512, G, bx); EpiGlu E{ZS5, p.in[21], R1}; pg8::gemm_phase(lds, g, S, E); }
    PHASE_END
    SEAM(5);
    PHASE_BEGIN(6)
    if (IN(6)) { KPR p = *launder_kp(); pg8::Gemm g{R1, (const bf16_t*)(p.ws + WS_WOUT), 1024, 1024, 1024}; pg8::StaticOrder S; S.init(T, 1024, G, bx); EpiRes<true> E{p.in[0], p.in[1], XB, SUMSQ}; pg8::gemm_phase(lds, g, S, E); }
    PHASE_END
    SEAM(6);
    PHASE_BEGIN(7)
    if (IN(7)) { KPR p = *launder_kp(); pg8::Gemm g{XB, (const bf16_t*)(p.ws + WS_WF1_0), 1024, 1024, 1024}; pg8::StaticOrder S; S.init(T, 5632, G, bx); EpiFF E{SUMSQ, ACT}; pg8::gemm_phase(lds, g, S, E); }
    PHASE_END
    SEAM(7);
    PHASE_BEGIN(8)
    if (IN(8)) { KPR p = *launder_kp(); pg8::Gemm g{ACT, (const bf16_t*)(p.ws + WS_WFD_0), 2816, 2816, 2816}; pg8::StaticOrder S; S.init(T, 1024, G, bx); EpiRes<false> E{nullptr, nullptr, XB, SUMSQ + T}; pg8::gemm_phase(lds, g, S, E); }
    PHASE_END
    SEAM(8);
    PHASE_BEGIN(9)
    if (IN(9)) { KPR p = *launder_kp(); pg8::Gemm g{XB, (const bf16_t*)(p.ws + WS_WQKV), 1024, 1024, 1024}; pg8::StaticOrder S; S.init(T, 1536, G, bx);
        EpiQKV E{SUMSQ + T, R1, UCAT, UCAT + (size_t)T * 256, p.out + O_PK, p.out + O_PV, p.out + O_SK, p.out + O_SV}; pg8::gemm_phase(lds, g, S, E); }
    PHASE_END
    SEAM(9);
    PHASE_BEGIN(10)
    if (IN(10)) { KPR p = *launder_kp(); for (int it = bx; it < 4160; it += G) attn_item(p, it, lds); }
    PHASE_END
    SEAM(10);
    PHASE_BEGIN(11)
    if (IN(11)) { KPR p = *launder_kp(); pg8::Gemm g{R2, (const bf16_t*)(p.ws + WS_WO), 1024, 1024, 1024}; pg8::StaticOrder S; S.init(T, 1024, G, bx); EpiRes<false> E{nullptr, nullptr, XB, SUMSQ + 2 * T}; pg8::gemm_phase(lds, g, S, E); }
    PHASE_END
    SEAM(11);
    PHASE_BEGIN(12)
    if (IN(12)) { KPR p = *launder_kp(); pg8::Gemm g{XB, (const bf16_t*)(p.ws + WS_WF1_1), 1024, 1024, 1024}; pg8::StaticOrder S; S.init(T, 5632, G, bx); EpiFF E{SUMSQ + 2 * T, ACT}; pg8::gemm_phase(lds, g, S, E); }
    PHASE_END
    SEAM(12);
    PHASE_BEGIN(13)
    if (IN(13)) { KPR p = *launder_kp(); pg8::Gemm g{ACT, (const bf16_t*)(p.ws + WS_WFD_1), 2816, 2816, 2816}; pg8::StaticOrder S; S.init(T, 1024, G, bx); EpiRes<false> E{nullptr, nullptr, XB, SUMSQ + 3 * T}; pg8::gemm_phase(lds, g, S, E); }
    PHASE_END
    SEAM(13);
    PHASE_BEGIN(14)
    if (IN(14)) { KPR p = *launder_kp();
        const int tl_ = ltid(); const int lane = tl_ & 63, wid = tl_ >> 6; const float* nw = p.in[10]; const float* sq = SUMSQ + 3 * T;
        f32x4 wv[4];
#pragma unroll
        for (int i = 0; i < 4; ++i) wv[i] = *(const f32x4*)(nw + lane * 4 + i * 256);
        for (int r0 = bx * 8 + wid; r0 < T; r0 += G * 8 * 4) {
            u32x2 bw[4][4]; float rs[4];
#pragma unroll
            for (int q = 0; q < 4; ++q) { const int r = r0 + q * G * 8; rs[q] = 0.f;
#pragma unroll
                for (int i = 0; i < 4; ++i) bw[q][i] = (u32x2){0u, 0u};
                if (r < T) { rs[q] = sq[r]; const bf16_t* xs = XB + (size_t)r * 1024;
#pragma unroll
                    for (int i = 0; i < 4; ++i) bw[q][i] = *(const u32x2*)(xs + lane * 4 + i * 256); } }
#pragma unroll
            for (int q = 0; q < 4; ++q) { const int r = r0 + q * G * 8; if (r < T) { const float sc = rsqrtf(rs[q] * (1.0f / 1024.0f) + 1e-6f); float* xp = p.out + (size_t)r * 1024;
#pragma unroll
                for (int i = 0; i < 4; ++i) { const f32x4 v = (f32x4){bflo(bw[q][i].x), bfhi(bw[q][i].x), bflo(bw[q][i].y), bfhi(bw[q][i].y)}; *(f32x4*)(xp + lane * 4 + i * 256) = v * sc * wv[i]; } } }
        }
    }
    PHASE_END
#undef IN
#undef SEAM
}

extern "C" void kernel_launch(void* const* d_in, const int* in_sizes, int n_in, void* d_out, int out_size, void* d_ws, size_t ws_size, hipStream_t stream) {
    static int grid_blocks = 0;
    if (!grid_blocks) {
        int dev = 0, cus = 0, per_cu = 0;
        hipGetDevice(&dev);
        hipDeviceGetAttribute(&cus, hipDeviceAttributeMultiprocessorCount, dev);
        hipFuncSetAttribute((const void*)fwd_kernel, hipFuncAttributeMaxDynamicSharedMemorySize, LDS_BYTES);
        hipOccupancyMaxActiveBlocksPerMultiprocessor(&per_cu, (const void*)fwd_kernel, 512, LDS_BYTES);
        if (per_cu < 1) per_cu = 1;
        grid_blocks = cus * per_cu;
        if (ws_size < WS_END) fprintf(stderr, "kernel_launch: workspace too small: %zu < %zu\n", ws_size, (size_t)WS_END);
    }
    hipMemsetAsync((unsigned char*)d_ws + WS_BAR, 0, 256, stream);
    Params p{};
    for (int i = 0; i < 35; ++i) p.in[i] = (const float*)d_in[i];
    p.out = (float*)d_out; p.ws = (unsigned char*)d_ws; p.ph_lo = 0; p.ph_hi = PH_HI;
    void* args[] = {&p};
    hipError_t e = hipLaunchCooperativeKernel((const void*)fwd_kernel, dim3(grid_blocks), dim3(512), args, LDS_BYTES, stream);
    if (e != hipSuccess) fprintf(stderr, "cooperative launch failed: %s (grid %d)\n", hipGetErrorString(e), grid_blocks);
}
```

```cpp
#include <hip/hip_runtime.h>
#include <hip/hip_cooperative_groups.h>
#include <cstdio>
namespace cg = cooperative_groups;

#define LAS __attribute__((address_space(3)))
typedef unsigned short bf16_t;
typedef short bf16x8 __attribute__((ext_vector_type(8)));
typedef short bf16x4 __attribute__((ext_vector_type(4)));
typedef float f32x4 __attribute__((ext_vector_type(4)));
typedef unsigned u32x4 __attribute__((ext_vector_type(4)));
typedef unsigned u32x2 __attribute__((ext_vector_type(2)));

constexpr int TP = 65536;
constexpr int TS = 256;
constexpr int T = TP + TS;
constexpr int DM = 1024;
constexpr int NCH = 4160;
constexpr int CRG = 4352;
constexpr int CRV = 4112;

constexpr size_t al256(size_t x) { return (x + 255) & ~(size_t)255; }
constexpr size_t WS_W1T = 0;
constexpr size_t WS_WGLU = WS_W1T + (size_t)2816 * 1024 * 2;
constexpr size_t WS_WOUT = WS_WGLU + (size_t)512 * 512 * 2;
constexpr size_t WS_WF1_0 = WS_WOUT + (size_t)1024 * 1024 * 2;
constexpr size_t WS_WFD_0 = WS_WF1_0 + (size_t)5632 * 1024 * 2;
constexpr size_t WS_WQKV = WS_WFD_0 + (size_t)1024 * 2816 * 2;
constexpr size_t WS_WO = WS_WQKV + (size_t)1536 * 1024 * 2;
constexpr size_t WS_WF1_1 = WS_WO + (size_t)1024 * 1024 * 2;
constexpr size_t WS_WFD_1 = WS_WF1_1 + (size_t)5632 * 1024 * 2;
constexpr size_t WS_KGT = WS_WFD_1 + (size_t)1024 * 2816 * 2;
constexpr size_t WS_HT = WS_KGT + (size_t)32 * 256 * 384 * 2;
constexpr size_t WS_LP16 = WS_HT + (size_t)32 * 256 * 256 * 2;
constexpr size_t WS_SUMSQ = WS_LP16 + (size_t)32 * 64 * 2 * 4;
constexpr size_t WS_GATES = WS_SUMSQ + al256((size_t)4 * T * 4);
constexpr size_t WS_GL = WS_GATES + al256((size_t)T * 8 * 4);
constexpr size_t WS_BAR = WS_GL + al256((size_t)NCH * 4);
constexpr size_t WS_R1 = WS_BAR + 256;
constexpr size_t R1_BYTES = (size_t)T * 1024 * 2;
constexpr size_t WS_R2 = WS_R1 + R1_BYTES;
constexpr size_t R2_BYTES = (size_t)T * 1536 * 2;
constexpr size_t WS_R3 = WS_R2 + R2_BYTES;
constexpr size_t GDN_CH_BYTES = 73728;
constexpr size_t GDN_BYTES = (size_t)NCH * GDN_CH_BYTES;
constexpr size_t R3_BYTES = GDN_BYTES + (size_t)T * 512 * 2;
constexpr size_t WS_R4 = WS_R3 + R3_BYTES;
constexpr size_t R4_BYTES = (size_t)T * 1024 * 2;
constexpr size_t WS_R5 = WS_R4 + R4_BYTES;
constexpr size_t R5_BYTES = (size_t)32 * CRG * 384 * 2;
constexpr size_t WS_END = WS_R5 + R5_BYTES;
static_assert(R3_BYTES >= (size_t)T * 2816 * 2, "ACT fits R3");
static_assert((size_t)32 * CRG * 128 * 4 <= R1_BYTES, "SS fits R1");
static_assert((size_t)T * 512 * 2 <= R5_BYTES, "K|V fit R5");
static_assert(WS_END <= (size_t)1073741824, "workspace");

constexpr size_t O_Y = 0;
constexpr size_t O_PS5RE = 67371008, O_PS5IM = 67387392, O_PGDN = 67403776, O_PCONV = 67928064, O_PK = 67964928, O_PV = 68227072;
constexpr size_t O_SS5RE = 68489216, O_SS5IM = 68521984, O_SGDN = 68554752, O_SCONV = 69603328, O_SK = 69677056, O_SV = 70201344;

constexpr int LDS_BYTES = 131072;
#ifndef CG_SEAMS
#define CG_SEAMS 0
#endif
#ifndef REP_MASK
#define REP_MASK 0
#endif
#ifndef PH_HI
#define PH_HI 15
#endif

struct Params { const float* in[35]; float* out; unsigned char* ws; int ph_lo, ph_hi; };
typedef const __attribute__((address_space(4))) Params& KPR;
typedef const __attribute__((address_space(4))) Params* KPP;
__device__ __forceinline__ int ltid() { int t = threadIdx.x; asm volatile("" : "+v"(t)); return t; }
__device__ __forceinline__ KPP launder_kp() { KPP q = (KPP)__builtin_amdgcn_kernarg_segment_ptr(); asm volatile("" : "+s"(q)); return q; }

typedef float f32x2v __attribute__((ext_vector_type(2)));
typedef __bf16 bf16x2v __attribute__((ext_vector_type(2)));
__device__ __forceinline__ unsigned cvt_pk_bf16(float lo, float hi) { const f32x2v v = {lo, hi}; const bf16x2v b = __builtin_convertvector(v, bf16x2v); return __builtin_bit_cast(unsigned, b); }
__device__ __forceinline__ bf16_t f2bf(float f) { return (bf16_t)(cvt_pk_bf16(f, 0.f) & 0xffffu); }
__device__ __forceinline__ float bf2f(bf16_t b) { return __uint_as_float(((unsigned)b) << 16); }
__device__ __forceinline__ float bflo(unsigned w) { return __uint_as_float(w << 16); }
__device__ __forceinline__ float bfhi(unsigned w) { return __uint_as_float(w & 0xffff0000u); }
__device__ __forceinline__ float silu_f(float x) { return x * __builtin_amdgcn_rcpf(1.0f + __expf(-x)); }
__device__ __forceinline__ float sigmoid_f(float x) { return __builtin_amdgcn_rcpf(1.0f + __expf(-x)); }
__device__ __forceinline__ float gelu_tanh_f(float x) { const float u = 1.5957691216057308f * (x + 0.044715f * x * x * x); return x * __builtin_amdgcn_rcpf(1.0f + __expf(-u)); }
#define LDS_BARRIER() do { asm volatile("s_waitcnt lgkmcnt(0)" ::: "memory"); __builtin_amdgcn_s_barrier(); asm volatile("" ::: "memory"); } while (0)

namespace pg8 {
constexpr int BM = 256, BK = 64, HALF = 128, HTB = HALF * BK * 2, STAGE_BYTES = 8 * HTB, NXCD = 8, WGM = 8;
__device__ __forceinline__ int lds_byte(int r, int c) { const int st = (r >> 4) * 2 + (c >> 5), rr = r & 15, cc = c & 31, ob = rr * 64 + cc * 2; return st * 1024 + (ob ^ (((ob >> 9) & 1) << 5)); }
__device__ __forceinline__ void stage_rc(int b, int& R, int& C) { const int st = b / 1024, sb = b % 1024, swz = sb ^ (((sb >> 9) & 1) << 5); R = (st >> 1) * 16 + swz / 64; C = (st & 1) * 32 + (swz % 64) / 2; }
__device__ __forceinline__ int perm32(int rho) { const int n = rho >> 4, i = rho & 15; return 8 * (i >> 2) + 4 * n + (i & 3); }
struct Unit { int pm, pn; };
struct Gemm { const bf16_t* A; const bf16_t* Bt; int lda, ldb, K; };
struct StaticOrder {
    int nM, nN, nwg, G, c;
    __device__ void init(int M, int N, int G_, int c_) { nM = M / BM; nN = N / BM; nwg = nM * nN; G = G_; c = c_; }
    __device__ bool next(int i, Unit& u) const {
        const long L = (long)i * G + c; if (L >= nwg) return false;
        int wgid = (int)L; { const int q = nwg / NXCD, r = nwg % NXCD, xcd = wgid % NXCD, off = wgid / NXCD; wgid = (xcd < r ? xcd * (q + 1) : r * (q + 1) + (xcd - r) * q) + off; }
        const int nig = WGM * nN, gid = wgid / nig, fm = gid * WGM, gsz = (nM - fm) < WGM ? (nM - fm) : WGM;
        u.pm = fm + ((wgid % nig) % gsz); u.pn = (wgid % nig) / gsz; return true;
    }
};
struct GroupOrder {
    int G, c;
    __device__ bool next(int i, Unit& u) const { const int L = i * G + c; if (L >= 32 * 17) return false; u.pm = L; u.pn = L / 17; return true; }
};

template <class Epi, class Sched>
__device__ __forceinline__ void gemm_phase(LAS unsigned char* lds, const Gemm g, const Sched& S, const Epi& E) {
    const int tid = ltid(), wid = __builtin_amdgcn_readfirstlane(tid >> 6), lane = tid & 63, wr = wid >> 2, wc = wid & 3, fr = lane & 15, fq = lane >> 4;
    const int K = g.K, nt = K / BK;
    unsigned voffA[2], voffB[2];
#pragma unroll
    for (int i = 0; i < 2; ++i) { int R, C; stage_rc(tid * 16 + i * 8192, R, C); const int Rb = Epi::PERM ? ((R & ~31) + perm32(R & 31)) : R;
        voffA[i] = (unsigned)(R * g.lda + C) * 2u; voffB[i] = (unsigned)(Rb * g.ldb + C) * 2u; }
    const size_t kstep = (size_t)(BK * 2);
    const size_t hstepA = (size_t)HALF * g.lda * 2, hstepB = (size_t)HALF * g.ldb * 2;
    const size_t tstepA = 2 * hstepA, tstepB = 2 * hstepB;
    const unsigned ldsw = (unsigned)wid * 1024u;
    const int aoff = lds_byte(wr * 64 + fr, fq * 8), boff = lds_byte(wc * 32 + fr, fq * 8);
#define PG8_SA(b, h) (((b) * 2 + (h)) * HTB)
#define PG8_SB(b, h) ((4 + (b) * 2 + (h)) * HTB)
#define PG8_STAGE(bufoff, gbase, voff) do { _Pragma("unroll") for (int _i = 0; _i < 2; ++_i) \
        __builtin_amdgcn_global_load_lds((const unsigned*)((const char*)(gbase) + (voff)[_i]), (LAS unsigned*)(lds + (bufoff) + ldsw + _i * 8192), 16, 0, 0); } while (0)
#define PG8_LDA(dst, b, h) do { _Pragma("unroll") for (int m = 0; m < 4; ++m) _Pragma("unroll") for (int k = 0; k < 2; ++k) dst[m][k] = *(const LAS bf16x8*)(lds + PG8_SA(b, h) + aoff + m * 2048 + k * 1024); } while (0)
#define PG8_LDB(dst, b, h) do { _Pragma("unroll") for (int n = 0; n < 2; ++n) _Pragma("unroll") for (int k = 0; k < 2; ++k) dst[n][k] = *(const LAS bf16x8*)(lds + PG8_SB(b, h) + boff + n * 2048 + k * 1024); } while (0)
#define PG8_MMA(ai, bj, At, Bt) do { __builtin_amdgcn_s_setprio(1); _Pragma("unroll") for (int m = 0; m < 4; ++m) _Pragma("unroll") for (int n = 0; n < 2; ++n) _Pragma("unroll") for (int k = 0; k < 2; ++k) \
        acc[ai][bj][m][n] = __builtin_amdgcn_mfma_f32_16x16x32_bf16(Bt[n][k], At[m][k], acc[ai][bj][m][n], 0, 0, 0); __builtin_amdgcn_s_setprio(0); } while (0)
#define PG8_WAIT_V(n) asm volatile("s_waitcnt vmcnt(" #n ")" ::: "memory")
#define PG8_WAIT_L(n) asm volatile("s_waitcnt lgkmcnt(" #n ")" ::: "memory")
#define PG8_BAR __builtin_amdgcn_s_barrier()
#define PG8_SCHED __builtin_amdgcn_sched_barrier(0)
    Unit cur, nxt; int ui = 0;
    if (!S.next(0, cur)) return;
    f32x4 acc[2][2][4][2];
#pragma unroll
    for (int a = 0; a < 2; ++a)
#pragma unroll
        for (int b = 0; b < 2; ++b)
#pragma unroll
            for (int m = 0; m < 4; ++m)
#pragma unroll
                for (int n = 0; n < 2; ++n) acc[a][b][m][n] = (f32x4){0.f, 0.f, 0.f, 0.f};
    bf16x8 At[4][2], B0[2][2], B1[2][2];
    const char* cA = (const char*)g.A + (size_t)cur.pm * tstepA; const char* cB = (const char*)g.Bt + (size_t)cur.pn * tstepB;
    PG8_STAGE(PG8_SB(0, 0), cB, voffB); PG8_STAGE(PG8_SB(0, 1), cB + hstepB, voffB); PG8_STAGE(PG8_SA(0, 0), cA, voffA); PG8_STAGE(PG8_SA(0, 1), cA + hstepA, voffA);
    if (wr == 1) PG8_BAR;
    PG8_WAIT_V(2); PG8_BAR;
    PG8_STAGE(PG8_SB(1, 0), cB + kstep, voffB); PG8_STAGE(PG8_SA(1, 0), cA + kstep, voffA); PG8_STAGE(PG8_SB(1, 1), cB + hstepB + kstep, voffB);
    PG8_WAIT_V(6); PG8_BAR;
    for (;;) {
        const bool has_next = S.next(ui + 1, nxt);
        const char* nA = has_next ? (const char*)g.A + (size_t)nxt.pm * tstepA : cA; const char* nB = has_next ? (const char*)g.Bt + (size_t)nxt.pn * tstepB : cB;
        for (int t = 0; t < nt; t += 2) {
            const bool last = (t == nt - 2);
            const char* a1 = cA + (size_t)(t + 1) * kstep;
            const char* a2 = last ? nA : cA + (size_t)(t + 2) * kstep; const char* b2 = last ? nB : cB + (size_t)(t + 2) * kstep;
            const char* a3 = a2 + kstep; const char* b3 = b2 + kstep;
            PG8_LDB(B0, 0, 0); PG8_LDB(B1, 0, 1); PG8_SCHED; PG8_LDA(At, 0, 0); PG8_STAGE(PG8_SA(1, 1), a1 + hstepA, voffA);
            PG8_WAIT_V(8); PG8_WAIT_L(0); PG8_BAR; PG8_MMA(0, 0, At, B0); PG8_MMA(0, 1, At, B1); PG8_BAR; PG8_SCHED;
            PG8_LDA(At, 0, 1); PG8_STAGE(PG8_SB(0, 0), b2, voffB); PG8_STAGE(PG8_SB(0, 1), b2 + hstepB, voffB); PG8_STAGE(PG8_SA(0, 0), a2, voffA);
            PG8_WAIT_V(8); PG8_WAIT_L(0); PG8_BAR; PG8_MMA(1, 0, At, B0); PG8_MMA(1, 1, At, B1); PG8_BAR; PG8_SCHED;
            PG8_LDB(B0, 1, 0); PG8_LDB(B1, 1, 1); PG8_SCHED; PG8_LDA(At, 1, 0); PG8_STAGE(PG8_SA(0, 1), a2 + hstepA, voffA);
            PG8_WAIT_V(8); PG8_WAIT_L(0); PG8_BAR; PG8_MMA(0, 0, At, B0); PG8_MMA(0, 1, At, B1); PG8_BAR; PG8_SCHED;
            PG8_LDA(At, 1, 1); PG8_STAGE(PG8_SB(1, 0), b3, voffB); PG8_STAGE(PG8_SB(1, 1), b3 + hstepB, voffB); PG8_STAGE(PG8_SA(1, 0), a3, voffA);
            PG8_WAIT_V(8); PG8_WAIT_L(0); PG8_BAR; PG8_MMA(1, 0, At, B0); PG8_MMA(1, 1, At, B1); PG8_BAR; PG8_SCHED;
        }
        if (wr == 0) PG8_BAR;
        { const int lE = ltid() & 63; E(acc, cur, wr, wc, lE & 15, lE >> 4); }
        if (!has_next) break;
#pragma unroll
        for (int a = 0; a < 2; ++a)
#pragma unroll
            for (int b = 0; b < 2; ++b)
#pragma unroll
                for (int m = 0; m < 4; ++m)
#pragma unroll
                    for (int n = 0; n < 2; ++n) acc[a][b][m][n] = (f32x4){0.f, 0.f, 0.f, 0.f};
        cur = nxt; cA = nA; cB = nB; ++ui;
        if (wr == 1) PG8_BAR;
    }
    PG8_WAIT_V(0);
    PG8_BAR;
#undef PG8_SA
#undef PG8_SB
#undef PG8_STAGE
#undef PG8_LDA
#undef PG8_LDB
#undef PG8_MMA
#undef PG8_WAIT_V
#undef PG8_WAIT_L
#undef PG8_BAR
#undef PG8_SCHED
}
}
using pg8::Unit;

__device__ __forceinline__ u32x4 pack8(const f32x4 a, const f32x4 b) { u32x4 w; w.x = cvt_pk_bf16(a[0], a[1]); w.y = cvt_pk_bf16(a[2], a[3]); w.z = cvt_pk_bf16(b[0], b[1]); w.w = cvt_pk_bf16(b[2], b[3]); return w; }
__device__ __forceinline__ void unpack8(const u32x4 w, f32x4& a, f32x4& b) { a = (f32x4){bflo(w.x), bfhi(w.x), bflo(w.y), bfhi(w.y)}; b = (f32x4){bflo(w.z), bfhi(w.z), bflo(w.w), bfhi(w.w)}; }

struct Epi1 {
    static constexpr bool PERM = true;
    bf16_t* ucat; bf16_t* qkvraw; bf16_t* zg; float* gates;
    __device__ __forceinline__ void operator()(const f32x4 (&acc)[2][2][4][2], const Unit& u, int wr, int wc, int fr, int fq) const {
        const int row0 = u.pm * 256 + wr * 64 + fr, pn = u.pn;
#pragma unroll
        for (int ai = 0; ai < 2; ++ai)
#pragma unroll
            for (int m = 0; m < 4; ++m) { const int r = row0 + ai * 128 + m * 16;
#pragma unroll
                for (int bj = 0; bj < 2; ++bj) { const int c0 = pn * 256 + bj * 128 + wc * 32 + 8 * fq;
                    if (pn == 10) { if (bj == 0 && wc == 0 && fq == 0) { *(f32x4*)(gates + (size_t)r * 8) = acc[ai][bj][m][0]; *(f32x4*)(gates + (size_t)r * 8 + 4) = acc[ai][bj][m][1]; } }
                    else { const u32x4 w = pack8(acc[ai][bj][m][0], acc[ai][bj][m][1]); bf16_t* dst;
                        if (pn < 2) dst = ucat + ((size_t)((c0 >> 4) * CRG + (r >> 4)) * 384 + (r & 15) * 16 + (c0 & 15));
                        else if (pn < 8) dst = qkvraw + (size_t)r * 1536 + (c0 - 512);
                        else dst = zg + (size_t)r * 512 + (c0 - 2048);
                        *(u32x4*)dst = w; } } }
    }
};
struct EpiS {
    static constexpr bool PERM = false;
    float* ss;
    __device__ __forceinline__ void operator()(const f32x4 (&acc)[2][2][4][2], const Unit& u, int wr, int wc, int fr, int fq) const {
        const int row0 = u.pm * 256 + wr * 64 + fr, col0 = wc * 32 + 4 * fq;
#pragma unroll
        for (int ai = 0; ai < 2; ++ai)
#pragma unroll
            for (int m = 0; m < 4; ++m) { float* rp = ss + (size_t)(row0 + ai * 128 + m * 16) * 128 + col0;
#pragma unroll
                for (int n = 0; n < 2; ++n) *(f32x4*)(rp + n * 16) = acc[ai][0][m][n]; }
    }
};
struct EpiY {
    static constexpr bool PERM = true;
    const bf16_t* ucat; const float* dvec; bf16_t* zs5;
    __device__ __forceinline__ void operator()(const f32x4 (&acc)[2][2][4][2], const Unit& u, int wr, int wc, int fr, int fq) const {
        const int g = u.pn, crow0 = u.pm * 256 + wr * 64 + fr;
        f32x4 dd[2][2];
#pragma unroll
        for (int bj = 0; bj < 2; ++bj) { const int cp = (bj * 128 + wc * 32 + 8 * fq) & 15; dd[bj][0] = *(const f32x4*)(dvec + g * 16 + cp); dd[bj][1] = *(const f32x4*)(dvec + g * 16 + cp + 4); }
#pragma unroll
        for (int ai = 0; ai < 2; ++ai) {
            u32x4 uw[4][2];
#pragma unroll
            for (int m = 0; m < 4; ++m) { const int crow = crow0 + ai * 128 + m * 16, cr = crow - g * CRG;
#pragma unroll
                for (int bj = 0; bj < 2; ++bj) { const int n0 = bj * 128 + wc * 32 + 8 * fq; uw[m][bj] = (u32x4){0u, 0u, 0u, 0u}; if (cr < CRV) uw[m][bj] = *(const u32x4*)(ucat + (size_t)crow * 384 + n0); } }
#pragma unroll
            for (int m = 0; m < 4; ++m) { const int crow = crow0 + ai * 128 + m * 16, cr = crow - g * CRG;
                if (cr < CRV) {
#pragma unroll
                    for (int bj = 0; bj < 2; ++bj) { const int n0 = bj * 128 + wc * 32 + 8 * fq, tl = n0 >> 4, cp = n0 & 15;
                        f32x4 u0, u1; unpack8(uw[m][bj], u0, u1);
                        f32x4 y0 = acc[ai][bj][m][0] + dd[bj][0] * u0, y1 = acc[ai][bj][m][1] + dd[bj][1] * u1;
#pragma unroll
                        for (int j = 0; j < 4; ++j) { y0[j] = gelu_tanh_f(y0[j]); y1[j] = gelu_tanh_f(y1[j]); }
                        *(u32x4*)(zs5 + (size_t)(cr * 16 + tl) * 512 + g * 16 + cp) = pack8(y0, y1); } } }
            asm volatile("" ::: "memory"); }
    }
};
struct EpiGlu {
    static constexpr bool PERM = true;
    const bf16_t* zs5; const float* bglu; bf16_t* mixin;
    __device__ __forceinline__ void operator()(const f32x4 (&acc)[2][2][4][2], const Unit& u, int wr, int wc, int fr, int fq) const {
        const int row0 = u.pm * 256 + wr * 64 + fr;
#pragma unroll
        for (int bj = 0; bj < 2; ++bj) { const int c0 = u.pn * 256 + bj * 128 + wc * 32 + 8 * fq;
            const f32x4 b0 = *(const f32x4*)(bglu + c0), b1 = *(const f32x4*)(bglu + c0 + 4);
#pragma unroll
            for (int ai = 0; ai < 2; ++ai)
#pragma unroll
                for (int m = 0; m < 4; ++m) { const int r = row0 + ai * 128 + m * 16;
                    const u32x4 zw = *(const u32x4*)(zs5 + (size_t)r * 512 + c0); f32x4 z0, z1; unpack8(zw, z0, z1);
                    f32x4 o0, o1;
#pragma unroll
                    for (int j = 0; j < 4; ++j) { o0[j] = z0[j] * sigmoid_f(acc[ai][bj][m][0][j] + b0[j]); o1[j] = z1[j] * sigmoid_f(acc[ai][bj][m][1][j] + b1[j]); }
                    *(u32x4*)(mixin + (size_t)r * 1024 + c0) = pack8(o0, o1); } }
    }
};
template <bool F32BASE> struct EpiRes {
    static constexpr bool PERM = false;
    const float* base_p; const float* base_s; bf16_t* xb; float* sumsq;
    __device__ __forceinline__ void operator()(const f32x4 (&acc)[2][2][4][2], const Unit& u, int wr, int wc, int fr, int fq) const {
        const int row0 = u.pm * 256 + wr * 64 + fr, col0 = u.pn * 256 + wc * 32 + 4 * fq;
        constexpr int MB = F32BASE ? 2 : 4;
#pragma unroll
        for (int ai = 0; ai < 2; ++ai)
#pragma unroll
            for (int m0 = 0; m0 < 4; m0 += MB) {
                f32x4 b[MB][2][2];
#pragma unroll
                for (int mm = 0; mm < MB; ++mm) { const int r = row0 + ai * 128 + (m0 + mm) * 16;
                    const float* bp = F32BASE ? ((r < TP) ? base_p + (size_t)r * 1024 : base_s + (size_t)(r - TP) * 1024) : nullptr;
#pragma unroll
                    for (int bj = 0; bj < 2; ++bj)
#pragma unroll
                        for (int n = 0; n < 2; ++n) { const int c = col0 + bj * 128 + n * 16;
                            if (F32BASE) b[mm][bj][n] = *(const f32x4*)(bp + c);
                            else { const u32x2 bw = *(const u32x2*)(xb + (size_t)r * 1024 + c); b[mm][bj][n] = (f32x4){bflo(bw.x), bfhi(bw.x), bflo(bw.y), bfhi(bw.y)}; } } }
#pragma unroll
                for (int mm = 0; mm < MB; ++mm) { const int m = m0 + mm, r = row0 + ai * 128 + m * 16; float s = 0.f;
#pragma unroll
                    for (int bj = 0; bj < 2; ++bj)
#pragma unroll
                        for (int n = 0; n < 2; ++n) { const int c = col0 + bj * 128 + n * 16; const f32x4 v = b[mm][bj][n] + acc[ai][bj][m][n];
                            u32x2 w; w.x = cvt_pk_bf16(v[0], v[1]); w.y = cvt_pk_bf16(v[2], v[3]); *(u32x2*)(xb + (size_t)r * 1024 + c) = w;
                            s += (v[0] * v[0] + v[1] * v[1]) + (v[2] * v[2] + v[3] * v[3]); }
                    s += __shfl_xor(s, 16); s += __shfl_xor(s, 32);
                    if (fq == 0) atomicAdd(sumsq + r, s); }
                asm volatile("" ::: "memory"); }
    }
};
struct EpiFF {
    static constexpr bool PERM = true;
    const float* sumsq; bf16_t* act;
    __device__ __forceinline__ void operator()(const f32x4 (&acc)[2][2][4][2], const Unit& u, int wr, int wc, int fr, int fq) const {
        const int row0 = u.pm * 256 + wr * 64 + fr, c0 = u.pn * 128 + wc * 32 + 8 * fq;
        float rsv[2][4];
#pragma unroll
        for (int ai = 0; ai < 2; ++ai)
#pragma unroll
            for (int m = 0; m < 4; ++m) rsv[ai][m] = sumsq[row0 + ai * 128 + m * 16];
#pragma unroll
        for (int ai = 0; ai < 2; ++ai)
#pragma unroll
            for (int m = 0; m < 4; ++m) { const int r = row0 + ai * 128 + m * 16; const float rs = rsqrtf(rsv[ai][m] * (1.0f / 1024.0f) + 1e-6f);
                f32x4 o0, o1;
#pragma unroll
                for (int j = 0; j < 4; ++j) { o0[j] = silu_f(acc[ai][0][m][0][j] * rs) * (acc[ai][1][m][0][j] * rs); o1[j] = silu_f(acc[ai][0][m][1][j] * rs) * (acc[ai][1][m][1][j] * rs); }
                *(u32x4*)(act + (size_t)r * 2816 + c0) = pack8(o0, o1); }
    }
};
struct EpiQKV {
    static constexpr bool PERM = true;
    const float* sumsq; bf16_t* q; bf16_t* kb; bf16_t* vb; float* opk; float* opv; float* osk; float* osv;
    __device__ __forceinline__ void operator()(const f32x4 (&acc)[2][2][4][2], const Unit& u, int wr, int wc, int fr, int fq) const {
        const int row0 = u.pm * 256 + wr * 64 + fr, pn = u.pn;
        float rsv[2][4];
#pragma unroll
        for (int ai = 0; ai < 2; ++ai)
#pragma unroll
            for (int m = 0; m < 4; ++m) rsv[ai][m] = sumsq[row0 + ai * 128 + m * 16];
#pragma unroll
        for (int ai = 0; ai < 2; ++ai)
#pragma unroll
            for (int m = 0; m < 4; ++m) { const int r = row0 + ai * 128 + m * 16; const float rs = rsqrtf(rsv[ai][m] * (1.0f / 1024.0f) + 1e-6f);
#pragma unroll
                for (int bj = 0; bj < 2; ++bj) { const int cl = bj * 128 + wc * 32 + 8 * fq;
                    if (pn < 4) { const float sc = rs * 0.125f; *(u32x4*)(q + (size_t)r * 1024 + pn * 256 + cl) = pack8(acc[ai][bj][m][0] * sc, acc[ai][bj][m][1] * sc); }
                    else { const f32x4 v0 = acc[ai][bj][m][0] * rs, v1 = acc[ai][bj][m][1] * rs;
                        bf16_t* dst = (pn == 4 ? kb : vb) + (size_t)r * 256 + cl; *(u32x4*)dst = pack8(v0, v1);
                        float* od = nullptr;
                        if (r < TP) { const int t = r & 8191; if (t >= 8064) od = (pn == 4 ? opk : opv) + ((size_t)((r >> 13) * 128 + (t - 8064)) * 256 + cl); }
                        else { const int rr = r - TP; od = (pn == 4 ? osk : osv) + ((size_t)((rr >> 4) * 128 + 112 + (rr & 15)) * 256 + cl); }
                        if (od) { *(f32x4*)od = v0; *(f32x4*)(od + 4) = v1; } } } }
    }
};

struct WDesc { const float* src; int ld, K, N, rowoff, mode; bf16_t* dst; const float* fold; };
__device__ __forceinline__ void wt_tile(const WDesc& d, int tile, LAS float* tl) {
    const int ntn = (d.N + 63) >> 6, kt = tile / ntn, ntile = tile - kt * ntn, k0 = kt * 64, n0 = ntile * 64, tid = ltid();
#pragma unroll
    for (int ps = 0; ps < 8; ++ps) { const int k = ps * 8 + (tid >> 6), n = tid & 63; float v = 0.f;
        if (n0 + n < d.N) v = d.src[(size_t)(k0 + k) * d.ld + n0 + n];
        if (d.fold) v *= d.fold[k0 + k];
        tl[k * 65 + n] = v; }
    __syncthreads();
#pragma unroll
    for (int ps = 0; ps < 8; ++ps) { const int n = ps * 8 + (tid >> 6), k = tid & 63, gn = n0 + n;
        if (gn < d.N) { const int drow = (d.mode ? ((gn >> 7) * 256 + (gn & 127)) : gn) + d.rowoff; d.dst[(size_t)drow * d.K + k0 + k] = f2bf(tl[k * 65 + n]); } }
    __syncthreads();
}

__device__ __forceinline__ void s5_gen_group(KPR p, int g, LAS unsigned char* lds) {
    LAS float* LP = (LAS float*)lds;
    LAS float* BB = LP + 17 * 64 * 2;
    LAS float* KL = BB + 64 * 16 * 2;
    LAS float* CF = KL + 4096;
    LAS float* CR = CF + 128; LAS float* CI = CR + 1024;
    const int tid = ltid();
    const float* lam_re = p.in[12]; const float* lam_im = p.in[13]; const float* log_dt = p.in[14];
    const float* b_re = p.in[15]; const float* b_im = p.in[16]; const float* c_re = p.in[17]; const float* c_im = p.in[18];
    bf16_t* kgt = (bf16_t*)(p.ws + WS_KGT) + (size_t)g * 256 * 384; bf16_t* ht = (bf16_t*)(p.ws + WS_HT) + (size_t)g * 256 * 256; float* lp16 = (float*)(p.ws + WS_LP16) + g * 128;
    if (tid < 64) { const int pp = tid; const double dt = exp((double)log_dt[g]); const double lr = (double)lam_re[g * 64 + pp], li = (double)lam_im[g * 64 + pp];
        for (int k = 0; k <= 16; ++k) { const double mg = exp(k * lr * dt), an = k * li * dt; const double cr = mg * cos(an), ci = mg * sin(an);
            LP[(k * 64 + pp) * 2] = (float)cr; LP[(k * 64 + pp) * 2 + 1] = (float)ci;
            if (k == 16) { lp16[pp * 2] = (float)cr; lp16[pp * 2 + 1] = (float)ci; }
            if (k == 1) { const double nr = cr - 1.0, ni = ci, dn = lr * lr + li * li; CF[pp * 2] = (float)((nr * lr + ni * li) / dn); CF[pp * 2 + 1] = (float)((ni * lr - nr * li) / dn); } } }
    __syncthreads();
    for (int e = tid; e < 1024; e += 512) { CR[e] = c_re[(size_t)g * 1024 + e]; CI[e] = c_im[(size_t)g * 1024 + e]; }
    for (int e = tid; e < 1024; e += 512) { const int pp = e >> 4; const float br = b_re[(size_t)g * 1024 + e], bi = b_im[(size_t)g * 1024 + e], fr_ = CF[pp * 2], fi_ = CF[pp * 2 + 1];
        BB[e * 2] = fr_ * br - fi_ * bi; BB[e * 2 + 1] = fr_ * bi + fi_ * br; }
    __syncthreads();
    for (int e = tid; e < 4096; e += 512) { const int k = e >> 8, c = (e >> 4) & 15, cp = e & 15; float s = 0.f;
#pragma unroll 8
        for (int pp = 0; pp < 64; ++pp) { const float cr = CR[c * 64 + pp], ci = CI[c * 64 + pp];
            const float lr = LP[(k * 64 + pp) * 2], li = LP[(k * 64 + pp) * 2 + 1], br = BB[(pp * 16 + cp) * 2], bi = BB[(pp * 16 + cp) * 2 + 1];
            const float mr = lr * br - li * bi, mi = lr * bi + li * br; s += cr * mr - ci * mi; }
        KL[e] = s; }
    __syncthreads();
    for (int e = tid; e < 256 * 384; e += 512) { const int n = e / 384, k = e - n * 384, t = n >> 4, c = n & 15; float v;
        if (k < 256) { const int s = k >> 4, cp = k & 15; v = (s <= t) ? KL[((t - s) * 16 + c) * 16 + cp] : 0.f; }
        else { const int pp = (k - 256) & 63; const float cr = CR[c * 64 + pp], ci = CI[c * 64 + pp];
            const float lr = LP[((t + 1) * 64 + pp) * 2], li = LP[((t + 1) * 64 + pp) * 2 + 1];
            v = (k < 320) ? (cr * lr - ci * li) : -(cr * li + ci * lr); }
        kgt[e] = f2bf(v); }
    for (int e = tid; e < 256 * 256; e += 512) { const int n = e >> 8, k = e & 255; float v = 0.f;
        if (n < 128) { const int pp = n & 63, s = k >> 4, cp = k & 15; const float lr = LP[((15 - s) * 64 + pp) * 2], li = LP[((15 - s) * 64 + pp) * 2 + 1], br = BB[(pp * 16 + cp) * 2], bi = BB[(pp * 16 + cp) * 2 + 1];
            v = (n < 64) ? (lr * br - li * bi) : (lr * bi + li * br); }
        ht[e] = f2bf(v); }
    __syncthreads();
}

__device__ __forceinline__ void phase0(KPR p, LAS unsigned char* lds) {
    const int tid = ltid(), G = gridDim.x, bx = blockIdx.x, lane = tid & 63, wid = tid >> 6;
    for (int g = bx; g < 32; g += G) s5_gen_group(p, g, lds);
    {
        const float* nf = p.in[9]; const float* nm = p.in[8];
        const int shift = (bx + G - (32 % G)) % G;
        for (int it = shift; it < 5840; it += G) {
            int t = it; WDesc d;
            if (t < 656) d = WDesc{p.in[11], 2568, 1024, 2568, 0, 0, (bf16_t*)(p.ws + WS_W1T), nullptr};
            else if ((t -= 656) < 64) d = WDesc{p.in[20], 512, 512, 512, 0, 0, (bf16_t*)(p.ws + WS_WGLU), nullptr};
            else if ((t -= 64) < 256) d = WDesc{p.in[26], 1024, 1024, 1024, 0, 0, (bf16_t*)(p.ws + WS_WOUT), nullptr};
            else if ((t -= 256) < 704) d = WDesc{p.in[32], 2816, 1024, 2816, 0, 1, (bf16_t*)(p.ws + WS_WF1_0), nf};
            else if ((t -= 704) < 704) d = WDesc{p.in[33], 2816, 1024, 2816, 128, 1, (bf16_t*)(p.ws + WS_WF1_0), nf};
            else if ((t -= 704) < 704) d = WDesc{p.in[34], 1024, 2816, 1024, 0, 0, (bf16_t*)(p.ws + WS_WFD_0), nullptr};
            else if ((t -= 704) < 256) d = WDesc{p.in[27], 1024, 1024, 1024, 0, 0, (bf16_t*)(p.ws + WS_WQKV), nm + 1024};
            else if ((t -= 256) < 64) d = WDesc{p.in[28], 256, 1024, 256, 1024, 0, (bf16_t*)(p.ws + WS_WQKV), nm + 1024};
            else if ((t -= 64) < 64) d = WDesc{p.in[29], 256, 1024, 256, 1280, 0, (bf16_t*)(p.ws + WS_WQKV), nm + 1024};
            else if ((t -= 64) < 256) d = WDesc{p.in[31], 1024, 1024, 1024, 0, 0, (bf16_t*)(p.ws + WS_WO), nullptr};
            else if ((t -= 256) < 704) d = WDesc{p.in[32] + (size_t)1024 * 2816, 2816, 1024, 2816, 0, 1, (bf16_t*)(p.ws + WS_WF1_1), nf + 1024};
            else if ((t -= 704) < 704) d = WDesc{p.in[33] + (size_t)1024 * 2816, 2816, 1024, 2816, 128, 1, (bf16_t*)(p.ws + WS_WF1_1), nf + 1024};
            else { t -= 704; d = WDesc{p.in[34] + (size_t)2816 * 1024, 1024, 2816, 1024, 0, 0, (bf16_t*)(p.ws + WS_WFD_1), nullptr}; }
            wt_tile(d, t, (LAS float*)lds);
        }
    }
    {
        bf16_t* h0 = (bf16_t*)(p.ws + WS_R1); const float* nw = p.in[8];
        f32x4 wv[4];
#pragma unroll
        for (int i = 0; i < 4; ++i) wv[i] = *(const f32x4*)(nw + lane * 4 + i * 256);
        for (int r0 = bx * 8 + wid; r0 < T; r0 += G * 8 * 4) {
            f32x4 v[4][4];
#pragma unroll
            for (int q = 0; q < 4; ++q) { const int r = r0 + q * G * 8; if (r < T) { const float* xp = (r < TP) ? p.in[0] + (size_t)r * 1024 : p.in[1] + (size_t)(r - TP) * 1024;
#pragma unroll
                for (int i = 0; i < 4; ++i) v[q][i] = *(const f32x4*)(xp + lane * 4 + i * 256); } else {
#pragma unroll
                for (int i = 0; i < 4; ++i) v[q][i] = (f32x4){0.f, 0.f, 0.f, 0.f}; } }
#pragma unroll
            for (int q = 0; q < 4; ++q) { const int r = r0 + q * G * 8; float s = 0.f;
#pragma unroll
                for (int i = 0; i < 4; ++i) s += (v[q][i][0] * v[q][i][0] + v[q][i][1] * v[q][i][1]) + (v[q][i][2] * v[q][i][2] + v[q][i][3] * v[q][i][3]);
#pragma unroll
                for (int o = 32; o >= 1; o >>= 1) s += __shfl_xor(s, o);
                const float rs = rsqrtf(s * (1.0f / 1024.0f) + 1e-6f);
                if (r < T) {
#pragma unroll
                    for (int i = 0; i < 4; ++i) { const f32x4 y = v[q][i] * rs * wv[i]; u32x2 w; w.x = cvt_pk_bf16(y[0], y[1]); w.y = cvt_pk_bf16(y[2], y[3]); *(u32x2*)(h0 + (size_t)r * 1024 + lane * 4 + i * 256) = w; } } }
        }
    }
    {
        const size_t gt = (size_t)bx * 512 + tid, gs = (size_t)G * 512;
        if (gt == 0) *(unsigned*)(p.ws + WS_BAR) = 0u;
        float* sq = (float*)(p.ws + WS_SUMSQ); for (size_t i = gt; i < (size_t)4 * T; i += gs) sq[i] = 0.f;
        unsigned* wpad = (unsigned*)(p.ws + WS_W1T + (size_t)2568 * 1024 * 2); for (size_t i = gt; i < (size_t)248 * 512; i += gs) wpad[i] = 0u;
        const float* ck = p.in[6]; const float* cv = p.in[7]; float* ok = p.out + O_SK; float* ov = p.out + O_SV;
        for (size_t i = gt; i < (size_t)16 * 112 * 256; i += gs) { const size_t b = i / (112 * 256), rem = i - b * (112 * 256); ok[b * 32768 + rem] = ck[b * 32768 + 4096 + rem]; ov[b * 32768 + rem] = cv[b * 32768 + 4096 + rem]; }
    }
}

struct GdnItem { int b, h, n, rowbase, ntok; bool samp; };
__device__ __forceinline__ GdnItem gdn_decode(int ch) { GdnItem it; it.samp = ch >= 4096;
    if (!it.samp) { it.b = ch >> 9; it.h = (ch >> 7) & 3; it.n = ch & 127; it.rowbase = it.b * 8192 + it.n * 64; it.ntok = 64; } else { const int s = ch - 4096; it.b = s >> 2; it.h = s & 3; it.n = 0; it.rowbase = TP + it.b * 16; it.ntok = 16; }
    return it; }
__device__ __forceinline__ void gdn_s1(KPR p, int ch, LAS unsigned char* buf, int t) {
    const GdnItem it = gdn_decode(ch); const int h = it.h, b = it.b, n = it.n, rowbase = it.rowbase, ntok = it.ntok; const bool samp = it.samp;
    LAS bf16_t* qn = (LAS bf16_t*)buf; LAS bf16_t* kn = qn + 64 * 136; LAS bf16_t* vv = kn + 64 * 136;
    const bf16_t* qkvraw = (const bf16_t*)(p.ws + WS_R2); const float* cw = p.in[22]; const float* cst = p.in[5];
    const int cg = t & 31, t0 = (t >> 5) * 8;
    u32x2 raw[3][11];
#pragma unroll
    for (int part = 0; part < 3; ++part) { const int cbase = part * 512 + h * 128 + cg * 4;
#pragma unroll
        for (int jj = 0; jj < 11; ++jj) { const int ti = t0 - 3 + jj, tabs = n * 64 + ti; raw[part][jj] = (u32x2){0u, 0u};
            if (ti < ntok) {
                if (tabs >= 0) raw[part][jj] = *(const u32x2*)(qkvraw + (size_t)(rowbase + ti) * 1536 + cbase);
                else if (samp) { const f32x4 f = *(const f32x4*)(cst + (size_t)(b * 3 + 3 + tabs) * 1536 + cbase); raw[part][jj].x = cvt_pk_bf16(f[0], f[1]); raw[part][jj].y = cvt_pk_bf16(f[2], f[3]); } } }
    }
#pragma unroll
    for (int part = 0; part < 3; ++part) {
        f32x4 xr[11]; f32x4 cwp[4];
#pragma unroll
        for (int j = 0; j < 4; ++j) cwp[j] = *(const f32x4*)(cw + j * 1536 + part * 512 + h * 128 + cg * 4);
#pragma unroll
        for (int jj = 0; jj < 11; ++jj) xr[jj] = (f32x4){bflo(raw[part][jj].x), bfhi(raw[part][jj].x), bflo(raw[part][jj].y), bfhi(raw[part][jj].y)};
        LAS bf16_t* dstm = (part == 0 ? qn : (part == 1 ? kn : vv)) + cg * 4;
        f32x4 y[8]; float ss[8];
#pragma unroll
        for (int tk = 0; tk < 8; ++tk) { const int tok = t0 + tk;
            y[tk] = xr[tk] * cwp[0] + xr[tk + 1] * cwp[1] + xr[tk + 2] * cwp[2] + xr[tk + 3] * cwp[3];
            if (tok >= ntok) y[tk] = (f32x4){0.f, 0.f, 0.f, 0.f};
#pragma unroll
            for (int e = 0; e < 4; ++e) y[tk][e] = silu_f(y[tk][e]);
            ss[tk] = (y[tk][0] * y[tk][0] + y[tk][1] * y[tk][1]) + (y[tk][2] * y[tk][2] + y[tk][3] * y[tk][3]); }
        if (part < 2) {
#pragma unroll
            for (int o = 1; o < 32; o <<= 1)
#pragma unroll
                for (int tk = 0; tk < 8; ++tk) ss[tk] += __shfl_xor(ss[tk], o); }
#pragma unroll
        for (int tk = 0; tk < 8; ++tk) { float sc = 1.0f;
            if (part < 2) { sc = rsqrtf(ss[tk] + 1e-6f); if (part == 0) sc *= 0.08838834764831845f; }
            u32x2 wv; wv.x = cvt_pk_bf16(y[tk][0] * sc, y[tk][1] * sc); wv.y = cvt_pk_bf16(y[tk][2] * sc, y[tk][3] * sc);
            *(LAS u32x2*)(dstm + (t0 + tk) * 136) = wv; }
    }
}
__device__ __forceinline__ void gdn_prep_phase(KPR p, LAS unsigned char* lds, int bx, int G) {
    const int tid = ltid(), lane = tid & 63, w = tid >> 6, fr = lane & 15, fq = lane >> 4;
    LAS float* Am = (LAS float*)(lds + 2 * 52224); LAS float* gcs = Am + 4096; LAS float* betas = gcs + 64; LAS float* egc = betas + 64;
    const float* gates = (const float*)(p.ws + WS_GATES);
    int ch = bx; if (ch >= NCH) return;
    if (tid >= 256) gdn_s1(p, ch, lds, tid - 256);
    for (int k = 0;; ++k) {
        LAS unsigned char* cur = lds + (k & 1) * 52224; LAS unsigned char* nxt = lds + ((k + 1) & 1) * 52224;
        LAS bf16_t* qn = (LAS bf16_t*)cur; LAS bf16_t* kn = qn + 64 * 136; LAS bf16_t* vv = kn + 64 * 136;
        const GdnItem it = gdn_decode(ch); const int h = it.h, rowbase = it.rowbase, ntok = it.ntok;
        unsigned char* cb = p.ws + WS_R3 + (size_t)ch * GDN_CH_BYTES;
        bf16_t* o_uT = (bf16_t*)cb; bf16_t* o_w = (bf16_t*)(cb + 16384); bf16_t* o_qd = (bf16_t*)(cb + 32768); bf16_t* o_kdT = (bf16_t*)(cb + 49152); bf16_t* o_attn = (bf16_t*)(cb + 65536);
        __syncthreads();
        if (tid < 64) { float gg = 0.f, be = 0.f;
            if (tid < ntok) { const float a = gates[(size_t)(rowbase + tid) * 8 + 4 + h], bb = gates[(size_t)(rowbase + tid) * 8 + h];
                const float xs = a + p.in[24][h]; const float sp = xs > 20.f ? xs : log1pf(expf(xs)); gg = -expf(p.in[23][h]) * sp; be = 1.0f / (1.0f + expf(-bb)); }
            float gc = gg;
#pragma unroll
            for (int o = 1; o < 64; o <<= 1) { const float v = __shfl_up(gc, o); if (lane >= o) gc += v; }
            gcs[tid] = gc; betas[tid] = be; egc[tid] = expf(gc);
            if (tid == 63) ((float*)(p.ws + WS_GL))[ch] = expf(gc); }
        __syncthreads();
        {
            const int rt = w & 3, kind = w >> 2; LAS bf16_t* am = kind ? qn : kn;
            bf16x8 af[4];
#pragma unroll
            for (int ks = 0; ks < 4; ++ks) af[ks] = *(const LAS bf16x8*)(am + (16 * rt + fr) * 136 + 32 * ks + 8 * fq);
#pragma unroll
            for (int ct = 0; ct < 4; ++ct) {
                f32x4 acc = (f32x4){0.f, 0.f, 0.f, 0.f};
                if (ct <= rt) {
#pragma unroll
                    for (int ks = 0; ks < 4; ++ks) { const bf16x8 bfr = *(const LAS bf16x8*)(kn + (16 * ct + fr) * 136 + 32 * ks + 8 * fq); acc = __builtin_amdgcn_mfma_f32_16x16x32_bf16(af[ks], bfr, acc, 0, 0, 0); } }
                const int col = 16 * ct + fr; const float gcc = gcs[col];
#pragma unroll
                for (int j = 0; j < 4; ++j) { const int row = 16 * rt + 4 * fq + j; const float dec = __expf(fminf(gcs[row] - gcc, 0.f));
                    if (kind == 0) Am[row * 64 + col] = (row > col) ? betas[row] * acc[j] * dec : 0.f;
                    else o_attn[row * 64 + col] = f2bf((row >= col) ? acc[j] * dec : 0.f); }
            }
        }
        __syncthreads();
        const int chn = ch + G;
        int vz = 0; asm volatile("" : "+v"(vz));
        if (tid < 256) {
            const int c = tid; const bool isu = c < 128; const int cc = isu ? c : c - 128; LAS bf16_t* srcm = isu ? vv : kn;
            LAS float* AmV = Am + vz; LAS float* beV = betas + vz; LAS float* egV = egc + vz;
            float X[64];
#pragma unroll
            for (int i = 0; i < 64; ++i) {
                float r = bf2f(srcm[i * 136 + cc]) * beV[i]; if (!isu) r *= egV[i];
                float pa[4] = {0.f, 0.f, 0.f, 0.f};
#pragma unroll
                for (int j4 = 0; j4 < (i + 3) / 4; ++j4) { const f32x4 a4 = *(const LAS f32x4*)(AmV + i * 64 + j4 * 4);
#pragma unroll
                    for (int jj = 0; jj < 4; ++jj) { if (j4 * 4 + jj < i) pa[jj] += a4[jj] * X[j4 * 4 + jj]; } }
                r -= (pa[0] + pa[1]) + (pa[2] + pa[3]);
                asm volatile("" : "+v"(r) :: "memory"); X[i] = r; }
            if (isu) {
#pragma unroll
                for (int i8 = 0; i8 < 8; ++i8) { u32x4 wv; wv.x = cvt_pk_bf16(X[i8 * 8], X[i8 * 8 + 1]); wv.y = cvt_pk_bf16(X[i8 * 8 + 2], X[i8 * 8 + 3]); wv.z = cvt_pk_bf16(X[i8 * 8 + 4], X[i8 * 8 + 5]); wv.w = cvt_pk_bf16(X[i8 * 8 + 6], X[i8 * 8 + 7]);
                    *(u32x4*)(o_uT + cc * 64 + i8 * 8) = wv; } }
            else {
#pragma unroll
                for (int i = 0; i < 64; ++i) o_w[i * 128 + cc] = f2bf(X[i]); }
            { LAS float* gcV = gcs + vz; LAS float* egV2 = egc + vz;
              if (c < 128) { const float gl_ = gcV[63];
#pragma unroll
                for (int i8 = 0; i8 < 8; ++i8) { float v[8];
#pragma unroll
                    for (int e = 0; e < 8; ++e) { const int tk = i8 * 8 + e; v[e] = bf2f(kn[tk * 136 + c]) * __expf(gl_ - gcV[tk]); }
                    u32x4 wv; wv.x = cvt_pk_bf16(v[0], v[1]); wv.y = cvt_pk_bf16(v[2], v[3]); wv.z = cvt_pk_bf16(v[4], v[5]); wv.w = cvt_pk_bf16(v[6], v[7]);
                    *(u32x4*)(o_kdT + c * 64 + i8 * 8) = wv; } }
              else { const int cq = c - 128;
#pragma unroll 8
                for (int i = 0; i < 64; ++i) o_qd[i * 128 + cq] = f2bf(bf2f(qn[i * 136 + cq]) * egV2[i]); } }
        } else {
            const int c = tid - 256;
            if (chn < NCH) gdn_s1(p, chn, nxt, c);
        }
        if (chn >= NCH) break;
        ch = chn;
    }
    __syncthreads();
}

struct GFrag { bf16x8 A1[4], A2[2], Ak[2]; float gl; };
__device__ __forceinline__ void gdn_load(GFrag& f, const unsigned char* ws, int ch, int w, int sl, int fr, int fq) {
    const unsigned char* cb = ws + WS_R3 + (size_t)ch * GDN_CH_BYTES;
    const bf16_t* kdT = (const bf16_t*)(cb + 49152);
    const bool vp = w < 4; const int tt = w & 3;
    const bf16_t* p1 = (const bf16_t*)(cb + (vp ? 16384 : 32768)) + (16 * tt + fr) * 128 + 8 * fq;
    const bf16_t* p2 = vp ? (const bf16_t*)cb + (sl * 32 + fr) * 64 + 16 * tt + 4 * fq : (const bf16_t*)(cb + 65536) + (16 * tt + fr) * 64 + 8 * fq;
    const int st2 = vp ? 16 * 64 : 32;
#pragma unroll
    for (int ks = 0; ks < 4; ++ks) f.A1[ks] = *(const bf16x8*)(p1 + 32 * ks);
#pragma unroll
    for (int k2 = 0; k2 < 2; ++k2) f.A2[k2] = *(const bf16x8*)(p2 + st2 * k2);
#pragma unroll
    for (int k2 = 0; k2 < 2; ++k2) f.Ak[k2] = *(const bf16x8*)(kdT + (16 * w + fr) * 64 + 32 * k2 + 8 * fq);
    f.gl = ((const float*)(ws + WS_GL))[ch];
}
__device__ __forceinline__ void gdn_step(const GFrag& cur, f32x4 (&accS)[2], LAS unsigned char* ST, LAS unsigned char* VN, bf16_t* gorow, int ntok, int w, int fr, int fq) {
    const bool vp = w < 4; const int tt = w & 3;
    f32x4 acc[2];
#pragma unroll
    for (int dt = 0; dt < 2; ++dt) acc[dt] = (f32x4){0.f, 0.f, 0.f, 0.f};
#pragma unroll
    for (int ks = 0; ks < 4; ++ks)
#pragma unroll
        for (int dt = 0; dt < 2; ++dt) { const bf16x8 bs = *(const LAS bf16x8*)(ST + (16 * dt + fr) * 272 + (32 * ks + 8 * fq) * 2);
            acc[dt] = __builtin_amdgcn_mfma_f32_16x16x32_bf16(cur.A1[ks], bs, acc[dt], 0, 0, 0); }
    if (vp) {
#pragma unroll
        for (int dt = 0; dt < 2; ++dt) { const float v0 = bf2f((bf16_t)cur.A2[dt][0]) - acc[dt][0], v1 = bf2f((bf16_t)cur.A2[dt][1]) - acc[dt][1], v2 = bf2f((bf16_t)cur.A2[dt][2]) - acc[dt][2], v3 = bf2f((bf16_t)cur.A2[dt][3]) - acc[dt][3];
            u32x2 wv; wv.x = cvt_pk_bf16(v0, v1); wv.y = cvt_pk_bf16(v2, v3); *(LAS u32x2*)(VN + (16 * dt + fr) * 144 + (16 * tt + 4 * fq) * 2) = wv; } }
    LDS_BARRIER();
    if (!vp) {
#pragma unroll
        for (int dt = 0; dt < 2; ++dt) {
#pragma unroll
            for (int k2 = 0; k2 < 2; ++k2) { const bf16x8 bv = *(const LAS bf16x8*)(VN + (16 * dt + fr) * 144 + (32 * k2 + 8 * fq) * 2); acc[dt] = __builtin_amdgcn_mfma_f32_16x16x32_bf16(cur.A2[k2], bv, acc[dt], 0, 0, 0); }
#pragma unroll
            for (int j = 0; j < 4; ++j) { const int tok = 16 * tt + 4 * fq + j; if (tok < ntok) gorow[(size_t)tok * 512 + 16 * dt] = f2bf(acc[dt][j]); } }
    }
#pragma unroll
    for (int d2 = 0; d2 < 2; ++d2) { accS[d2] = accS[d2] * cur.gl;
#pragma unroll
        for (int k2 = 0; k2 < 2; ++k2) { const bf16x8 bv = *(const LAS bf16x8*)(VN + (16 * d2 + fr) * 144 + (32 * k2 + 8 * fq) * 2); accS[d2] = __builtin_amdgcn_mfma_f32_16x16x32_bf16(cur.Ak[k2], bv, accS[d2], 0, 0, 0); }
        u32x2 wv; wv.x = cvt_pk_bf16(accS[d2][0], accS[d2][1]); wv.y = cvt_pk_bf16(accS[d2][2], accS[d2][3]);
        *(LAS u32x2*)(ST + (16 * d2 + fr) * 272 + (16 * w + 4 * fq) * 2) = wv; }
    LDS_BARRIER();
}
__device__ __forceinline__ void gdn_chain_item(KPR p, int item, LAS unsigned char* lds) {
    const int tid = ltid(), lane = tid & 63, w = __builtin_amdgcn_readfirstlane(tid >> 6), fr = lane & 15, fq = lane >> 4;
    int bh, sl, nsteps, ch0, rowbase, h, ntok; float* sout; const float* sin = nullptr;
    if (item < 128) { bh = (item & 7) + 8 * (item >> 5); sl = (item >> 3) & 3; nsteps = 128;
        ch0 = bh * 128; rowbase = (bh >> 2) * 8192; h = bh & 3; ntok = 64; sout = p.out + O_PGDN + (size_t)bh * 16384; }
    else { const int j = item - 128; bh = j >> 2; sl = j & 3; nsteps = 1; ch0 = 4096 + bh; rowbase = TP + (bh >> 2) * 16; h = bh & 3; ntok = 16; sout = p.out + O_SGDN + (size_t)bh * 16384; sin = p.in[4] + (size_t)bh * 16384; }
    LAS unsigned char* ST = lds; LAS unsigned char* VN = lds + 32 * 272;
    bf16_t* go = (bf16_t*)(p.ws + WS_R4) + (size_t)rowbase * 512 + h * 128 + sl * 32 + fr;
    const unsigned char* ws = p.ws; const int last = nsteps - 1;
    f32x4 accS[2];
#pragma unroll
    for (int d2 = 0; d2 < 2; ++d2) {
#pragma unroll
        for (int j = 0; j < 4; ++j) accS[d2][j] = sin ? sin[(size_t)(16 * w + 4 * fq + j) * 128 + sl * 32 + 16 * d2 + fr] : 0.f;
        u32x2 wv; wv.x = cvt_pk_bf16(accS[d2][0], accS[d2][1]); wv.y = cvt_pk_bf16(accS[d2][2], accS[d2][3]);
        *(LAS u32x2*)(ST + (16 * d2 + fr) * 272 + (16 * w + 4 * fq) * 2) = wv; }
    GFrag f0, f1, f2;
    gdn_load(f0, ws, ch0, w, sl, fr, fq); gdn_load(f1, ws, ch0 + (1 < last ? 1 : last), w, sl, fr, fq);
    LDS_BARRIER();
#define CLAMPN(x) ((x) < last ? (x) : last)
    for (int n = 0; n < nsteps; n += 3) {
        gdn_load(f2, ws, ch0 + CLAMPN(n + 2), w, sl, fr, fq); __builtin_amdgcn_sched_barrier(0);
        gdn_step(f0, accS, ST, VN, go + (size_t)n * 64 * 512, ntok, w, fr, fq);
        if (n + 1 < nsteps) { gdn_load(f0, ws, ch0 + CLAMPN(n + 3), w, sl, fr, fq); __builtin_amdgcn_sched_barrier(0);
            gdn_step(f1, accS, ST, VN, go + (size_t)(n + 1) * 64 * 512, ntok, w, fr, fq); }
        if (n + 2 < nsteps) { gdn_load(f1, ws, ch0 + CLAMPN(n + 4), w, sl, fr, fq); __builtin_amdgcn_sched_barrier(0);
            gdn_step(f2, accS, ST, VN, go + (size_t)(n + 2) * 64 * 512, ntok, w, fr, fq); }
    }
#undef CLAMPN
#pragma unroll
    for (int d2 = 0; d2 < 2; ++d2)
#pragma unroll
        for (int j = 0; j < 4; ++j) sout[(size_t)(16 * w + 4 * fq + j) * 128 + sl * 32 + 16 * d2 + fr] = accS[d2][j];
    __syncthreads();
}

__device__ __forceinline__ void s5_scan_prompt(KPR p, int item) {
    const int idx = item * 512 + ltid(), pp = idx & 63, g = (idx >> 6) & 31, b = idx >> 11;
    const float* ss = (const float*)(p.ws + WS_R1) + ((size_t)g * CRG + b * 512) * 128; bf16_t* uc = (bf16_t*)(p.ws + WS_R5) + ((size_t)g * CRG + b * 512) * 384 + 256;
    const float* lp = (const float*)(p.ws + WS_LP16) + g * 128 + pp * 2; const float lr = lp[0], li = lp[1];
    float xr = 0.f, xi = 0.f;
    float sr[8], si[8], nr[8], ni[8];
#pragma unroll
    for (int k = 0; k < 8; ++k) { sr[k] = ss[(size_t)k * 128 + pp]; si[k] = ss[(size_t)k * 128 + 64 + pp]; }
    for (int n0 = 0; n0 < 512; n0 += 8) {
        const int nn = (n0 + 8 < 512) ? n0 + 8 : n0;
#pragma unroll
        for (int k = 0; k < 8; ++k) { nr[k] = ss[(size_t)(nn + k) * 128 + pp]; ni[k] = ss[(size_t)(nn + k) * 128 + 64 + pp]; }
#pragma unroll
        for (int k = 0; k < 8; ++k) { uc[(size_t)(n0 + k) * 384 + pp] = f2bf(xr); uc[(size_t)(n0 + k) * 384 + 64 + pp] = f2bf(xi);
            const float tr = lr * xr - li * xi + sr[k], ti = lr * xi + li * xr + si[k]; xr = tr; xi = ti; }
#pragma unroll
        for (int k = 0; k < 8; ++k) { sr[k] = nr[k]; si[k] = ni[k]; }
    }
    p.out[O_PS5RE + (size_t)(b * 32 + g) * 64 + pp] = xr; p.out[O_PS5IM + (size_t)(b * 32 + g) * 64 + pp] = xi;
}
__device__ __forceinline__ void s5_scan_sample(KPR p, int item) {
    const int idx = item * 512 + threadIdx.x, pp = idx & 63, g = (idx >> 6) & 31, b = idx >> 11;
    const size_t row = (size_t)g * CRG + 4096 + b;
    const float* ss = (const float*)(p.ws + WS_R1) + row * 128; bf16_t* uc = (bf16_t*)(p.ws + WS_R5) + row * 384 + 256;
    const float* lp = (const float*)(p.ws + WS_LP16) + g * 128 + pp * 2; const float lr = lp[0], li = lp[1];
    const float xr = p.in[2][(size_t)(b * 32 + g) * 64 + pp], xi = p.in[3][(size_t)(b * 32 + g) * 64 + pp];
    uc[pp] = f2bf(xr); uc[64 + pp] = f2bf(xi);
    p.out[O_SS5RE + (size_t)(b * 32 + g) * 64 + pp] = lr * xr - li * xi + ss[pp]; p.out[O_SS5IM + (size_t)(b * 32 + g) * 64 + pp] = lr * xi + li * xr + ss[64 + pp];
}

__device__ __forceinline__ void attn_item(KPR p, int item, LAS unsigned char* lds) {
    const int tid = ltid(), lane = tid & 63, w = __builtin_amdgcn_readfirstlane(tid >> 6), fr = lane & 15, fq = lane >> 4;
    const bf16_t* Q = (const bf16_t*)(p.ws + WS_R1); const bf16_t* KB = (const bf16_t*)(p.ws + WS_R5); const bf16_t* VB = KB + (size_t)T * 256; bf16_t* AO = (bf16_t*)(p.ws + WS_R2);
    LAS unsigned char* Ks = lds; LAS unsigned char* Vt = lds + 192 * 144;
    int kvh, qrow0, nq, nkt, nvalid; const bool samp = item >= 4096;
    if (!samp) { kvh = item & 3; const int c = (item >> 2) & 127, b = item >> 9; const int c0 = c >= 2 ? c - 2 : 0; qrow0 = b * 8192 + c * 64; nq = 64; nvalid = (c - c0 + 1) * 64; nkt = nvalid >> 4;
        const int krow0 = b * 8192 + c0 * 64;
        for (int e = tid; e < nvalid * 8; e += 512) { const int row = e >> 3, pc = e & 7;
            const u32x4 kw = *(const u32x4*)(KB + (size_t)(krow0 + row) * 256 + kvh * 64 + pc * 8); *(LAS u32x4*)(Ks + row * 144 + pc * 16) = kw;
            const u32x4 vw = *(const u32x4*)(VB + (size_t)(krow0 + row) * 256 + kvh * 64 + pc * 8);
            const unsigned vs[4] = {vw.x, vw.y, vw.z, vw.w};
#pragma unroll
            for (int jj = 0; jj < 4; ++jj) { *(LAS bf16_t*)(Vt + (pc * 8 + 2 * jj) * 400 + row * 2) = (bf16_t)(vs[jj] & 0xffffu); *(LAS bf16_t*)(Vt + (pc * 8 + 2 * jj + 1) * 400 + row * 2) = (bf16_t)(vs[jj] >> 16); } } }
    else { const int j = item - 4096; kvh = j & 3; const int b = j >> 2; qrow0 = TP + b * 16; nq = 16; nvalid = 144; nkt = 10;
        const float* ck = p.in[6]; const float* cv = p.in[7];
        for (int e = tid; e < 160 * 8; e += 512) { const int row = e >> 3, pc = e & 7; u32x4 kw = (u32x4){0u, 0u, 0u, 0u}, vw = (u32x4){0u, 0u, 0u, 0u};
            if (row < 128) { const float* kp = ck + ((size_t)(b * 128 + row) * 4 + kvh) * 64 + pc * 8; const float* vp = cv + ((size_t)(b * 128 + row) * 4 + kvh) * 64 + pc * 8;
                kw = pack8(*(const f32x4*)kp, *(const f32x4*)(kp + 4)); vw = pack8(*(const f32x4*)vp, *(const f32x4*)(vp + 4)); }
            else if (row < 144) { kw = *(const u32x4*)(KB + (size_t)(qrow0 + row - 128) * 256 + kvh * 64 + pc * 8); vw = *(const u32x4*)(VB + (size_t)(qrow0 + row - 128) * 256 + kvh * 64 + pc * 8); }
            *(LAS u32x4*)(Ks + row * 144 + pc * 16) = kw;
            const unsigned vs[4] = {vw.x, vw.y, vw.z, vw.w};
#pragma unroll
            for (int jj = 0; jj < 4; ++jj) { *(LAS bf16_t*)(Vt + (pc * 8 + 2 * jj) * 400 + row * 2) = (bf16_t)(vs[jj] & 0xffffu); *(LAS bf16_t*)(Vt + (pc * 8 + 2 * jj + 1) * 400 + row * 2) = (bf16_t)(vs[jj] >> 16); } } }
    const int hg = w >> 1, th = w & 1, head = kvh * 4 + hg;
    bf16x8 qf[2][2];
#pragma unroll
    for (int qt = 0; qt < 2; ++qt)
#pragma unroll
        for (int ks = 0; ks < 2; ++ks) { const int tok = 32 * th + 16 * qt + fr; qf[qt][ks] = (bf16x8){0, 0, 0, 0, 0, 0, 0, 0};
            if (tok < nq) qf[qt][ks] = *(const bf16x8*)(Q + (size_t)(qrow0 + tok) * 1024 + head * 64 + 32 * ks + 8 * fq); }
    const float sink = p.in[30][head];
    __syncthreads();
    f32x4 sc[12][2];
#pragma unroll
    for (int kt = 0; kt < 12; ++kt) {
#pragma unroll
        for (int qt = 0; qt < 2; ++qt) sc[kt][qt] = (f32x4){0.f, 0.f, 0.f, 0.f};
        if (kt < nkt) {
#pragma unroll
            for (int ks = 0; ks < 2; ++ks) { const bf16x8 kf = *(const LAS bf16x8*)(Ks + (16 * kt + fr) * 144 + (32 * ks + 8 * fq) * 2);
#pragma unroll
                for (int qt = 0; qt < 2; ++qt) sc[kt][qt] = __builtin_amdgcn_mfma_f32_16x16x32_bf16(kf, qf[qt][ks], sc[kt][qt], 0, 0, 0); } }
    }
    float mx[2] = {sink, sink};
#pragma unroll
    for (int kt = 0; kt < 12; ++kt)
#pragma unroll
        for (int qt = 0; qt < 2; ++qt)
#pragma unroll
            for (int j = 0; j < 4; ++j) { const bool ok = (kt < nkt) && (16 * kt + 4 * fq + j < nvalid); if (!ok) sc[kt][qt][j] = -1e30f; mx[qt] = fmaxf(mx[qt], sc[kt][qt][j]); }
    float sm[2];
#pragma unroll
    for (int qt = 0; qt < 2; ++qt) { mx[qt] = fmaxf(mx[qt], __shfl_xor(mx[qt], 16)); mx[qt] = fmaxf(mx[qt], __shfl_xor(mx[qt], 32)); sm[qt] = 0.f; }
#pragma unroll
    for (int kt = 0; kt < 12; ++kt)
#pragma unroll
        for (int qt = 0; qt < 2; ++qt)
#pragma unroll
            for (int j = 0; j < 4; ++j) { const float e = __expf(sc[kt][qt][j] - mx[qt]); sc[kt][qt][j] = e; sm[qt] += e; }
    float inv[2];
#pragma unroll
    for (int qt = 0; qt < 2; ++qt) { sm[qt] += __shfl_xor(sm[qt], 16); sm[qt] += __shfl_xor(sm[qt], 32); inv[qt] = 1.0f / (sm[qt] + __expf(sink - mx[qt])); }
    f32x4 oacc[4][2];
#pragma unroll
    for (int dd = 0; dd < 4; ++dd)
#pragma unroll
        for (int qt = 0; qt < 2; ++qt) oacc[dd][qt] = (f32x4){0.f, 0.f, 0.f, 0.f};
#pragma unroll
    for (int kp = 0; kp < 6; ++kp) {
        if (2 * kp < nkt) {
            bf16x8 pf[2];
#pragma unroll
            for (int qt = 0; qt < 2; ++qt) { const f32x4 a = sc[2 * kp][qt] * inv[qt], b2 = sc[2 * kp + 1][qt] * inv[qt]; const u32x4 pw = pack8(a, b2); pf[qt] = __builtin_bit_cast(bf16x8, pw); }
#pragma unroll
            for (int dd = 0; dd < 4; ++dd) { const bf16x4 v0 = *(const LAS bf16x4*)(Vt + (16 * dd + fr) * 400 + (32 * kp + 4 * fq) * 2), v1 = *(const LAS bf16x4*)(Vt + (16 * dd + fr) * 400 + (32 * kp + 16 + 4 * fq) * 2);
                const bf16x8 vf = (bf16x8){v0[0], v0[1], v0[2], v0[3], v1[0], v1[1], v1[2], v1[3]};
#pragma unroll
                for (int qt = 0; qt < 2; ++qt) oacc[dd][qt] = __builtin_amdgcn_mfma_f32_16x16x32_bf16(vf, pf[qt], oacc[dd][qt], 0, 0, 0); } }
    }
#pragma unroll
    for (int qt = 0; qt < 2; ++qt) { const int tok = 32 * th + 16 * qt + fr;
        if (tok < nq) {
#pragma unroll
            for (int dd = 0; dd < 4; ++dd) { u32x2 wv; wv.x = cvt_pk_bf16(oacc[dd][qt][0], oacc[dd][qt][1]); wv.y = cvt_pk_bf16(oacc[dd][qt][2], oacc[dd][qt][3]);
                *(u32x2*)(AO + (size_t)(qrow0 + tok) * 1024 + head * 64 + 16 * dd + 4 * fq) = wv; } } }
    __syncthreads();
}

__global__ void __launch_bounds__(512) fwd_kernel(Params p_arg) {
    extern __shared__ __attribute__((aligned(16))) unsigned char lds_raw[];
    LAS unsigned char* lds = (LAS unsigned char*)lds_raw;
    cg::grid_group grid = cg::this_grid();
    const int G = gridDim.x, bx = blockIdx.x, tid = threadIdx.x;
    const int lo = p_arg.ph_lo, hi = p_arg.ph_hi;
#ifndef PHMASK
#define PHMASK 0x7fff
#endif
#define IN(k) (((PHMASK >> (k)) & 1) && lo <= (k) && (k) < hi)
    unsigned* const barctr = (unsigned*)(p_arg.ws + WS_BAR); unsigned nbar = 0;
#define GRIDBAR() do { __syncthreads(); ++nbar; \
        if (tid == 0) { const unsigned target = nbar * (unsigned)G; __builtin_amdgcn_fence(__ATOMIC_RELEASE, "agent"); __hip_atomic_fetch_add(barctr, 1u, __ATOMIC_RELAXED, __HIP_MEMORY_SCOPE_AGENT); \
            while (__hip_atomic_load(barctr, __ATOMIC_RELAXED, __HIP_MEMORY_SCOPE_AGENT) < target) __builtin_amdgcn_s_sleep(1); \
            __builtin_amdgcn_fence(__ATOMIC_ACQUIRE, "agent"); } \
        __syncthreads(); } while (0)
#define SEAM(k) do { if (IN(k) && IN((k) + 1)) { if ((k) <= CG_SEAMS) grid.sync(); else GRIDBAR(); } } while (0)
#define PHASE_BEGIN(k) _Pragma("unroll 1") for (int rep_ = 0; rep_ < ((((REP_MASK) >> (k)) & 1) ? 2 : 1); ++rep_) { if (rep_) GRIDBAR();
#define PHASE_END }
#define R1 ((bf16_t*)(p.ws + WS_R1))
#define R2 ((bf16_t*)(p.ws + WS_R2))
#define ACT ((bf16_t*)(p.ws + WS_R3))
#define ZG ((bf16_t*)(p.ws + WS_R3 + GDN_BYTES))
#define XB ((bf16_t*)(p.ws + WS_R4))
#define GO XB
#define ZS5 (XB + (size_t)T * 512)
#define UCAT ((bf16_t*)(p.ws + WS_R5))
#define SUMSQ ((float*)(p.ws + WS_SUMSQ))
#define GATES ((float*)(p.ws + WS_GATES))
    PHASE_BEGIN(0)
    if (IN(0)) { KPR p = *launder_kp(); phase0(p, lds); }
    PHASE_END
    SEAM(0);
    PHASE_BEGIN(1)
    if (IN(1)) { KPR p = *launder_kp(); pg8::Gemm g{R1, (const bf16_t*)(p.ws + WS_W1T), 1024, 1024, 1024}; pg8::StaticOrder S; S.init(T, 2816, G, bx); Epi1 E{UCAT, R2, ZG, GATES}; pg8::gemm_phase(lds, g, S, E); }
    PHASE_END
    SEAM(1);
    PHASE_BEGIN(2)
    if (IN(2)) { KPR p = *launder_kp();
        { pg8::Gemm g{UCAT, (const bf16_t*)(p.ws + WS_HT), 384, 256, 256}; pg8::GroupOrder S{G, bx}; EpiS E{(float*)(p.ws + WS_R1)}; pg8::gemm_phase(lds, g, S, E); }
        __syncthreads();
        gdn_prep_phase(p, lds, bx, G);
        for (int i = bx * 512 + tid; i < 24 * 3 * 1536; i += G * 512) { const int c = i % 1536, j = (i / 1536) % 3, b = i / 4608;
            if (b < 8) p.out[O_PCONV + (size_t)(b * 3 + j) * 1536 + c] = bf2f(R2[(size_t)(b * 8192 + 8189 + j) * 1536 + c]);
            else p.out[O_SCONV + (size_t)((b - 8) * 3 + j) * 1536 + c] = bf2f(R2[(size_t)(TP + (b - 8) * 16 + 13 + j) * 1536 + c]); }
    }
    PHASE_END
    SEAM(2);
    PHASE_BEGIN(3)
    if (IN(3)) { KPR p = *launder_kp();
        for (int it = bx; it < 480; it += G) {
#ifdef REP_SUB
            if (rep_ == 1 && ((REP_SUB == 1) != (it < 128))) continue;
#endif
            if (it < 128) gdn_chain_item(p, it, lds);
            else if (it < 160) s5_scan_prompt(p, it - 128);
            else if (it < 416) gdn_chain_item(p, it - 160 + 128, lds);
            else s5_scan_sample(p, it - 416);
        }
    }
    PHASE_END
    SEAM(3);
    PHASE_BEGIN(4)
    if (IN(4)) { KPR p = *launder_kp();
        { pg8::Gemm g{UCAT, (const bf16_t*)(p.ws + WS_KGT), 384, 384, 384}; pg8::GroupOrder S{G, bx}; EpiY E{UCAT, p.in[19], ZS5}; pg8::gemm_phase(lds, g, S, E); }
        const float* nw = p.in[25];
        { const int tl_ = ltid(); const int l16 = tl_ & 15; const f32x4 w0 = *(const f32x4*)(nw + l16 * 8), w1 = *(const f32x4*)(nw + l16 * 8 + 4);
          const size_t gstride = ((size_t)G * 512) >> 4;
          for (size_t gi0 = ((size_t)bx * 512 + tl_) >> 4; gi0 < (size_t)T * 4; gi0 += 4 * gstride) {
            u32x4 ow[4], zw[4];
#pragma unroll
            for (int q = 0; q < 4; ++q) { const size_t gi = gi0 + q * gstride; if (gi < (size_t)T * 4) { const size_t r = gi >> 2; const int h = (int)(gi & 3);
                ow[q] = *(const u32x4*)(GO + r * 512 + h * 128 + l16 * 8); zw[q] = *(const u32x4*)(ZG + r * 512 + h * 128 + l16 * 8); } else { ow[q] = (u32x4){0u, 0u, 0u, 0u}; zw[q] = ow[q]; } }
#pragma unroll
            for (int q = 0; q < 4; ++q) { const size_t gi = gi0 + q * gstride; const size_t r = gi >> 2; const int h = (int)(gi & 3);
                f32x4 o0, o1, z0, z1; unpack8(ow[q], o0, o1); unpack8(zw[q], z0, z1);
                float s = (o0[0] * o0[0] + o0[1] * o0[1]) + (o0[2] * o0[2] + o0[3] * o0[3]) + (o1[0] * o1[0] + o1[1] * o1[1]) + (o1[2] * o1[2] + o1[3] * o1[3]);
                s += __shfl_xor(s, 1); s += __shfl_xor(s, 2); s += __shfl_xor(s, 4); s += __shfl_xor(s, 8);
                const float rs = rsqrtf(s * (1.0f / 128.0f) + 1e-6f);
                f32x4 y0, y1;
#pragma unroll
                for (int j = 0; j < 4; ++j) { y0[j] = o0[j] * rs * w0[j] * silu_f(z0[j]); y1[j] = o1[j] * rs * w1[j] * silu_f(z1[j]); }
                if (gi < (size_t)T * 4) *(u32x4*)(R1 + r * 1024 + 512 + h * 128 + l16 * 8) = pack8(y0, y1); } } }
    }
    PHASE_END
    SEAM(4);
    PHASE_BEGIN(5)
    if (IN(5)) { KPR p = *launder_kp(); pg8::Gemm g{ZS5, (const bf16_t*)(p.ws + WS_WGLU), 512, 512, 512}; pg8::StaticOrder S; S.init(T, 512, G, bx); EpiGlu E{ZS5, p.in[21], R1}; pg8::gemm_phase(lds, g, S, E); }
    PHASE_END
    SEAM(5);
    PHASE_BEGIN(6)
    if (IN(6)) { KPR p = *launder_kp(); pg8::Gemm g{R1, (const bf16_t*)(p.ws + WS_WOUT), 1024, 1024, 1024}; pg8::StaticOrder S; S.init(T, 1024, G, bx); EpiRes<true> E{p.in[0], p.in[1], XB, SUMSQ}; pg8::gemm_phase(lds, g, S, E); }
    PHASE_END
    SEAM(6);
    PHASE_BEGIN(7)
    if (IN(7)) { KPR p = *launder_kp(); pg8::Gemm g{XB, (const bf16_t*)(p.ws + WS_WF1_0), 1024, 1024, 1024}; pg8::StaticOrder S; S.init(T, 5632, G, bx); EpiFF E{SUMSQ, ACT}; pg8::gemm_phase(lds, g, S, E); }
    PHASE_END
    SEAM(7);
    PHASE_BEGIN(8)
    if (IN(8)) { KPR p = *launder_kp(); pg8::Gemm g{ACT, (const bf16_t*)(p.ws + WS_WFD_0), 2816, 2816, 2816}; pg8::StaticOrder S; S.init(T, 1024, G, bx); EpiRes<false> E{nullptr, nullptr, XB, SUMSQ + T}; pg8::gemm_phase(lds, g, S, E); }
    PHASE_END
    SEAM(8);
    PHASE_BEGIN(9)
    if (IN(9)) { KPR p = *launder_kp(); pg8::Gemm g{XB, (const bf16_t*)(p.ws + WS_WQKV), 1024, 1024, 1024}; pg8::StaticOrder S; S.init(T, 1536, G, bx);
        EpiQKV E{SUMSQ + T, R1, UCAT, UCAT + (size_t)T * 256, p.out + O_PK, p.out + O_PV, p.out + O_SK, p.out + O_SV}; pg8::gemm_phase(lds, g, S, E); }
    PHASE_END
    SEAM(9);
    PHASE_BEGIN(10)
    if (IN(10)) { KPR p = *launder_kp(); for (int it = bx; it < 4160; it += G) attn_item(p, it, lds); }
    PHASE_END
    SEAM(10);
    PHASE_BEGIN(11)
    if (IN(11)) { KPR p = *launder_kp(); pg8::Gemm g{R2, (const bf16_t*)(p.ws + WS_WO), 1024, 1024, 1024}; pg8::StaticOrder S; S.init(T, 1024, G, bx); EpiRes<false> E{nullptr, nullptr, XB, SUMSQ + 2 * T}; pg8::gemm_phase(lds, g, S, E); }
    PHASE_END
    SEAM(11);
    PHASE_BEGIN(12)
    if (IN(12)) { KPR p = *launder_kp(); pg8::Gemm g{XB, (const bf16_t*)(p.ws + WS_WF1_1), 1024, 1024, 1024}; pg8::StaticOrder S; S.init(T, 5632, G, bx); EpiFF E{SUMSQ + 2 * T, ACT}; pg8::gemm_phase(lds, g, S, E); }
    PHASE_END
    SEAM(12);
    PHASE_BEGIN(13)
    if (IN(13)) { KPR p = *launder_kp(); pg8::Gemm g{ACT, (const bf16_t*)(p.ws + WS_WFD_1), 2816, 2816, 2816}; pg8::StaticOrder S; S.init(T, 1024, G, bx); EpiRes<false> E{nullptr, nullptr, XB, SUMSQ + 3 * T}; pg8::gemm_phase(lds, g, S, E); }
    PHASE_END
    SEAM(13);
    PHASE_BEGIN(14)
    if (IN(14)) { KPR p = *launder_kp();
        const int tl_ = ltid(); const int lane = tl_ & 63, wid = tl_ >> 6; const float* nw = p.in[10]; const float* sq = SUMSQ + 3 * T;
        f32x4 wv[4];
#pragma unroll
        for (int i = 0; i < 4; ++i) wv[i] = *(const f32x4*)(nw + lane * 4 + i * 256);
        for (int r0 = bx * 8 + wid; r0 < T; r0 += G * 8 * 4) {
            u32x2 bw[4][4]; float rs[4];
#pragma unroll
            for (int q = 0; q < 4; ++q) { const int r = r0 + q * G * 8; rs[q] = 0.f;
#pragma unroll
                for (int i = 0; i < 4; ++i) bw[q][i] = (u32x2){0u, 0u};
                if (r < T) { rs[q] = sq[r]; const bf16_t* xs = XB + (size_t)r * 1024;
#pragma unroll
                    for (int i = 0; i < 4; ++i) bw[q][i] = *(const u32x2*)(xs + lane * 4 + i * 256); } }
#pragma unroll
            for (int q = 0; q < 4; ++q) { const int r = r0 + q * G * 8; if (r < T) { const float sc = rsqrtf(rs[q] * (1.0f / 1024.0f) + 1e-6f); float* xp = p.out + (size_t)r * 1024;
#pragma unroll
                for (int i = 0; i < 4; ++i) { const f32x4 v = (f32x4){bflo(bw[q][i].x), bfhi(bw[q][i].x), bflo(bw[q][i].y), bfhi(bw[q][i].y)}; *(f32x4*)(xp + lane * 4 + i * 256) = v * sc * wv[i]; } } }
        }
    }
    PHASE_END
#undef IN
#undef SEAM
}

extern "C" void kernel_launch(void* const* d_in, const int* in_sizes, int n_in, void* d_out, int out_size, void* d_ws, size_t ws_size, hipStream_t stream) {
    static int grid_blocks = 0;
    if (!grid_blocks) {
        int dev = 0, cus = 0, per_cu = 0;
        hipGetDevice(&dev);
        hipDeviceGetAttribute(&cus, hipDeviceAttributeMultiprocessorCount, dev);
        hipFuncSetAttribute((const void*)fwd_kernel, hipFuncAttributeMaxDynamicSharedMemorySize, LDS_BYTES);
        hipOccupancyMaxActiveBlocksPerMultiprocessor(&per_cu, (const void*)fwd_kernel, 512, LDS_BYTES);
        if (per_cu < 1) per_cu = 1;
        grid_blocks = cus * per_cu;
        if (ws_size < WS_END) fprintf(stderr, "kernel_launch: workspace too small: %zu < %zu\n", ws_size, (size_t)WS_END);
    }
    Params p{};
    for (int i = 0; i < 35; ++i) p.in[i] = (const float*)d_in[i];
    p.out = (float*)d_out; p.ws = (unsigned char*)d_ws; p.ph_lo = 0; p.ph_hi = PH_HI;
    void* args[] = {&p};
    hipError_t e = hipLaunchCooperativeKernel((const void*)fwd_kernel, dim3(grid_blocks), dim3(512), args, LDS_BYTES, stream);
    if (e != hipSuccess) fprintf(stderr, "cooperative launch failed: %s (grid %d)\n", hipGetErrorString(e), grid_blocks);
}
```

```cpp
#include <hip/hip_runtime.h>
#include <hip/hip_cooperative_groups.h>
#include <cstdio>
namespace cg = cooperative_groups;

#define LAS __attribute__((address_space(3)))
typedef unsigned short bf16_t;
typedef short bf16x8 __attribute__((ext_vector_type(8)));
typedef short bf16x4 __attribute__((ext_vector_type(4)));
typedef float f32x4 __attribute__((ext_vector_type(4)));
typedef unsigned u32x4 __attribute__((ext_vector_type(4)));
typedef unsigned u32x2 __attribute__((ext_vector_type(2)));

constexpr int TP = 65536;
constexpr int TS = 256;
constexpr int T = TP + TS;
constexpr int DM = 1024;
constexpr int NCH = 4160;
constexpr int CRG = 4352;
constexpr int CRV = 4112;

constexpr size_t al256(size_t x) { return (x + 255) & ~(size_t)255; }
constexpr size_t WS_W1T = 0;
constexpr size_t WS_WGLU = WS_W1T + (size_t)2816 * 1024 * 2;
constexpr size_t WS_WOUT = WS_WGLU + (size_t)512 * 512 * 2;
constexpr size_t WS_WF1_0 = WS_WOUT + (size_t)1024 * 1024 * 2;
constexpr size_t WS_WFD_0 = WS_WF1_0 + (size_t)5632 * 1024 * 2;
constexpr size_t WS_WQKV = WS_WFD_0 + (size_t)1024 * 2816 * 2;
constexpr size_t WS_WO = WS_WQKV + (size_t)1536 * 1024 * 2;
constexpr size_t WS_WF1_1 = WS_WO + (size_t)1024 * 1024 * 2;
constexpr size_t WS_WFD_1 = WS_WF1_1 + (size_t)5632 * 1024 * 2;
constexpr size_t WS_KGT = WS_WFD_1 + (size_t)1024 * 2816 * 2;
constexpr size_t WS_HT = WS_KGT + (size_t)32 * 256 * 384 * 2;
constexpr size_t WS_LP16 = WS_HT + (size_t)32 * 256 * 256 * 2;
constexpr size_t WS_SUMSQ = WS_LP16 + (size_t)32 * 64 * 2 * 4;
constexpr size_t WS_GATES = WS_SUMSQ + al256((size_t)4 * T * 4);
constexpr size_t WS_GL = WS_GATES + al256((size_t)T * 8 * 4);
constexpr size_t WS_BAR = WS_GL + al256((size_t)NCH * 4);
constexpr size_t WS_R1 = WS_BAR + 256;
constexpr size_t R1_BYTES = (size_t)T * 1024 * 2;
constexpr size_t WS_R2 = WS_R1 + R1_BYTES;
constexpr size_t R2_BYTES = (size_t)T * 1536 * 2;
constexpr size_t WS_R3 = WS_R2 + R2_BYTES;
constexpr size_t GDN_CH_BYTES = 73728;
constexpr size_t GDN_BYTES = (size_t)NCH * GDN_CH_BYTES;
constexpr size_t R3_BYTES = GDN_BYTES + (size_t)T * 512 * 2;
constexpr size_t WS_R4 = WS_R3 + R3_BYTES;
constexpr size_t R4_BYTES = (size_t)T * 1024 * 2;
constexpr size_t WS_R5 = WS_R4 + R4_BYTES;
constexpr size_t R5_BYTES = (size_t)32 * CRG * 384 * 2;
constexpr size_t WS_END = WS_R5 + R5_BYTES;
static_assert(R3_BYTES >= (size_t)T * 2816 * 2, "ACT fits R3");
static_assert((size_t)32 * CRG * 128 * 4 <= R1_BYTES, "SS fits R1");
static_assert((size_t)T * 512 * 2 <= R5_BYTES, "K|V fit R5");
static_assert(WS_END <= (size_t)1073741824, "workspace");

constexpr size_t O_Y = 0;
constexpr size_t O_PS5RE = 67371008, O_PS5IM = 67387392, O_PGDN = 67403776, O_PCONV = 67928064, O_PK = 67964928, O_PV = 68227072;
constexpr size_t O_SS5RE = 68489216, O_SS5IM = 68521984, O_SGDN = 68554752, O_SCONV = 69603328, O_SK = 69677056, O_SV = 70201344;

constexpr int LDS_BYTES = 131072;
#ifndef CG_SEAMS
#define CG_SEAMS 0
#endif
#ifndef REP_MASK
#define REP_MASK 0
#endif
#ifndef PH_HI
#define PH_HI 15
#endif

struct Params { const float* in[35]; float* out; unsigned char* ws; int ph_lo, ph_hi; };
typedef const __attribute__((address_space(4))) Params& KPR;
typedef const __attribute__((address_space(4))) Params* KPP;
__device__ __forceinline__ int ltid() { int t = threadIdx.x; asm volatile("" : "+v"(t)); return t; }
__device__ __forceinline__ KPP launder_kp() { KPP q = (KPP)__builtin_amdgcn_kernarg_segment_ptr(); asm volatile("" : "+s"(q)); return q; }

typedef float f32x2v __attribute__((ext_vector_type(2)));
typedef __bf16 bf16x2v __attribute__((ext_vector_type(2)));
__device__ __forceinline__ unsigned cvt_pk_bf16(float lo, float hi) { const f32x2v v = {lo, hi}; const bf16x2v b = __builtin_convertvector(v, bf16x2v); return __builtin_bit_cast(unsigned, b); }
__device__ __forceinline__ bf16_t f2bf(float f) { return (bf16_t)(cvt_pk_bf16(f, 0.f) & 0xffffu); }
__device__ __forceinline__ float bf2f(bf16_t b) { return __uint_as_float(((unsigned)b) << 16); }
__device__ __forceinline__ float bflo(unsigned w) { return __uint_as_float(w << 16); }
__device__ __forceinline__ float bfhi(unsigned w) { return __uint_as_float(w & 0xffff0000u); }
__device__ __forceinline__ float silu_f(float x) { return x * __builtin_amdgcn_rcpf(1.0f + __expf(-x)); }
__device__ __forceinline__ float sigmoid_f(float x) { return __builtin_amdgcn_rcpf(1.0f + __expf(-x)); }
__device__ __forceinline__ float gelu_tanh_f(float x) { const float u = 1.5957691216057308f * (x + 0.044715f * x * x * x); return x * __builtin_amdgcn_rcpf(1.0f + __expf(-u)); }
#define LDS_BARRIER() do { asm volatile("s_waitcnt lgkmcnt(0)" ::: "memory"); __builtin_amdgcn_s_barrier(); asm volatile("" ::: "memory"); } while (0)

namespace pg8 {
constexpr int BM = 256, BK = 64, HALF = 128, HTB = HALF * BK * 2, STAGE_BYTES = 8 * HTB, NXCD = 8, WGM = 8;
__device__ __forceinline__ int lds_byte(int r, int c) { const int st = (r >> 4) * 2 + (c >> 5), rr = r & 15, cc = c & 31, ob = rr * 64 + cc * 2; return st * 1024 + (ob ^ (((ob >> 9) & 1) << 5)); }
__device__ __forceinline__ void stage_rc(int b, int& R, int& C) { const int st = b / 1024, sb = b % 1024, swz = sb ^ (((sb >> 9) & 1) << 5); R = (st >> 1) * 16 + swz / 64; C = (st & 1) * 32 + (swz % 64) / 2; }
__device__ __forceinline__ int perm32(int rho) { const int n = rho >> 4, i = rho & 15; return 8 * (i >> 2) + 4 * n + (i & 3); }
struct Unit { int pm, pn; };
struct Gemm { const bf16_t* A; const bf16_t* Bt; int lda, ldb, K; };
struct StaticOrder {
    int nM, nN, nwg, G, c;
    __device__ void init(int M, int N, int G_, int c_) { nM = M / BM; nN = N / BM; nwg = nM * nN; G = G_; c = c_; }
    __device__ bool next(int i, Unit& u) const {
        const long L = (long)i * G + c; if (L >= nwg) return false;
        int wgid = (int)L; { const int q = nwg / NXCD, r = nwg % NXCD, xcd = wgid % NXCD, off = wgid / NXCD; wgid = (xcd < r ? xcd * (q + 1) : r * (q + 1) + (xcd - r) * q) + off; }
        const int nig = WGM * nN, gid = wgid / nig, fm = gid * WGM, gsz = (nM - fm) < WGM ? (nM - fm) : WGM;
        u.pm = fm + ((wgid % nig) % gsz); u.pn = (wgid % nig) / gsz; return true;
    }
};
struct GroupOrder {
    int G, c;
    __device__ bool next(int i, Unit& u) const { const int L = i * G + c; if (L >= 32 * 17) return false; u.pm = L; u.pn = L / 17; return true; }
};

template <class Epi, class Sched>
__device__ __forceinline__ void gemm_phase(LAS unsigned char* lds, const Gemm g, const Sched& S, const Epi& E) {
    const int tid = ltid(), wid = __builtin_amdgcn_readfirstlane(tid >> 6), lane = tid & 63, wr = wid >> 2, wc = wid & 3, fr = lane & 15, fq = lane >> 4;
    const int K = g.K, nt = K / BK;
    unsigned voffA[2], voffB[2];
#pragma unroll
    for (int i = 0; i < 2; ++i) { int R, C; stage_rc(tid * 16 + i * 8192, R, C); const int Rb = Epi::PERM ? ((R & ~31) + perm32(R & 31)) : R;
        voffA[i] = (unsigned)(R * g.lda + C) * 2u; voffB[i] = (unsigned)(Rb * g.ldb + C) * 2u; }
    const size_t kstep = (size_t)(BK * 2);
    const size_t hstepA = (size_t)HALF * g.lda * 2, hstepB = (size_t)HALF * g.ldb * 2;
    const size_t tstepA = 2 * hstepA, tstepB = 2 * hstepB;
    const unsigned ldsw = (unsigned)wid * 1024u;
    const int aoff = lds_byte(wr * 64 + fr, fq * 8), boff = lds_byte(wc * 32 + fr, fq * 8);
#define PG8_SA(b, h) (((b) * 2 + (h)) * HTB)
#define PG8_SB(b, h) ((4 + (b) * 2 + (h)) * HTB)
#define PG8_STAGE(bufoff, gbase, voff) do { _Pragma("unroll") for (int _i = 0; _i < 2; ++_i) \
        __builtin_amdgcn_global_load_lds((const unsigned*)((const char*)(gbase) + (voff)[_i]), (LAS unsigned*)(lds + (bufoff) + ldsw + _i * 8192), 16, 0, 0); } while (0)
#define PG8_LDA(dst, b, h) do { _Pragma("unroll") for (int m = 0; m < 4; ++m) _Pragma("unroll") for (int k = 0; k < 2; ++k) dst[m][k] = *(const LAS bf16x8*)(lds + PG8_SA(b, h) + aoff + m * 2048 + k * 1024); } while (0)
#define PG8_LDB(dst, b, h) do { _Pragma("unroll") for (int n = 0; n < 2; ++n) _Pragma("unroll") for (int k = 0; k < 2; ++k) dst[n][k] = *(const LAS bf16x8*)(lds + PG8_SB(b, h) + boff + n * 2048 + k * 1024); } while (0)
#define PG8_MMA(ai, bj, At, Bt) do { __builtin_amdgcn_s_setprio(1); _Pragma("unroll") for (int m = 0; m < 4; ++m) _Pragma("unroll") for (int n = 0; n < 2; ++n) _Pragma("unroll") for (int k = 0; k < 2; ++k) \
        acc[ai][bj][m][n] = __builtin_amdgcn_mfma_f32_16x16x32_bf16(Bt[n][k], At[m][k], acc[ai][bj][m][n], 0, 0, 0); __builtin_amdgcn_s_setprio(0); } while (0)
#define PG8_WAIT_V(n) asm volatile("s_waitcnt vmcnt(" #n ")" ::: "memory")
#define PG8_WAIT_L(n) asm volatile("s_waitcnt lgkmcnt(" #n ")" ::: "memory")
#define PG8_BAR __builtin_amdgcn_s_barrier()
#define PG8_SCHED __builtin_amdgcn_sched_barrier(0)
    Unit cur, nxt; int ui = 0;
    if (!S.next(0, cur)) return;
    f32x4 acc[2][2][4][2];
#pragma unroll
    for (int a = 0; a < 2; ++a)
#pragma unroll
        for (int b = 0; b < 2; ++b)
#pragma unroll
            for (int m = 0; m < 4; ++m)
#pragma unroll
                for (int n = 0; n < 2; ++n) acc[a][b][m][n] = (f32x4){0.f, 0.f, 0.f, 0.f};
    bf16x8 At[4][2], B0[2][2], B1[2][2];
    const char* cA = (const char*)g.A + (size_t)cur.pm * tstepA; const char* cB = (const char*)g.Bt + (size_t)cur.pn * tstepB;
    PG8_STAGE(PG8_SB(0, 0), cB, voffB); PG8_STAGE(PG8_SB(0, 1), cB + hstepB, voffB); PG8_STAGE(PG8_SA(0, 0), cA, voffA); PG8_STAGE(PG8_SA(0, 1), cA + hstepA, voffA);
    if (wr == 1) PG8_BAR;
    PG8_WAIT_V(2); PG8_BAR;
    PG8_STAGE(PG8_SB(1, 0), cB + kstep, voffB); PG8_STAGE(PG8_SA(1, 0), cA + kstep, voffA); PG8_STAGE(PG8_SB(1, 1), cB + hstepB + kstep, voffB);
    PG8_WAIT_V(6); PG8_BAR;
    for (;;) {
        const bool has_next = S.next(ui + 1, nxt);
        const char* nA = has_next ? (const char*)g.A + (size_t)nxt.pm * tstepA : cA; const char* nB = has_next ? (const char*)g.Bt + (size_t)nxt.pn * tstepB : cB;
        for (int t = 0; t < nt; t += 2) {
            const bool last = (t == nt - 2);
            const char* a1 = cA + (size_t)(t + 1) * kstep;
            const char* a2 = last ? nA : cA + (size_t)(t + 2) * kstep; const char* b2 = last ? nB : cB + (size_t)(t + 2) * kstep;
            const char* a3 = a2 + kstep; const char* b3 = b2 + kstep;
            PG8_LDB(B0, 0, 0); PG8_LDB(B1, 0, 1); PG8_SCHED; PG8_LDA(At, 0, 0); PG8_STAGE(PG8_SA(1, 1), a1 + hstepA, voffA);
            PG8_WAIT_V(8); PG8_WAIT_L(0); PG8_BAR; PG8_MMA(0, 0, At, B0); PG8_MMA(0, 1, At, B1); PG8_BAR; PG8_SCHED;
            PG8_LDA(At, 0, 1); PG8_STAGE(PG8_SB(0, 0), b2, voffB); PG8_STAGE(PG8_SB(0, 1), b2 + hstepB, voffB); PG8_STAGE(PG8_SA(0, 0), a2, voffA);
            PG8_WAIT_V(8); PG8_WAIT_L(0); PG8_BAR; PG8_MMA(1, 0, At, B0); PG8_MMA(1, 1, At, B1); PG8_BAR; PG8_SCHED;
            PG8_LDB(B0, 1, 0); PG8_LDB(B1, 1, 1); PG8_SCHED; PG8_LDA(At, 1, 0); PG8_STAGE(PG8_SA(0, 1), a2 + hstepA, voffA);
            PG8_WAIT_V(8); PG8_WAIT_L(0); PG8_BAR; PG8_MMA(0, 0, At, B0); PG8_MMA(0, 1, At, B1); PG8_BAR; PG8_SCHED;
            PG8_LDA(At, 1, 1); PG8_STAGE(PG8_SB(1, 0), b3, voffB); PG8_STAGE(PG8_SB(1, 1), b3 + hstepB, voffB); PG8_STAGE(PG8_SA(1, 0), a3, voffA);
            PG8_WAIT_V(8); PG8_WAIT_L(0); PG8_BAR; PG8_MMA(1, 0, At, B0); PG8_MMA(1, 1, At, B1); PG8_BAR; PG8_SCHED;
        }
        if (wr == 0) PG8_BAR;
        { const int lE = ltid() & 63; E(acc, cur, wr, wc, lE & 15, lE >> 4); }
        if (!has_next) break;
#pragma unroll
        for (int a = 0; a < 2; ++a)
#pragma unroll
            for (int b = 0; b < 2; ++b)
#pragma unroll
                for (int m = 0; m < 4; ++m)
#pragma unroll
                    for (int n = 0; n < 2; ++n) acc[a][b][m][n] = (f32x4){0.f, 0.f, 0.f, 0.f};
        cur = nxt; cA = nA; cB = nB; ++ui;
        if (wr == 1) PG8_BAR;
    }
    PG8_WAIT_V(0);
    PG8_BAR;
#undef PG8_SA
#undef PG8_SB
#undef PG8_STAGE
#undef PG8_LDA
#undef PG8_LDB
#undef PG8_MMA
#undef PG8_WAIT_V
#undef PG8_WAIT_L
#undef PG8_BAR
#undef PG8_SCHED
}
}
using pg8::Unit;

__device__ __forceinline__ u32x4 pack8(const f32x4 a, const f32x4 b) { u32x4 w; w.x = cvt_pk_bf16(a[0], a[1]); w.y = cvt_pk_bf16(a[2], a[3]); w.z = cvt_pk_bf16(b[0], b[1]); w.w = cvt_pk_bf16(b[2], b[3]); return w; }
__device__ __forceinline__ void unpack8(const u32x4 w, f32x4& a, f32x4& b) { a = (f32x4){bflo(w.x), bfhi(w.x), bflo(w.y), bfhi(w.y)}; b = (f32x4){bflo(w.z), bfhi(w.z), bflo(w.w), bfhi(w.w)}; }

struct Epi1 {
    static constexpr bool PERM = true;
    bf16_t* ucat; bf16_t* qkvraw; bf16_t* zg; float* gates;
    __device__ __forceinline__ void operator()(const f32x4 (&acc)[2][2][4][2], const Unit& u, int wr, int wc, int fr, int fq) const {
        const int row0 = u.pm * 256 + wr * 64 + fr, pn = u.pn;
#pragma unroll
        for (int ai = 0; ai < 2; ++ai)
#pragma unroll
            for (int m = 0; m < 4; ++m) { const int r = row0 + ai * 128 + m * 16;
#pragma unroll
                for (int bj = 0; bj < 2; ++bj) { const int c0 = pn * 256 + bj * 128 + wc * 32 + 8 * fq;
                    if (pn == 10) { if (bj == 0 && wc == 0 && fq == 0) { *(f32x4*)(gates + (size_t)r * 8) = acc[ai][bj][m][0]; *(f32x4*)(gates + (size_t)r * 8 + 4) = acc[ai][bj][m][1]; } }
                    else { const u32x4 w = pack8(acc[ai][bj][m][0], acc[ai][bj][m][1]); bf16_t* dst;
                        if (pn < 2) dst = ucat + ((size_t)((c0 >> 4) * CRG + (r >> 4)) * 384 + (r & 15) * 16 + (c0 & 15));
                        else if (pn < 8) dst = qkvraw + (size_t)r * 1536 + (c0 - 512);
                        else dst = zg + (size_t)r * 512 + (c0 - 2048);
                        *(u32x4*)dst = w; } } }
    }
};
struct EpiS {
    static constexpr bool PERM = false;
    float* ss;
    __device__ __forceinline__ void operator()(const f32x4 (&acc)[2][2][4][2], const Unit& u, int wr, int wc, int fr, int fq) const {
        const int row0 = u.pm * 256 + wr * 64 + fr, col0 = wc * 32 + 4 * fq;
#pragma unroll
        for (int ai = 0; ai < 2; ++ai)
#pragma unroll
            for (int m = 0; m < 4; ++m) { float* rp = ss + (size_t)(row0 + ai * 128 + m * 16) * 128 + col0;
#pragma unroll
                for (int n = 0; n < 2; ++n) *(f32x4*)(rp + n * 16) = acc[ai][0][m][n]; }
    }
};
struct EpiY {
    static constexpr bool PERM = true;
    const bf16_t* ucat; const float* dvec; bf16_t* zs5;
    __device__ __forceinline__ void operator()(const f32x4 (&acc)[2][2][4][2], const Unit& u, int wr, int wc, int fr, int fq) const {
        const int g = u.pn, crow0 = u.pm * 256 + wr * 64 + fr;
        f32x4 dd[2][2];
#pragma unroll
        for (int bj = 0; bj < 2; ++bj) { const int cp = (bj * 128 + wc * 32 + 8 * fq) & 15; dd[bj][0] = *(const f32x4*)(dvec + g * 16 + cp); dd[bj][1] = *(const f32x4*)(dvec + g * 16 + cp + 4); }
#pragma unroll
        for (int ai = 0; ai < 2; ++ai) {
            u32x4 uw[4][2];
#pragma unroll
            for (int m = 0; m < 4; ++m) { const int crow = crow0 + ai * 128 + m * 16, cr = crow - g * CRG;
#pragma unroll
                for (int bj = 0; bj < 2; ++bj) { const int n0 = bj * 128 + wc * 32 + 8 * fq; uw[m][bj] = (u32x4){0u, 0u, 0u, 0u}; if (cr < CRV) uw[m][bj] = *(const u32x4*)(ucat + (size_t)crow * 384 + n0); } }
#pragma unroll
            for (int m = 0; m < 4; ++m) { const int crow = crow0 + ai * 128 + m * 16, cr = crow - g * CRG;
                if (cr < CRV) {
#pragma unroll
                    for (int bj = 0; bj < 2; ++bj) { const int n0 = bj * 128 + wc * 32 + 8 * fq, tl = n0 >> 4, cp = n0 & 15;
                        f32x4 u0, u1; unpack8(uw[m][bj], u0, u1);
                        f32x4 y0 = acc[ai][bj][m][0] + dd[bj][0] * u0, y1 = acc[ai][bj][m][1] + dd[bj][1] * u1;
#pragma unroll
                        for (int j = 0; j < 4; ++j) { y0[j] = gelu_tanh_f(y0[j]); y1[j] = gelu_tanh_f(y1[j]); }
                        *(u32x4*)(zs5 + (size_t)(cr * 16 + tl) * 512 + g * 16 + cp) = pack8(y0, y1); } } }
            asm volatile("" ::: "memory"); }
    }
};
struct EpiGlu {
    static constexpr bool PERM = true;
    const bf16_t* zs5; const float* bglu; bf16_t* mixin;
    __device__ __forceinline__ void operator()(const f32x4 (&acc)[2][2][4][2], const Unit& u, int wr, int wc, int fr, int fq) const {
        const int row0 = u.pm * 256 + wr * 64 + fr;
#pragma unroll
        for (int bj = 0; bj < 2; ++bj) { const int c0 = u.pn * 256 + bj * 128 + wc * 32 + 8 * fq;
            const f32x4 b0 = *(const f32x4*)(bglu + c0), b1 = *(const f32x4*)(bglu + c0 + 4);
#pragma unroll
            for (int ai = 0; ai < 2; ++ai)
#pragma unroll
                for (int m = 0; m < 4; ++m) { const int r = row0 + ai * 128 + m * 16;
                    const u32x4 zw = *(const u32x4*)(zs5 + (size_t)r * 512 + c0); f32x4 z0, z1; unpack8(zw, z0, z1);
                    f32x4 o0, o1;
#pragma unroll
                    for (int j = 0; j < 4; ++j) { o0[j] = z0[j] * sigmoid_f(acc[ai][bj][m][0][j] + b0[j]); o1[j] = z1[j] * sigmoid_f(acc[ai][bj][m][1][j] + b1[j]); }
                    *(u32x4*)(mixin + (size_t)r * 1024 + c0) = pack8(o0, o1); } }
    }
};
template <bool F32BASE> struct EpiRes {
    static constexpr bool PERM = false;
    const float* base_p; const float* base_s; bf16_t* xb; float* sumsq;
    __device__ __forceinline__ void operator()(const f32x4 (&acc)[2][2][4][2], const Unit& u, int wr, int wc, int fr, int fq) const {
        const int row0 = u.pm * 256 + wr * 64 + fr, col0 = u.pn * 256 + wc * 32 + 4 * fq;
        constexpr int MB = F32BASE ? 2 : 4;
#pragma unroll
        for (int ai = 0; ai < 2; ++ai)
#pragma unroll
            for (int m0 = 0; m0 < 4; m0 += MB) {
                f32x4 b[MB][2][2];
#pragma unroll
                for (int mm = 0; mm < MB; ++mm) { const int r = row0 + ai * 128 + (m0 + mm) * 16;
                    const float* bp = F32BASE ? ((r < TP) ? base_p + (size_t)r * 1024 : base_s + (size_t)(r - TP) * 1024) : nullptr;
#pragma unroll
                    for (int bj = 0; bj < 2; ++bj)
#pragma unroll
                        for (int n = 0; n < 2; ++n) { const int c = col0 + bj * 128 + n * 16;
                            if (F32BASE) b[mm][bj][n] = *(const f32x4*)(bp + c);
                            else { const u32x2 bw = *(const u32x2*)(xb + (size_t)r * 1024 + c); b[mm][bj][n] = (f32x4){bflo(bw.x), bfhi(bw.x), bflo(bw.y), bfhi(bw.y)}; } } }
#pragma unroll
                for (int mm = 0; mm < MB; ++mm) { const int m = m0 + mm, r = row0 + ai * 128 + m * 16; float s = 0.f;
#pragma unroll
                    for (int bj = 0; bj < 2; ++bj)
#pragma unroll
                        for (int n = 0; n < 2; ++n) { const int c = col0 + bj * 128 + n * 16; const f32x4 v = b[mm][bj][n] + acc[ai][bj][m][n];
                            u32x2 w; w.x = cvt_pk_bf16(v[0], v[1]); w.y = cvt_pk_bf16(v[2], v[3]); *(u32x2*)(xb + (size_t)r * 1024 + c) = w;
                            s += (v[0] * v[0] + v[1] * v[1]) + (v[2] * v[2] + v[3] * v[3]); }
                    s += __shfl_xor(s, 16); s += __shfl_xor(s, 32);
                    if (fq == 0) atomicAdd(sumsq + r, s); }
                asm volatile("" ::: "memory"); }
    }
};
struct EpiFF {
    static constexpr bool PERM = true;
    const float* sumsq; bf16_t* act;
    __device__ __forceinline__ void operator()(const f32x4 (&acc)[2][2][4][2], const Unit& u, int wr, int wc, int fr, int fq) const {
        const int row0 = u.pm * 256 + wr * 64 + fr, c0 = u.pn * 128 + wc * 32 + 8 * fq;
        float rsv[2][4];
#pragma unroll
        for (int ai = 0; ai < 2; ++ai)
#pragma unroll
            for (int m = 0; m < 4; ++m) rsv[ai][m] = sumsq[row0 + ai * 128 + m * 16];
#pragma unroll
        for (int ai = 0; ai < 2; ++ai)
#pragma unroll
            for (int m = 0; m < 4; ++m) { const int r = row0 + ai * 128 + m * 16; const float rs = rsqrtf(rsv[ai][m] * (1.0f / 1024.0f) + 1e-6f);
                f32x4 o0, o1;
#pragma unroll
                for (int j = 0; j < 4; ++j) { o0[j] = silu_f(acc[ai][0][m][0][j] * rs) * (acc[ai][1][m][0][j] * rs); o1[j] = silu_f(acc[ai][0][m][1][j] * rs) * (acc[ai][1][m][1][j] * rs); }
                *(u32x4*)(act + (size_t)r * 2816 + c0) = pack8(o0, o1); }
    }
};
struct EpiQKV {
    static constexpr bool PERM = true;
    const float* sumsq; bf16_t* q; bf16_t* kb; bf16_t* vb; float* opk; float* opv; float* osk; float* osv;
    __device__ __forceinline__ void operator()(const f32x4 (&acc)[2][2][4][2], const Unit& u, int wr, int wc, int fr, int fq) const {
        const int row0 = u.pm * 256 + wr * 64 + fr, pn = u.pn;
        float rsv[2][4];
#pragma unroll
        for (int ai = 0; ai < 2; ++ai)
#pragma unroll
            for (int m = 0; m < 4; ++m) rsv[ai][m] = sumsq[row0 + ai * 128 + m * 16];
#pragma unroll
        for (int ai = 0; ai < 2; ++ai)
#pragma unroll
            for (int m = 0; m < 4; ++m) { const int r = row0 + ai * 128 + m * 16; const float rs = rsqrtf(rsv[ai][m] * (1.0f / 1024.0f) + 1e-6f);
#pragma unroll
                for (int bj = 0; bj < 2; ++bj) { const int cl = bj * 128 + wc * 32 + 8 * fq;
                    if (pn < 4) { const float sc = rs * 0.125f; *(u32x4*)(q + (size_t)r * 1024 + pn * 256 + cl) = pack8(acc[ai][bj][m][0] * sc, acc[ai][bj][m][1] * sc); }
                    else { const f32x4 v0 = acc[ai][bj][m][0] * rs, v1 = acc[ai][bj][m][1] * rs;
                        bf16_t* dst = (pn == 4 ? kb : vb) + (size_t)r * 256 + cl; *(u32x4*)dst = pack8(v0, v1);
                        float* od = nullptr;
                        if (r < TP) { const int t = r & 8191; if (t >= 8064) od = (pn == 4 ? opk : opv) + ((size_t)((r >> 13) * 128 + (t - 8064)) * 256 + cl); }
                        else { const int rr = r - TP; od = (pn == 4 ? osk : osv) + ((size_t)((rr >> 4) * 128 + 112 + (rr & 15)) * 256 + cl); }
                        if (od) { *(f32x4*)od = v0; *(f32x4*)(od + 4) = v1; } } } }
    }
};

struct WDesc { const float* src; int ld, K, N, rowoff, mode; bf16_t* dst; const float* fold; };
__device__ __forceinline__ void wt_tile(const WDesc& d, int tile, LAS float* tl) {
    const int ntn = (d.N + 63) >> 6, kt = tile / ntn, ntile = tile - kt * ntn, k0 = kt * 64, n0 = ntile * 64, tid = ltid();
#pragma unroll
    for (int ps = 0; ps < 8; ++ps) { const int k = ps * 8 + (tid >> 6), n = tid & 63; float v = 0.f;
        if (n0 + n < d.N) v = d.src[(size_t)(k0 + k) * d.ld + n0 + n];
        if (d.fold) v *= d.fold[k0 + k];
        tl[k * 65 + n] = v; }
    __syncthreads();
#pragma unroll
    for (int ps = 0; ps < 8; ++ps) { const int n = ps * 8 + (tid >> 6), k = tid & 63, gn = n0 + n;
        if (gn < d.N) { const int drow = (d.mode ? ((gn >> 7) * 256 + (gn & 127)) : gn) + d.rowoff; d.dst[(size_t)drow * d.K + k0 + k] = f2bf(tl[k * 65 + n]); } }
    __syncthreads();
}

__device__ __forceinline__ void wt_run(KPR p, int it, LAS unsigned char* lds) {
    const float* nf = p.in[9]; const float* nm = p.in[8];
    int t = it; WDesc d;
    if (t < 656) d = WDesc{p.in[11], 2568, 1024, 2568, 0, 0, (bf16_t*)(p.ws + WS_W1T), nullptr};
    else if ((t -= 656) < 64) d = WDesc{p.in[20], 512, 512, 512, 0, 0, (bf16_t*)(p.ws + WS_WGLU), nullptr};
    else if ((t -= 64) < 256) d = WDesc{p.in[26], 1024, 1024, 1024, 0, 0, (bf16_t*)(p.ws + WS_WOUT), nullptr};
    else if ((t -= 256) < 704) d = WDesc{p.in[32], 2816, 1024, 2816, 0, 1, (bf16_t*)(p.ws + WS_WF1_0), nf};
    else if ((t -= 704) < 704) d = WDesc{p.in[33], 2816, 1024, 2816, 128, 1, (bf16_t*)(p.ws + WS_WF1_0), nf};
    else if ((t -= 704) < 704) d = WDesc{p.in[34], 1024, 2816, 1024, 0, 0, (bf16_t*)(p.ws + WS_WFD_0), nullptr};
    else if ((t -= 704) < 256) d = WDesc{p.in[27], 1024, 1024, 1024, 0, 0, (bf16_t*)(p.ws + WS_WQKV), nm + 1024};
    else if ((t -= 256) < 64) d = WDesc{p.in[28], 256, 1024, 256, 1024, 0, (bf16_t*)(p.ws + WS_WQKV), nm + 1024};
    else if ((t -= 64) < 64) d = WDesc{p.in[29], 256, 1024, 256, 1280, 0, (bf16_t*)(p.ws + WS_WQKV), nm + 1024};
    else if ((t -= 64) < 256) d = WDesc{p.in[31], 1024, 1024, 1024, 0, 0, (bf16_t*)(p.ws + WS_WO), nullptr};
    else if ((t -= 256) < 704) d = WDesc{p.in[32] + (size_t)1024 * 2816, 2816, 1024, 2816, 0, 1, (bf16_t*)(p.ws + WS_WF1_1), nf + 1024};
    else if ((t -= 704) < 704) d = WDesc{p.in[33] + (size_t)1024 * 2816, 2816, 1024, 2816, 128, 1, (bf16_t*)(p.ws + WS_WF1_1), nf + 1024};
    else { t -= 704; d = WDesc{p.in[34] + (size_t)2816 * 1024, 1024, 2816, 1024, 0, 0, (bf16_t*)(p.ws + WS_WFD_1), nullptr}; }
    wt_tile(d, t, (LAS float*)lds);
}
__device__ __forceinline__ void s5_gen_group(KPR p, int g, LAS unsigned char* lds) {
    LAS float* LP = (LAS float*)lds;
    LAS float* BB = LP + 17 * 64 * 2;
    LAS float* KL = BB + 64 * 16 * 2;
    LAS float* CF = KL + 4096;
    LAS float* CR = CF + 128; LAS float* CI = CR + 1024;
    const int tid = ltid();
    const float* lam_re = p.in[12]; const float* lam_im = p.in[13]; const float* log_dt = p.in[14];
    const float* b_re = p.in[15]; const float* b_im = p.in[16]; const float* c_re = p.in[17]; const float* c_im = p.in[18];
    bf16_t* kgt = (bf16_t*)(p.ws + WS_KGT) + (size_t)g * 256 * 384; bf16_t* ht = (bf16_t*)(p.ws + WS_HT) + (size_t)g * 256 * 256; float* lp16 = (float*)(p.ws + WS_LP16) + g * 128;
    if (tid < 64) { const int pp = tid; const double dt = exp((double)log_dt[g]); const double lr = (double)lam_re[g * 64 + pp], li = (double)lam_im[g * 64 + pp];
        for (int k = 0; k <= 16; ++k) { const double mg = exp(k * lr * dt), an = k * li * dt; const double cr = mg * cos(an), ci = mg * sin(an);
            LP[(k * 64 + pp) * 2] = (float)cr; LP[(k * 64 + pp) * 2 + 1] = (float)ci;
            if (k == 16) { lp16[pp * 2] = (float)cr; lp16[pp * 2 + 1] = (float)ci; }
            if (k == 1) { const double nr = cr - 1.0, ni = ci, dn = lr * lr + li * li; CF[pp * 2] = (float)((nr * lr + ni * li) / dn); CF[pp * 2 + 1] = (float)((ni * lr - nr * li) / dn); } } }
    __syncthreads();
    for (int e = tid; e < 1024; e += 512) { CR[e] = c_re[(size_t)g * 1024 + e]; CI[e] = c_im[(size_t)g * 1024 + e]; }
    for (int e = tid; e < 1024; e += 512) { const int pp = e >> 4; const float br = b_re[(size_t)g * 1024 + e], bi = b_im[(size_t)g * 1024 + e], fr_ = CF[pp * 2], fi_ = CF[pp * 2 + 1];
        BB[e * 2] = fr_ * br - fi_ * bi; BB[e * 2 + 1] = fr_ * bi + fi_ * br; }
    __syncthreads();
    for (int e = tid; e < 4096; e += 512) { const int k = e >> 8, c = (e >> 4) & 15, cp = e & 15; float s = 0.f;
#pragma unroll 8
        for (int pp = 0; pp < 64; ++pp) { const float cr = CR[c * 64 + pp], ci = CI[c * 64 + pp];
            const float lr = LP[(k * 64 + pp) * 2], li = LP[(k * 64 + pp) * 2 + 1], br = BB[(pp * 16 + cp) * 2], bi = BB[(pp * 16 + cp) * 2 + 1];
            const float mr = lr * br - li * bi, mi = lr * bi + li * br; s += cr * mr - ci * mi; }
        KL[e] = s; }
    __syncthreads();
    for (int e = tid; e < 256 * 384; e += 512) { const int n = e / 384, k = e - n * 384, t = n >> 4, c = n & 15; float v;
        if (k < 256) { const int s = k >> 4, cp = k & 15; v = (s <= t) ? KL[((t - s) * 16 + c) * 16 + cp] : 0.f; }
        else { const int pp = (k - 256) & 63; const float cr = CR[c * 64 + pp], ci = CI[c * 64 + pp];
            const float lr = LP[((t + 1) * 64 + pp) * 2], li = LP[((t + 1) * 64 + pp) * 2 + 1];
            v = (k < 320) ? (cr * lr - ci * li) : -(cr * li + ci * lr); }
        kgt[e] = f2bf(v); }
    for (int e = tid; e < 256 * 256; e += 512) { const int n = e >> 8, k = e & 255; float v = 0.f;
        if (n < 128) { const int pp = n & 63, s = k >> 4, cp = k & 15; const float lr = LP[((15 - s) * 64 + pp) * 2], li = LP[((15 - s) * 64 + pp) * 2 + 1], br = BB[(pp * 16 + cp) * 2], bi = BB[(pp * 16 + cp) * 2 + 1];
            v = (n < 64) ? (lr * br - li * bi) : (lr * bi + li * br); }
        ht[e] = f2bf(v); }
    __syncthreads();
}

__device__ __forceinline__ void phase0(KPR p, LAS unsigned char* lds) {
    const int tid = ltid(), G = gridDim.x, bx = blockIdx.x, lane = tid & 63, wid = tid >> 6;
    for (int g = bx; g < 32; g += G) s5_gen_group(p, g, lds);
    {
        const int shift = (bx + G - (32 % G)) % G; const int nt0 = (G > 160) ? 656 : 5840;
        for (int it = shift; it < nt0; it += G) wt_run(p, it, lds);
    }
    {
        bf16_t* h0 = (bf16_t*)(p.ws + WS_R1); const float* nw = p.in[8];
        f32x4 wv[4];
#pragma unroll
        for (int i = 0; i < 4; ++i) wv[i] = *(const f32x4*)(nw + lane * 4 + i * 256);
        for (int r0 = bx * 8 + wid; r0 < T; r0 += G * 8 * 4) {
            f32x4 v[4][4];
#pragma unroll
            for (int q = 0; q < 4; ++q) { const int r = r0 + q * G * 8; if (r < T) { const float* xp = (r < TP) ? p.in[0] + (size_t)r * 1024 : p.in[1] + (size_t)(r - TP) * 1024;
#pragma unroll
                for (int i = 0; i < 4; ++i) v[q][i] = *(const f32x4*)(xp + lane * 4 + i * 256); } else {
#pragma unroll
                for (int i = 0; i < 4; ++i) v[q][i] = (f32x4){0.f, 0.f, 0.f, 0.f}; } }
#pragma unroll
            for (int q = 0; q < 4; ++q) { const int r = r0 + q * G * 8; float s = 0.f;
#pragma unroll
                for (int i = 0; i < 4; ++i) s += (v[q][i][0] * v[q][i][0] + v[q][i][1] * v[q][i][1]) + (v[q][i][2] * v[q][i][2] + v[q][i][3] * v[q][i][3]);
#pragma unroll
                for (int o = 32; o >= 1; o >>= 1) s += __shfl_xor(s, o);
                const float rs = rsqrtf(s * (1.0f / 1024.0f) + 1e-6f);
                if (r < T) {
#pragma unroll
                    for (int i = 0; i < 4; ++i) { const f32x4 y = v[q][i] * rs * wv[i]; u32x2 w; w.x = cvt_pk_bf16(y[0], y[1]); w.y = cvt_pk_bf16(y[2], y[3]); *(u32x2*)(h0 + (size_t)r * 1024 + lane * 4 + i * 256) = w; } } }
        }
    }
    {
        const size_t gt = (size_t)bx * 512 + tid, gs = (size_t)G * 512;
        if (gt == 0) *(unsigned*)(p.ws + WS_BAR) = 0u;
        float* sq = (float*)(p.ws + WS_SUMSQ); for (size_t i = gt; i < (size_t)4 * T; i += gs) sq[i] = 0.f;
        unsigned* wpad = (unsigned*)(p.ws + WS_W1T + (size_t)2568 * 1024 * 2); for (size_t i = gt; i < (size_t)248 * 512; i += gs) wpad[i] = 0u;
        const float* ck = p.in[6]; const float* cv = p.in[7]; float* ok = p.out + O_SK; float* ov = p.out + O_SV;
        for (size_t i = gt; i < (size_t)16 * 112 * 256; i += gs) { const size_t b = i / (112 * 256), rem = i - b * (112 * 256); ok[b * 32768 + rem] = ck[b * 32768 + 4096 + rem]; ov[b * 32768 + rem] = cv[b * 32768 + 4096 + rem]; }
    }
}

struct GdnItem { int b, h, n, rowbase, ntok; bool samp; };
__device__ __forceinline__ GdnItem gdn_decode(int ch) { GdnItem it; it.samp = ch >= 4096;
    if (!it.samp) { it.b = ch >> 9; it.h = (ch >> 7) & 3; it.n = ch & 127; it.rowbase = it.b * 8192 + it.n * 64; it.ntok = 64; } else { const int s = ch - 4096; it.b = s >> 2; it.h = s & 3; it.n = 0; it.rowbase = TP + it.b * 16; it.ntok = 16; }
    return it; }
__device__ __forceinline__ void gdn_s1(KPR p, int ch, LAS unsigned char* buf, int t) {
    const GdnItem it = gdn_decode(ch); const int h = it.h, b = it.b, n = it.n, rowbase = it.rowbase, ntok = it.ntok; const bool samp = it.samp;
    LAS bf16_t* qn = (LAS bf16_t*)buf; LAS bf16_t* kn = qn + 64 * 136; LAS bf16_t* vv = kn + 64 * 136;
    const bf16_t* qkvraw = (const bf16_t*)(p.ws + WS_R2); const float* cw = p.in[22]; const float* cst = p.in[5];
    const int cg = t & 31, t0 = (t >> 5) * 8;
    u32x2 raw[3][11];
#pragma unroll
    for (int part = 0; part < 3; ++part) { const int cbase = part * 512 + h * 128 + cg * 4;
#pragma unroll
        for (int jj = 0; jj < 11; ++jj) { const int ti = t0 - 3 + jj, tabs = n * 64 + ti; raw[part][jj] = (u32x2){0u, 0u};
            if (ti < ntok) {
                if (tabs >= 0) raw[part][jj] = *(const u32x2*)(qkvraw + (size_t)(rowbase + ti) * 1536 + cbase);
                else if (samp) { const f32x4 f = *(const f32x4*)(cst + (size_t)(b * 3 + 3 + tabs) * 1536 + cbase); raw[part][jj].x = cvt_pk_bf16(f[0], f[1]); raw[part][jj].y = cvt_pk_bf16(f[2], f[3]); } } }
    }
#pragma unroll
    for (int part = 0; part < 3; ++part) {
        f32x4 xr[11]; f32x4 cwp[4];
#pragma unroll
        for (int j = 0; j < 4; ++j) cwp[j] = *(const f32x4*)(cw + j * 1536 + part * 512 + h * 128 + cg * 4);
#pragma unroll
        for (int jj = 0; jj < 11; ++jj) xr[jj] = (f32x4){bflo(raw[part][jj].x), bfhi(raw[part][jj].x), bflo(raw[part][jj].y), bfhi(raw[part][jj].y)};
        LAS bf16_t* dstm = (part == 0 ? qn : (part == 1 ? kn : vv)) + cg * 4;
        f32x4 y[8]; float ss[8];
#pragma unroll
        for (int tk = 0; tk < 8; ++tk) { const int tok = t0 + tk;
            y[tk] = xr[tk] * cwp[0] + xr[tk + 1] * cwp[1] + xr[tk + 2] * cwp[2] + xr[tk + 3] * cwp[3];
            if (tok >= ntok) y[tk] = (f32x4){0.f, 0.f, 0.f, 0.f};
#pragma unroll
            for (int e = 0; e < 4; ++e) y[tk][e] = silu_f(y[tk][e]);
            ss[tk] = (y[tk][0] * y[tk][0] + y[tk][1] * y[tk][1]) + (y[tk][2] * y[tk][2] + y[tk][3] * y[tk][3]); }
        if (part < 2) {
#pragma unroll
            for (int o = 1; o < 32; o <<= 1)
#pragma unroll
                for (int tk = 0; tk < 8; ++tk) ss[tk] += __shfl_xor(ss[tk], o); }
#pragma unroll
        for (int tk = 0; tk < 8; ++tk) { float sc = 1.0f;
            if (part < 2) { sc = rsqrtf(ss[tk] + 1e-6f); if (part == 0) sc *= 0.08838834764831845f; }
            u32x2 wv; wv.x = cvt_pk_bf16(y[tk][0] * sc, y[tk][1] * sc); wv.y = cvt_pk_bf16(y[tk][2] * sc, y[tk][3] * sc);
            *(LAS u32x2*)(dstm + (t0 + tk) * 136) = wv; }
    }
}
__device__ __forceinline__ void gdn_prep_phase(KPR p, LAS unsigned char* lds, int bx, int G) {
    const int tid = ltid(), lane = tid & 63, w = tid >> 6, fr = lane & 15, fq = lane >> 4;
    LAS float* Am = (LAS float*)(lds + 2 * 52224); LAS float* gcs = Am + 4096; LAS float* betas = gcs + 64; LAS float* egc = betas + 64;
    const float* gates = (const float*)(p.ws + WS_GATES);
    int ch = bx; if (ch >= NCH) return;
    if (tid >= 256) gdn_s1(p, ch, lds, tid - 256);
    for (int k = 0;; ++k) {
        LAS unsigned char* cur = lds + (k & 1) * 52224; LAS unsigned char* nxt = lds + ((k + 1) & 1) * 52224;
        LAS bf16_t* qn = (LAS bf16_t*)cur; LAS bf16_t* kn = qn + 64 * 136; LAS bf16_t* vv = kn + 64 * 136;
        const GdnItem it = gdn_decode(ch); const int h = it.h, rowbase = it.rowbase, ntok = it.ntok;
        unsigned char* cb = p.ws + WS_R3 + (size_t)ch * GDN_CH_BYTES;
        bf16_t* o_uT = (bf16_t*)cb; bf16_t* o_w = (bf16_t*)(cb + 16384); bf16_t* o_qd = (bf16_t*)(cb + 32768); bf16_t* o_kdT = (bf16_t*)(cb + 49152); bf16_t* o_attn = (bf16_t*)(cb + 65536);
        __syncthreads();
        if (tid < 64) { float gg = 0.f, be = 0.f;
            if (tid < ntok) { const float a = gates[(size_t)(rowbase + tid) * 8 + 4 + h], bb = gates[(size_t)(rowbase + tid) * 8 + h];
                const float xs = a + p.in[24][h]; const float sp = xs > 20.f ? xs : log1pf(expf(xs)); gg = -expf(p.in[23][h]) * sp; be = 1.0f / (1.0f + expf(-bb)); }
            float gc = gg;
#pragma unroll
            for (int o = 1; o < 64; o <<= 1) { const float v = __shfl_up(gc, o); if (lane >= o) gc += v; }
            gcs[tid] = gc; betas[tid] = be; egc[tid] = expf(gc);
            if (tid == 63) ((float*)(p.ws + WS_GL))[ch] = expf(gc); }
        __syncthreads();
        {
            const int rt = w & 3, kind = w >> 2; LAS bf16_t* am = kind ? qn : kn;
            bf16x8 af[4];
#pragma unroll
            for (int ks = 0; ks < 4; ++ks) af[ks] = *(const LAS bf16x8*)(am + (16 * rt + fr) * 136 + 32 * ks + 8 * fq);
#pragma unroll
            for (int ct = 0; ct < 4; ++ct) {
                f32x4 acc = (f32x4){0.f, 0.f, 0.f, 0.f};
                if (ct <= rt) {
#pragma unroll
                    for (int ks = 0; ks < 4; ++ks) { const bf16x8 bfr = *(const LAS bf16x8*)(kn + (16 * ct + fr) * 136 + 32 * ks + 8 * fq); acc = __builtin_amdgcn_mfma_f32_16x16x32_bf16(af[ks], bfr, acc, 0, 0, 0); } }
                const int col = 16 * ct + fr; const float gcc = gcs[col];
#pragma unroll
                for (int j = 0; j < 4; ++j) { const int row = 16 * rt + 4 * fq + j; const float dec = __expf(fminf(gcs[row] - gcc, 0.f));
                    if (kind == 0) Am[row * 64 + col] = (row > col) ? betas[row] * acc[j] * dec : 0.f;
                    else o_attn[row * 64 + col] = f2bf((row >= col) ? acc[j] * dec : 0.f); }
            }
        }
        __syncthreads();
        const int chn = ch + G;
        int vz = 0; asm volatile("" : "+v"(vz));
        if (tid < 256) {
            const int c = tid; const bool isu = c < 128; const int cc = isu ? c : c - 128; LAS bf16_t* srcm = isu ? vv : kn;
            LAS float* AmV = Am + vz; LAS float* beV = betas + vz; LAS float* egV = egc + vz;
            float X[64];
#pragma unroll
            for (int i = 0; i < 64; ++i) {
                float r = bf2f(srcm[i * 136 + cc]) * beV[i]; if (!isu) r *= egV[i];
                float pa[4] = {0.f, 0.f, 0.f, 0.f};
#pragma unroll
                for (int j4 = 0; j4 < (i + 3) / 4; ++j4) { const f32x4 a4 = *(const LAS f32x4*)(AmV + i * 64 + j4 * 4);
#pragma unroll
                    for (int jj = 0; jj < 4; ++jj) { if (j4 * 4 + jj < i) pa[jj] += a4[jj] * X[j4 * 4 + jj]; } }
                r -= (pa[0] + pa[1]) + (pa[2] + pa[3]);
                asm volatile("" : "+v"(r) :: "memory"); X[i] = r; }
            if (isu) {
#pragma unroll
                for (int i8 = 0; i8 < 8; ++i8) { u32x4 wv; wv.x = cvt_pk_bf16(X[i8 * 8], X[i8 * 8 + 1]); wv.y = cvt_pk_bf16(X[i8 * 8 + 2], X[i8 * 8 + 3]); wv.z = cvt_pk_bf16(X[i8 * 8 + 4], X[i8 * 8 + 5]); wv.w = cvt_pk_bf16(X[i8 * 8 + 6], X[i8 * 8 + 7]);
                    *(u32x4*)(o_uT + cc * 64 + i8 * 8) = wv; } }
            else {
#pragma unroll
                for (int i = 0; i < 64; ++i) o_w[i * 128 + cc] = f2bf(X[i]); }
            { LAS float* gcV = gcs + vz; LAS float* egV2 = egc + vz;
              if (c < 128) { const float gl_ = gcV[63];
#pragma unroll
                for (int i8 = 0; i8 < 8; ++i8) { float v[8];
#pragma unroll
                    for (int e = 0; e < 8; ++e) { const int tk = i8 * 8 + e; v[e] = bf2f(kn[tk * 136 + c]) * __expf(gl_ - gcV[tk]); }
                    u32x4 wv; wv.x = cvt_pk_bf16(v[0], v[1]); wv.y = cvt_pk_bf16(v[2], v[3]); wv.z = cvt_pk_bf16(v[4], v[5]); wv.w = cvt_pk_bf16(v[6], v[7]);
                    *(u32x4*)(o_kdT + c * 64 + i8 * 8) = wv; } }
              else { const int cq = c - 128;
#pragma unroll 8
                for (int i = 0; i < 64; ++i) o_qd[i * 128 + cq] = f2bf(bf2f(qn[i * 136 + cq]) * egV2[i]); } }
        } else {
            const int c = tid - 256;
            if (chn < NCH) gdn_s1(p, chn, nxt, c);
        }
        if (chn >= NCH) break;
        ch = chn;
    }
    __syncthreads();
}

struct GFrag { bf16x8 A1[4], A2[2], Ak[2]; float gl; };
__device__ __forceinline__ void gdn_load(GFrag& f, const unsigned char* ws, int ch, int w, int sl, int fr, int fq) {
    const unsigned char* cb = ws + WS_R3 + (size_t)ch * GDN_CH_BYTES;
    const bf16_t* kdT = (const bf16_t*)(cb + 49152);
    const bool vp = w < 4; const int tt = w & 3;
    const bf16_t* p1 = (const bf16_t*)(cb + (vp ? 16384 : 32768)) + (16 * tt + fr) * 128 + 8 * fq;
    const bf16_t* p2 = vp ? (const bf16_t*)cb + (sl * 32 + fr) * 64 + 16 * tt + 4 * fq : (const bf16_t*)(cb + 65536) + (16 * tt + fr) * 64 + 8 * fq;
    const int st2 = vp ? 16 * 64 : 32;
#pragma unroll
    for (int ks = 0; ks < 4; ++ks) f.A1[ks] = *(const bf16x8*)(p1 + 32 * ks);
#pragma unroll
    for (int k2 = 0; k2 < 2; ++k2) f.A2[k2] = *(const bf16x8*)(p2 + st2 * k2);
#pragma unroll
    for (int k2 = 0; k2 < 2; ++k2) f.Ak[k2] = *(const bf16x8*)(kdT + (16 * w + fr) * 64 + 32 * k2 + 8 * fq);
    f.gl = ((const float*)(ws + WS_GL))[ch];
}
__device__ __forceinline__ void gdn_step(const GFrag& cur, f32x4 (&accS)[2], LAS unsigned char* ST, LAS unsigned char* VN, bf16_t* gorow, int ntok, int w, int fr, int fq) {
    const bool vp = w < 4; const int tt = w & 3;
    f32x4 acc[2];
#pragma unroll
    for (int dt = 0; dt < 2; ++dt) acc[dt] = (f32x4){0.f, 0.f, 0.f, 0.f};
#pragma unroll
    for (int ks = 0; ks < 4; ++ks)
#pragma unroll
        for (int dt = 0; dt < 2; ++dt) { const bf16x8 bs = *(const LAS bf16x8*)(ST + (16 * dt + fr) * 272 + (32 * ks + 8 * fq) * 2);
            acc[dt] = __builtin_amdgcn_mfma_f32_16x16x32_bf16(cur.A1[ks], bs, acc[dt], 0, 0, 0); }
    if (vp) {
#pragma unroll
        for (int dt = 0; dt < 2; ++dt) { const float v0 = bf2f((bf16_t)cur.A2[dt][0]) - acc[dt][0], v1 = bf2f((bf16_t)cur.A2[dt][1]) - acc[dt][1], v2 = bf2f((bf16_t)cur.A2[dt][2]) - acc[dt][2], v3 = bf2f((bf16_t)cur.A2[dt][3]) - acc[dt][3];
            u32x2 wv; wv.x = cvt_pk_bf16(v0, v1); wv.y = cvt_pk_bf16(v2, v3); *(LAS u32x2*)(VN + (16 * dt + fr) * 144 + (16 * tt + 4 * fq) * 2) = wv; } }
    LDS_BARRIER();
    if (!vp) {
#pragma unroll
        for (int dt = 0; dt < 2; ++dt) {
#pragma unroll
            for (int k2 = 0; k2 < 2; ++k2) { const bf16x8 bv = *(const LAS bf16x8*)(VN + (16 * dt + fr) * 144 + (32 * k2 + 8 * fq) * 2); acc[dt] = __builtin_amdgcn_mfma_f32_16x16x32_bf16(cur.A2[k2], bv, acc[dt], 0, 0, 0); }
#pragma unroll
            for (int j = 0; j < 4; ++j) { const int tok = 16 * tt + 4 * fq + j; if (tok < ntok) gorow[(size_t)tok * 512 + 16 * dt] = f2bf(acc[dt][j]); } }
    }
#pragma unroll
    for (int d2 = 0; d2 < 2; ++d2) { accS[d2] = accS[d2] * cur.gl;
#pragma unroll
        for (int k2 = 0; k2 < 2; ++k2) { const bf16x8 bv = *(const LAS bf16x8*)(VN + (16 * d2 + fr) * 144 + (32 * k2 + 8 * fq) * 2); accS[d2] = __builtin_amdgcn_mfma_f32_16x16x32_bf16(cur.Ak[k2], bv, accS[d2], 0, 0, 0); }
        u32x2 wv; wv.x = cvt_pk_bf16(accS[d2][0], accS[d2][1]); wv.y = cvt_pk_bf16(accS[d2][2], accS[d2][3]);
        *(LAS u32x2*)(ST + (16 * d2 + fr) * 272 + (16 * w + 4 * fq) * 2) = wv; }
    LDS_BARRIER();
}
__device__ __forceinline__ void gdn_chain_item(KPR p, int item, LAS unsigned char* lds) {
    const int tid = ltid(), lane = tid & 63, w = __builtin_amdgcn_readfirstlane(tid >> 6), fr = lane & 15, fq = lane >> 4;
    int bh, sl, nsteps, ch0, rowbase, h, ntok; float* sout; const float* sin = nullptr;
    if (item < 128) { bh = (item & 7) + 8 * (item >> 5); sl = (item >> 3) & 3; nsteps = 128;
        ch0 = bh * 128; rowbase = (bh >> 2) * 8192; h = bh & 3; ntok = 64; sout = p.out + O_PGDN + (size_t)bh * 16384; }
    else { const int j = item - 128; bh = j >> 2; sl = j & 3; nsteps = 1; ch0 = 4096 + bh; rowbase = TP + (bh >> 2) * 16; h = bh & 3; ntok = 16; sout = p.out + O_SGDN + (size_t)bh * 16384; sin = p.in[4] + (size_t)bh * 16384; }
    LAS unsigned char* ST = lds; LAS unsigned char* VN = lds + 32 * 272;
    bf16_t* go = (bf16_t*)(p.ws + WS_R4) + (size_t)rowbase * 512 + h * 128 + sl * 32 + fr;
    const unsigned char* ws = p.ws; const int last = nsteps - 1;
    f32x4 accS[2];
#pragma unroll
    for (int d2 = 0; d2 < 2; ++d2) {
#pragma unroll
        for (int j = 0; j < 4; ++j) accS[d2][j] = sin ? sin[(size_t)(16 * w + 4 * fq + j) * 128 + sl * 32 + 16 * d2 + fr] : 0.f;
        u32x2 wv; wv.x = cvt_pk_bf16(accS[d2][0], accS[d2][1]); wv.y = cvt_pk_bf16(accS[d2][2], accS[d2][3]);
        *(LAS u32x2*)(ST + (16 * d2 + fr) * 272 + (16 * w + 4 * fq) * 2) = wv; }
    GFrag f0, f1, f2;
    gdn_load(f0, ws, ch0, w, sl, fr, fq); gdn_load(f1, ws, ch0 + (1 < last ? 1 : last), w, sl, fr, fq);
    LDS_BARRIER();
#define CLAMPN(x) ((x) < last ? (x) : last)
    for (int n = 0; n < nsteps; n += 3) {
        gdn_load(f2, ws, ch0 + CLAMPN(n + 2), w, sl, fr, fq); __builtin_amdgcn_sched_barrier(0);
        gdn_step(f0, accS, ST, VN, go + (size_t)n * 64 * 512, ntok, w, fr, fq);
        if (n + 1 < nsteps) { gdn_load(f0, ws, ch0 + CLAMPN(n + 3), w, sl, fr, fq); __builtin_amdgcn_sched_barrier(0);
            gdn_step(f1, accS, ST, VN, go + (size_t)(n + 1) * 64 * 512, ntok, w, fr, fq); }
        if (n + 2 < nsteps) { gdn_load(f1, ws, ch0 + CLAMPN(n + 4), w, sl, fr, fq); __builtin_amdgcn_sched_barrier(0);
            gdn_step(f2, accS, ST, VN, go + (size_t)(n + 2) * 64 * 512, ntok, w, fr, fq); }
    }
#undef CLAMPN
#pragma unroll
    for (int d2 = 0; d2 < 2; ++d2)
#pragma unroll
        for (int j = 0; j < 4; ++j) sout[(size_t)(16 * w + 4 * fq + j) * 128 + sl * 32 + 16 * d2 + fr] = accS[d2][j];
    __syncthreads();
}

__device__ __forceinline__ void s5_scan_prompt(KPR p, int item) {
    const int idx = item * 512 + ltid(), pp = idx & 63, g = (idx >> 6) & 31, b = idx >> 11;
    const float* ss = (const float*)(p.ws + WS_R1) + ((size_t)g * CRG + b * 512) * 128; bf16_t* uc = (bf16_t*)(p.ws + WS_R5) + ((size_t)g * CRG + b * 512) * 384 + 256;
    const float* lp = (const float*)(p.ws + WS_LP16) + g * 128 + pp * 2; const float lr = lp[0], li = lp[1];
    float xr = 0.f, xi = 0.f;
    float sr[8], si[8], nr[8], ni[8];
#pragma unroll
    for (int k = 0; k < 8; ++k) { sr[k] = ss[(size_t)k * 128 + pp]; si[k] = ss[(size_t)k * 128 + 64 + pp]; }
    for (int n0 = 0; n0 < 512; n0 += 8) {
        const int nn = (n0 + 8 < 512) ? n0 + 8 : n0;
#pragma unroll
        for (int k = 0; k < 8; ++k) { nr[k] = ss[(size_t)(nn + k) * 128 + pp]; ni[k] = ss[(size_t)(nn + k) * 128 + 64 + pp]; }
#pragma unroll
        for (int k = 0; k < 8; ++k) { uc[(size_t)(n0 + k) * 384 + pp] = f2bf(xr); uc[(size_t)(n0 + k) * 384 + 64 + pp] = f2bf(xi);
            const float tr = lr * xr - li * xi + sr[k], ti = lr * xi + li * xr + si[k]; xr = tr; xi = ti; }
#pragma unroll
        for (int k = 0; k < 8; ++k) { sr[k] = nr[k]; si[k] = ni[k]; }
    }
    p.out[O_PS5RE + (size_t)(b * 32 + g) * 64 + pp] = xr; p.out[O_PS5IM + (size_t)(b * 32 + g) * 64 + pp] = xi;
}
__device__ __forceinline__ void s5_scan_sample(KPR p, int item) {
    const int idx = item * 512 + threadIdx.x, pp = idx & 63, g = (idx >> 6) & 31, b = idx >> 11;
    const size_t row = (size_t)g * CRG + 4096 + b;
    const float* ss = (const float*)(p.ws + WS_R1) + row * 128; bf16_t* uc = (bf16_t*)(p.ws + WS_R5) + row * 384 + 256;
    const float* lp = (const float*)(p.ws + WS_LP16) + g * 128 + pp * 2; const float lr = lp[0], li = lp[1];
    const float xr = p.in[2][(size_t)(b * 32 + g) * 64 + pp], xi = p.in[3][(size_t)(b * 32 + g) * 64 + pp];
    uc[pp] = f2bf(xr); uc[64 + pp] = f2bf(xi);
    p.out[O_SS5RE + (size_t)(b * 32 + g) * 64 + pp] = lr * xr - li * xi + ss[pp]; p.out[O_SS5IM + (size_t)(b * 32 + g) * 64 + pp] = lr * xi + li * xr + ss[64 + pp];
}

__device__ __forceinline__ void attn_item(KPR p, int item, LAS unsigned char* lds) {
    const int tid = ltid(), lane = tid & 63, w = __builtin_amdgcn_readfirstlane(tid >> 6), fr = lane & 15, fq = lane >> 4;
    const bf16_t* Q = (const bf16_t*)(p.ws + WS_R1); const bf16_t* KB = (const bf16_t*)(p.ws + WS_R5); const bf16_t* VB = KB + (size_t)T * 256; bf16_t* AO = (bf16_t*)(p.ws + WS_R2);
    LAS unsigned char* Ks = lds; LAS unsigned char* Vt = lds + 192 * 144;
    int kvh, qrow0, nq, nkt, nvalid; const bool samp = item >= 4096;
    if (!samp) { kvh = item & 3; const int c = (item >> 2) & 127, b = item >> 9; const int c0 = c >= 2 ? c - 2 : 0; qrow0 = b * 8192 + c * 64; nq = 64; nvalid = (c - c0 + 1) * 64; nkt = nvalid >> 4;
        const int krow0 = b * 8192 + c0 * 64;
        for (int e = tid; e < nvalid * 8; e += 512) { const int row = e >> 3, pc = e & 7;
            const u32x4 kw = *(const u32x4*)(KB + (size_t)(krow0 + row) * 256 + kvh * 64 + pc * 8); *(LAS u32x4*)(Ks + row * 144 + pc * 16) = kw;
            const u32x4 vw = *(const u32x4*)(VB + (size_t)(krow0 + row) * 256 + kvh * 64 + pc * 8);
            const unsigned vs[4] = {vw.x, vw.y, vw.z, vw.w};
#pragma unroll
            for (int jj = 0; jj < 4; ++jj) { *(LAS bf16_t*)(Vt + (pc * 8 + 2 * jj) * 400 + row * 2) = (bf16_t)(vs[jj] & 0xffffu); *(LAS bf16_t*)(Vt + (pc * 8 + 2 * jj + 1) * 400 + row * 2) = (bf16_t)(vs[jj] >> 16); } } }
    else { const int j = item - 4096; kvh = j & 3; const int b = j >> 2; qrow0 = TP + b * 16; nq = 16; nvalid = 144; nkt = 10;
        const float* ck = p.in[6]; const float* cv = p.in[7];
        for (int e = tid; e < 160 * 8; e += 512) { const int row = e >> 3, pc = e & 7; u32x4 kw = (u32x4){0u, 0u, 0u, 0u}, vw = (u32x4){0u, 0u, 0u, 0u};
            if (row < 128) { const float* kp = ck + ((size_t)(b * 128 + row) * 4 + kvh) * 64 + pc * 8; const float* vp = cv + ((size_t)(b * 128 + row) * 4 + kvh) * 64 + pc * 8;
                kw = pack8(*(const f32x4*)kp, *(const f32x4*)(kp + 4)); vw = pack8(*(const f32x4*)vp, *(const f32x4*)(vp + 4)); }
            else if (row < 144) { kw = *(const u32x4*)(KB + (size_t)(qrow0 + row - 128) * 256 + kvh * 64 + pc * 8); vw = *(const u32x4*)(VB + (size_t)(qrow0 + row - 128) * 256 + kvh * 64 + pc * 8); }
            *(LAS u32x4*)(Ks + row * 144 + pc * 16) = kw;
            const unsigned vs[4] = {vw.x, vw.y, vw.z, vw.w};
#pragma unroll
            for (int jj = 0; jj < 4; ++jj) { *(LAS bf16_t*)(Vt + (pc * 8 + 2 * jj) * 400 + row * 2) = (bf16_t)(vs[jj] & 0xffffu); *(LAS bf16_t*)(Vt + (pc * 8 + 2 * jj + 1) * 400 + row * 2) = (bf16_t)(vs[jj] >> 16); } } }
    const int hg = w >> 1, th = w & 1, head = kvh * 4 + hg;
    bf16x8 qf[2][2];
#pragma unroll
    for (int qt = 0; qt < 2; ++qt)
#pragma unroll
        for (int ks = 0; ks < 2; ++ks) { const int tok = 32 * th + 16 * qt + fr; qf[qt][ks] = (bf16x8){0, 0, 0, 0, 0, 0, 0, 0};
            if (tok < nq) qf[qt][ks] = *(const bf16x8*)(Q + (size_t)(qrow0 + tok) * 1024 + head * 64 + 32 * ks + 8 * fq); }
    const float sink = p.in[30][head];
    __syncthreads();
    f32x4 sc[12][2];
#pragma unroll
    for (int kt = 0; kt < 12; ++kt) {
#pragma unroll
        for (int qt = 0; qt < 2; ++qt) sc[kt][qt] = (f32x4){0.f, 0.f, 0.f, 0.f};
        if (kt < nkt) {
#pragma unroll
            for (int ks = 0; ks < 2; ++ks) { const bf16x8 kf = *(const LAS bf16x8*)(Ks + (16 * kt + fr) * 144 + (32 * ks + 8 * fq) * 2);
#pragma unroll
                for (int qt = 0; qt < 2; ++qt) sc[kt][qt] = __builtin_amdgcn_mfma_f32_16x16x32_bf16(kf, qf[qt][ks], sc[kt][qt], 0, 0, 0); } }
    }
    float mx[2] = {sink, sink};
#pragma unroll
    for (int kt = 0; kt < 12; ++kt)
#pragma unroll
        for (int qt = 0; qt < 2; ++qt)
#pragma unroll
            for (int j = 0; j < 4; ++j) { const bool ok = (kt < nkt) && (16 * kt + 4 * fq + j < nvalid); if (!ok) sc[kt][qt][j] = -1e30f; mx[qt] = fmaxf(mx[qt], sc[kt][qt][j]); }
    float sm[2];
#pragma unroll
    for (int qt = 0; qt < 2; ++qt) { mx[qt] = fmaxf(mx[qt], __shfl_xor(mx[qt], 16)); mx[qt] = fmaxf(mx[qt], __shfl_xor(mx[qt], 32)); sm[qt] = 0.f; }
#pragma unroll
    for (int kt = 0; kt < 12; ++kt)
#pragma unroll
        for (int qt = 0; qt < 2; ++qt)
#pragma unroll
            for (int j = 0; j < 4; ++j) { const float e = __expf(sc[kt][qt][j] - mx[qt]); sc[kt][qt][j] = e; sm[qt] += e; }
    float inv[2];
#pragma unroll
    for (int qt = 0; qt < 2; ++qt) { sm[qt] += __shfl_xor(sm[qt], 16); sm[qt] += __shfl_xor(sm[qt], 32); inv[qt] = 1.0f / (sm[qt] + __expf(sink - mx[qt])); }
    f32x4 oacc[4][2];
#pragma unroll
    for (int dd = 0; dd < 4; ++dd)
#pragma unroll
        for (int qt = 0; qt < 2; ++qt) oacc[dd][qt] = (f32x4){0.f, 0.f, 0.f, 0.f};
#pragma unroll
    for (int kp = 0; kp < 6; ++kp) {
        if (2 * kp < nkt) {
            bf16x8 pf[2];
#pragma unroll
            for (int qt = 0; qt < 2; ++qt) { const f32x4 a = sc[2 * kp][qt] * inv[qt], b2 = sc[2 * kp + 1][qt] * inv[qt]; const u32x4 pw = pack8(a, b2); pf[qt] = __builtin_bit_cast(bf16x8, pw); }
#pragma unroll
            for (int dd = 0; dd < 4; ++dd) { const bf16x4 v0 = *(const LAS bf16x4*)(Vt + (16 * dd + fr) * 400 + (32 * kp + 4 * fq) * 2), v1 = *(const LAS bf16x4*)(Vt + (16 * dd + fr) * 400 + (32 * kp + 16 + 4 * fq) * 2);
                const bf16x8 vf = (bf16x8){v0[0], v0[1], v0[2], v0[3], v1[0], v1[1], v1[2], v1[3]};
#pragma unroll
                for (int qt = 0; qt < 2; ++qt) oacc[dd][qt] = __builtin_amdgcn_mfma_f32_16x16x32_bf16(vf, pf[qt], oacc[dd][qt], 0, 0, 0); } }
    }
#pragma unroll
    for (int qt = 0; qt < 2; ++qt) { const int tok = 32 * th + 16 * qt + fr;
        if (tok < nq) {
#pragma unroll
            for (int dd = 0; dd < 4; ++dd) { u32x2 wv; wv.x = cvt_pk_bf16(oacc[dd][qt][0], oacc[dd][qt][1]); wv.y = cvt_pk_bf16(oacc[dd][qt][2], oacc[dd][qt][3]);
                *(u32x2*)(AO + (size_t)(qrow0 + tok) * 1024 + head * 64 + 16 * dd + 4 * fq) = wv; } } }
    __syncthreads();
}

__global__ void __launch_bounds__(512) fwd_kernel(Params p_arg) {
    extern __shared__ __attribute__((aligned(16))) unsigned char lds_raw[];
    LAS unsigned char* lds = (LAS unsigned char*)lds_raw;
    cg::grid_group grid = cg::this_grid();
    const int G = gridDim.x, bx = blockIdx.x, tid = threadIdx.x;
    const int lo = p_arg.ph_lo, hi = p_arg.ph_hi;
#ifndef PHMASK
#define PHMASK 0x7fff
#endif
#define IN(k) (((PHMASK >> (k)) & 1) && lo <= (k) && (k) < hi)
    unsigned* const barctr = (unsigned*)(p_arg.ws + WS_BAR); unsigned nbar = 0;
#define GRIDBAR() do { __syncthreads(); ++nbar; \
        if (tid == 0) { const unsigned target = nbar * (unsigned)G; __builtin_amdgcn_fence(__ATOMIC_RELEASE, "agent"); __hip_atomic_fetch_add(barctr, 1u, __ATOMIC_RELAXED, __HIP_MEMORY_SCOPE_AGENT); \
            while (__hip_atomic_load(barctr, __ATOMIC_RELAXED, __HIP_MEMORY_SCOPE_AGENT) < target) __builtin_amdgcn_s_sleep(1); \
            __builtin_amdgcn_fence(__ATOMIC_ACQUIRE, "agent"); } \
        __syncthreads(); } while (0)
#define SEAM(k) do { if (IN(k) && IN((k) + 1)) { if ((k) <= CG_SEAMS) grid.sync(); else GRIDBAR(); } } while (0)
#define PHASE_BEGIN(k) _Pragma("unroll 1") for (int rep_ = 0; rep_ < ((((REP_MASK) >> (k)) & 1) ? 2 : 1); ++rep_) { if (rep_) GRIDBAR();
#define PHASE_END }
#define R1 ((bf16_t*)(p.ws + WS_R1))
#define R2 ((bf16_t*)(p.ws + WS_R2))
#define ACT ((bf16_t*)(p.ws + WS_R3))
#define ZG ((bf16_t*)(p.ws + WS_R3 + GDN_BYTES))
#define XB ((bf16_t*)(p.ws + WS_R4))
#define GO XB
#define ZS5 (XB + (size_t)T * 512)
#define UCAT ((bf16_t*)(p.ws + WS_R5))
#define SUMSQ ((float*)(p.ws + WS_SUMSQ))
#define GATES ((float*)(p.ws + WS_GATES))
    PHASE_BEGIN(0)
    if (IN(0)) { KPR p = *launder_kp(); phase0(p, lds); }
    PHASE_END
    SEAM(0);
    PHASE_BEGIN(1)
    if (IN(1)) { KPR p = *launder_kp(); pg8::Gemm g{R1, (const bf16_t*)(p.ws + WS_W1T), 1024, 1024, 1024}; pg8::StaticOrder S; S.init(T, 2816, G, bx); Epi1 E{UCAT, R2, ZG, GATES}; pg8::gemm_phase(lds, g, S, E); }
    PHASE_END
    SEAM(1);
    PHASE_BEGIN(2)
    if (IN(2)) { KPR p = *launder_kp();
        { pg8::Gemm g{UCAT, (const bf16_t*)(p.ws + WS_HT), 384, 256, 256}; pg8::GroupOrder S{G, bx}; EpiS E{(float*)(p.ws + WS_R1)}; pg8::gemm_phase(lds, g, S, E); }
        __syncthreads();
        gdn_prep_phase(p, lds, bx, G);
        for (int i = bx * 512 + tid; i < 24 * 3 * 1536; i += G * 512) { const int c = i % 1536, j = (i / 1536) % 3, b = i / 4608;
            if (b < 8) p.out[O_PCONV + (size_t)(b * 3 + j) * 1536 + c] = bf2f(R2[(size_t)(b * 8192 + 8189 + j) * 1536 + c]);
            else p.out[O_SCONV + (size_t)((b - 8) * 3 + j) * 1536 + c] = bf2f(R2[(size_t)(TP + (b - 8) * 16 + 13 + j) * 1536 + c]); }
    }
    PHASE_END
    SEAM(2);
    PHASE_BEGIN(3)
    if (IN(3)) { KPR p = *launder_kp();
        for (int it = bx; it < 480; it += G) {
#ifdef REP_SUB
            if (rep_ == 1 && ((REP_SUB == 1) != (it < 128))) continue;
#endif
            if (it < 128) gdn_chain_item(p, it, lds);
            else if (it < 160) s5_scan_prompt(p, it - 128);
            else if (it < 416) gdn_chain_item(p, it - 160 + 128, lds);
            else s5_scan_sample(p, it - 416);
        }
        if (G > 160 && bx >= 160) { __syncthreads(); for (int it = 656 + (bx - 160); it < 5840; it += G - 160) wt_run(p, it, lds); }
    }
    PHASE_END
    SEAM(3);
    PHASE_BEGIN(4)
    if (IN(4)) { KPR p = *launder_kp();
        { pg8::Gemm g{UCAT, (const bf16_t*)(p.ws + WS_KGT), 384, 384, 384}; pg8::GroupOrder S{G, bx}; EpiY E{UCAT, p.in[19], ZS5}; pg8::gemm_phase(lds, g, S, E); }
        const float* nw = p.in[25];
        { const int tl_ = ltid(); const int l16 = tl_ & 15; const f32x4 w0 = *(const f32x4*)(nw + l16 * 8), w1 = *(const f32x4*)(nw + l16 * 8 + 4);
          const size_t gstride = ((size_t)G * 512) >> 4;
          for (size_t gi0 = ((size_t)bx * 512 + tl_) >> 4; gi0 < (size_t)T * 4; gi0 += 4 * gstride) {
            u32x4 ow[4], zw[4];
#pragma unroll
            for (int q = 0; q < 4; ++q) { const size_t gi = gi0 + q * gstride; if (gi < (size_t)T * 4) { const size_t r = gi >> 2; const int h = (int)(gi & 3);
                ow[q] = *(const u32x4*)(GO + r * 512 + h * 128 + l16 * 8); zw[q] = *(const u32x4*)(ZG + r * 512 + h * 128 + l16 * 8); } else { ow[q] = (u32x4){0u, 0u, 0u, 0u}; zw[q] = ow[q]; } }
#pragma unroll
            for (int q = 0; q < 4; ++q) { const size_t gi = gi0 + q * gstride; const size_t r = gi >> 2; const int h = (int)(gi & 3);
                f32x4 o0, o1, z0, z1; unpack8(ow[q], o0, o1); unpack8(zw[q], z0, z1);
                float s = (o0[0] * o0[0] + o0[1] * o0[1]) + (o0[2] * o0[2] + o0[3] * o0[3]) + (o1[0] * o1[0] + o1[1] * o1[1]) + (o1[2] * o1[2] + o1[3] * o1[3]);
                s += __shfl_xor(s, 1); s += __shfl_xor(s, 2); s += __shfl_xor(s, 4); s += __shfl_xor(s, 8);
                const float rs = rsqrtf(s * (1.0f / 128.0f) + 1e-6f);
                f32x4 y0, y1;
#pragma unroll
                for (int j = 0; j < 4; ++j) { y0[j] = o0[j] * rs * w0[j] * silu_f(z0[j]); y1[j] = o1[j] * rs * w1[j] * silu_f(z1[j]); }
                if (gi < (size_t)T * 4) *(u32x4*)(R1 + r * 1024 + 512 + h * 128 + l16 * 8) = pack8(y0, y1); } } }
    }
    PHASE_END
    SEAM(4);
    PHASE_BEGIN(5)
    if (IN(5)) { KPR p = *launder_kp(); pg8::Gemm g{ZS5, (const bf16_t*)(p.ws + WS_WGLU), 512, 512, 512}; pg8::StaticOrder S; S.init(T, 512, G, bx); EpiGlu E{ZS5, p.in[21], R1}; pg8::gemm_phase(lds, g, S, E); }
    PHASE_END
    SEAM(5);
    PHASE_BEGIN(6)
    if (IN(6)) { KPR p = *launder_kp(); pg8::Gemm g{R1, (const bf16_t*)(p.ws + WS_WOUT), 1024, 1024, 1024}; pg8::StaticOrder S; S.init(T, 1024, G, bx); EpiRes<true> E{p.in[0], p.in[1], XB, SUMSQ}; pg8::gemm_phase(lds, g, S, E); }
    PHASE_END
    SEAM(6);
    PHASE_BEGIN(7)
    if (IN(7)) { KPR p = *launder_kp(); pg8::Gemm g{XB, (const bf16_t*)(p.ws + WS_WF1_0), 1024, 1024, 1024}; pg8::StaticOrder S; S.init(T, 5632, G, bx); EpiFF E{SUMSQ, ACT}; pg8::gemm_phase(lds, g, S, E); }
    PHASE_END
    SEAM(7);
    PHASE_BEGIN(8)
    if (IN(8)) { KPR p = *launder_kp(); pg8::Gemm g{ACT, (const bf16_t*)(p.ws + WS_WFD_0), 2816, 2816, 2816}; pg8::StaticOrder S; S.init(T, 1024, G, bx); EpiRes<false> E{nullptr, nullptr, XB, SUMSQ + T}; pg8::gemm_phase(lds, g, S, E); }
    PHASE_END
    SEAM(8);
    PHASE_BEGIN(9)
    if (IN(9)) { KPR p = *launder_kp(); pg8::Gemm g{XB, (const bf16_t*)(p.ws + WS_WQKV), 1024, 1024, 1024}; pg8::StaticOrder S; S.init(T, 1536, G, bx);
        EpiQKV E{SUMSQ + T, R1, UCAT, UCAT + (size_t)T * 256, p.out + O_PK, p.out + O_PV, p.out + O_SK, p.out + O_SV}; pg8::gemm_phase(lds, g, S, E); }
    PHASE_END
    SEAM(9);
    PHASE_BEGIN(10)
    if (IN(10)) { KPR p = *launder_kp(); for (int it = bx; it < 4160; it += G) attn_item(p, it, lds); }
    PHASE_END
    SEAM(10);
    PHASE_BEGIN(11)
    if (IN(11)) { KPR p = *launder_kp(); pg8::Gemm g{R2, (const bf16_t*)(p.ws + WS_WO), 1024, 1024, 1024}; pg8::StaticOrder S; S.init(T, 1024, G, bx); EpiRes<false> E{nullptr, nullptr, XB, SUMSQ + 2 * T}; pg8::gemm_phase(lds, g, S, E); }
    PHASE_END
    SEAM(11);
    PHASE_BEGIN(12)
    if (IN(12)) { KPR p = *launder_kp(); pg8::Gemm g{XB, (const bf16_t*)(p.ws + WS_WF1_1), 1024, 1024, 1024}; pg8::StaticOrder S; S.init(T, 5632, G, bx); EpiFF E{SUMSQ + 2 * T, ACT}; pg8::gemm_phase(lds, g, S, E); }
    PHASE_END
    SEAM(12);
    PHASE_BEGIN(13)
    if (IN(13)) { KPR p = *launder_kp(); pg8::Gemm g{ACT, (const bf16_t*)(p.ws + WS_WFD_1), 2816, 2816, 2816}; pg8::StaticOrder S; S.init(T, 1024, G, bx); EpiRes<false> E{nullptr, nullptr, XB, SUMSQ + 3 * T}; pg8::gemm_phase(lds, g, S, E); }
    PHASE_END
    SEAM(13);
    PHASE_BEGIN(14)
    if (IN(14)) { KPR p = *launder_kp();
        const int tl_ = ltid(); const int lane = tl_ & 63, wid = tl_ >> 6; const float* nw = p.in[10]; const float* sq = SUMSQ + 3 * T;
        f32x4 wv[4];
#pragma unroll
        for (int i = 0; i < 4; ++i) wv[i] = *(const f32x4*)(nw + lane * 4 + i * 256);
        for (int r0 = bx * 8 + wid; r0 < T; r0 += G * 8 * 4) {
            u32x2 bw[4][4]; float rs[4];
#pragma unroll
            for (int q = 0; q < 4; ++q) { const int r = r0 + q * G * 8; rs[q] = 0.f;
#pragma unroll
                for (int i = 0; i < 4; ++i) bw[q][i] = (u32x2){0u, 0u};
                if (r < T) { rs[q] = sq[r]; const bf16_t* xs = XB + (size_t)r * 1024;
#pragma unroll
                    for (int i = 0; i < 4; ++i) bw[q][i] = *(const u32x2*)(xs + lane * 4 + i * 256); } }
#pragma unroll
            for (int q = 0; q < 4; ++q) { const int r = r0 + q * G * 8; if (r < T) { const float sc = rsqrtf(rs[q] * (1.0f / 1024.0f) + 1e-6f); float* xp = p.out + (size_t)r * 1024;
#pragma unroll
                for (int i = 0; i < 4; ++i) { const f32x4 v = (f32x4){bflo(bw[q][i].x), bfhi(bw[q][i].x), bflo(bw[q][i].y), bfhi(bw[q][i].y)}; *(f32x4*)(xp + lane * 4 + i * 256) = v * sc * wv[i]; } } }
        }
    }
    PHASE_END
#undef IN
#undef SEAM
}

extern "C" void kernel_launch(void* const* d_in, const int* in_sizes, int n_in, void* d_out, int out_size, void* d_ws, size_t ws_size, hipStream_t stream) {
    static int grid_blocks = 0;
    if (!grid_blocks) {
        int dev = 0, cus = 0, per_cu = 0;
        hipGetDevice(&dev);
        hipDeviceGetAttribute(&cus, hipDeviceAttributeMultiprocessorCount, dev);
        hipFuncSetAttribute((const void*)fwd_kernel, hipFuncAttributeMaxDynamicSharedMemorySize, LDS_BYTES);
        hipOccupancyMaxActiveBlocksPerMultiprocessor(&per_cu, (const void*)fwd_kernel, 512, LDS_BYTES);
        if (per_cu < 1) per_cu = 1;
        grid_blocks = cus * per_cu;
        if (ws_size < WS_END) fprintf(stderr, "kernel_launch: workspace too small: %zu < %zu\n", ws_size, (size_t)WS_END);
    }
    Params p{};
    for (int i = 0; i < 35; ++i) p.in[i] = (const float*)d_in[i];
    p.out = (float*)d_out; p.ws = (unsigned char*)d_ws; p.ph_lo = 0; p.ph_hi = PH_HI;
    void* args[] = {&p};
    hipError_t e = hipLaunchCooperativeKernel((const void*)fwd_kernel, dim3(grid_blocks), dim3(512), args, LDS_BYTES, stream);
    if (e != hipSuccess) fprintf(stderr, "cooperative launch failed: %s (grid %d)\n", hipGetErrorString(e), grid_blocks);
}
```

```cpp
#include <hip/hip_runtime.h>
#include <hip/hip_cooperative_groups.h>
#include <cstdio>
namespace cg = cooperative_groups;

#define LAS __attribute__((address_space(3)))
typedef unsigned short bf16_t;
typedef short bf16x8 __attribute__((ext_vector_type(8)));
typedef short bf16x4 __attribute__((ext_vector_type(4)));
typedef float f32x4 __attribute__((ext_vector_type(4)));
typedef unsigned u32x4 __attribute__((ext_vector_type(4)));
typedef unsigned u32x2 __attribute__((ext_vector_type(2)));

constexpr int TP = 65536;
constexpr int TS = 256;
constexpr int T = TP + TS;
constexpr int DM = 1024;
constexpr int NCH = 4160;
constexpr int CRG = 4352;
constexpr int CRV = 4112;

constexpr size_t al256(size_t x) { return (x + 255) & ~(size_t)255; }
constexpr size_t WS_W1T = 0;
constexpr size_t WS_WGLU = WS_W1T + (size_t)2816 * 1024 * 2;
constexpr size_t WS_WOUT = WS_WGLU + (size_t)512 * 512 * 2;
constexpr size_t WS_WF1_0 = WS_WOUT + (size_t)1024 * 1024 * 2;
constexpr size_t WS_WFD_0 = WS_WF1_0 + (size_t)5632 * 1024 * 2;
constexpr size_t WS_WQKV = WS_WFD_0 + (size_t)1024 * 2816 * 2;
constexpr size_t WS_WO = WS_WQKV + (size_t)1536 * 1024 * 2;
constexpr size_t WS_WF1_1 = WS_WO + (size_t)1024 * 1024 * 2;
constexpr size_t WS_WFD_1 = WS_WF1_1 + (size_t)5632 * 1024 * 2;
constexpr size_t WS_KGT = WS_WFD_1 + (size_t)1024 * 2816 * 2;
constexpr size_t WS_HT = WS_KGT + (size_t)32 * 256 * 384 * 2;
constexpr size_t WS_LP16 = WS_HT + (size_t)32 * 256 * 256 * 2;
constexpr size_t WS_SUMSQ = WS_LP16 + (size_t)32 * 64 * 2 * 4;
constexpr size_t WS_GATES = WS_SUMSQ + al256((size_t)4 * T * 4);
constexpr size_t WS_GL = WS_GATES + al256((size_t)T * 8 * 4);
constexpr size_t WS_BAR = WS_GL + al256((size_t)NCH * 4);
constexpr size_t WS_R1 = WS_BAR + 256;
constexpr size_t R1_BYTES = (size_t)T * 1024 * 2;
constexpr size_t WS_R2 = WS_R1 + R1_BYTES;
constexpr size_t R2_BYTES = (size_t)T * 1536 * 2;
constexpr size_t WS_R3 = WS_R2 + R2_BYTES;
constexpr size_t GDN_CH_BYTES = 73728;
constexpr size_t GDN_BYTES = (size_t)NCH * GDN_CH_BYTES;
constexpr size_t R3_BYTES = GDN_BYTES + (size_t)T * 512 * 2;
constexpr size_t WS_R4 = WS_R3 + R3_BYTES;
constexpr size_t R4_BYTES = (size_t)T * 1024 * 2;
constexpr size_t WS_R5 = WS_R4 + R4_BYTES;
constexpr size_t R5_BYTES = (size_t)32 * CRG * 384 * 2;
constexpr size_t WS_END = WS_R5 + R5_BYTES;
static_assert(R3_BYTES >= (size_t)T * 2816 * 2, "ACT fits R3");
static_assert((size_t)32 * CRG * 128 * 4 <= R1_BYTES, "SS fits R1");
static_assert((size_t)T * 512 * 2 <= R5_BYTES, "K|V fit R5");
static_assert(WS_END <= (size_t)1073741824, "workspace");

constexpr size_t O_Y = 0;
constexpr size_t O_PS5RE = 67371008, O_PS5IM = 67387392, O_PGDN = 67403776, O_PCONV = 67928064, O_PK = 67964928, O_PV = 68227072;
constexpr size_t O_SS5RE = 68489216, O_SS5IM = 68521984, O_SGDN = 68554752, O_SCONV = 69603328, O_SK = 69677056, O_SV = 70201344;

constexpr int LDS_BYTES = 131072;
#ifndef CG_SEAMS
#define CG_SEAMS 0
#endif
#ifndef REP_MASK
#define REP_MASK 0
#endif
#ifndef PH_HI
#define PH_HI 15
#endif

struct Params { const float* in[35]; float* out; unsigned char* ws; int ph_lo, ph_hi; };
typedef const __attribute__((address_space(4))) Params& KPR;
typedef const __attribute__((address_space(4))) Params* KPP;
__device__ __forceinline__ int ltid() { int t = threadIdx.x; asm volatile("" : "+v"(t)); return t; }
__device__ __forceinline__ KPP launder_kp() { KPP q = (KPP)__builtin_amdgcn_kernarg_segment_ptr(); asm volatile("" : "+s"(q)); return q; }

typedef float f32x2v __attribute__((ext_vector_type(2)));
typedef __bf16 bf16x2v __attribute__((ext_vector_type(2)));
__device__ __forceinline__ unsigned cvt_pk_bf16(float lo, float hi) { const f32x2v v = {lo, hi}; const bf16x2v b = __builtin_convertvector(v, bf16x2v); return __builtin_bit_cast(unsigned, b); }
__device__ __forceinline__ bf16_t f2bf(float f) { return (bf16_t)(cvt_pk_bf16(f, 0.f) & 0xffffu); }
__device__ __forceinline__ float bf2f(bf16_t b) { return __uint_as_float(((unsigned)b) << 16); }
__device__ __forceinline__ float bflo(unsigned w) { return __uint_as_float(w << 16); }
__device__ __forceinline__ float bfhi(unsigned w) { return __uint_as_float(w & 0xffff0000u); }
__device__ __forceinline__ float silu_f(float x) { return x * __builtin_amdgcn_rcpf(1.0f + __expf(-x)); }
__device__ __forceinline__ float sigmoid_f(float x) { return __builtin_amdgcn_rcpf(1.0f + __expf(-x)); }
__device__ __forceinline__ float gelu_tanh_f(float x) { const float u = 1.5957691216057308f * (x + 0.044715f * x * x * x); return x * __builtin_amdgcn_rcpf(1.0f + __expf(-u)); }
#define LDS_BARRIER() do { asm volatile("s_waitcnt lgkmcnt(0)" ::: "memory"); __builtin_amdgcn_s_barrier(); asm volatile("" ::: "memory"); } while (0)

namespace pg8 {
constexpr int BM = 256, BK = 64, HALF = 128, HTB = HALF * BK * 2, STAGE_BYTES = 8 * HTB, NXCD = 8, WGM = 8;
__device__ __forceinline__ int lds_byte(int r, int c) { const int st = (r >> 4) * 2 + (c >> 5), rr = r & 15, cc = c & 31, ob = rr * 64 + cc * 2; return st * 1024 + (ob ^ (((ob >> 9) & 1) << 5)); }
__device__ __forceinline__ void stage_rc(int b, int& R, int& C) { const int st = b / 1024, sb = b % 1024, swz = sb ^ (((sb >> 9) & 1) << 5); R = (st >> 1) * 16 + swz / 64; C = (st & 1) * 32 + (swz % 64) / 2; }
__device__ __forceinline__ int perm32(int rho) { const int n = rho >> 4, i = rho & 15; return 8 * (i >> 2) + 4 * n + (i & 3); }
struct Unit { int pm, pn; };
struct Gemm { const bf16_t* A; const bf16_t* Bt; int lda, ldb, K; };
struct StaticOrder {
    int nM, nN, nwg, G, c;
    __device__ void init(int M, int N, int G_, int c_) { nM = M / BM; nN = N / BM; nwg = nM * nN; G = G_; c = c_; }
    __device__ bool next(int i, Unit& u) const {
        const long L = (long)i * G + c; if (L >= nwg) return false;
        int wgid = (int)L; { const int q = nwg / NXCD, r = nwg % NXCD, xcd = wgid % NXCD, off = wgid / NXCD; wgid = (xcd < r ? xcd * (q + 1) : r * (q + 1) + (xcd - r) * q) + off; }
        const int nig = WGM * nN, gid = wgid / nig, fm = gid * WGM, gsz = (nM - fm) < WGM ? (nM - fm) : WGM;
        u.pm = fm + ((wgid % nig) % gsz); u.pn = (wgid % nig) / gsz; return true;
    }
};
struct GroupOrder {
    int G, c;
    __device__ bool next(int i, Unit& u) const { const int L = i * G + c; if (L >= 32 * 17) return false; u.pm = L; u.pn = L / 17; return true; }
};

template <class Epi, class Sched>
__device__ __forceinline__ void gemm_phase(LAS unsigned char* lds, const Gemm g, const Sched& S, const Epi& E) {
    const int tid = ltid(), wid = __builtin_amdgcn_readfirstlane(tid >> 6), lane = tid & 63, wr = wid >> 2, wc = wid & 3, fr = lane & 15, fq = lane >> 4;
    const int K = g.K, nt = K / BK;
    unsigned voffA[2], voffB[2];
#pragma unroll
    for (int i = 0; i < 2; ++i) { int R, C; stage_rc(tid * 16 + i * 8192, R, C); const int Rb = Epi::PERM ? ((R & ~31) + perm32(R & 31)) : R;
        voffA[i] = (unsigned)(R * g.lda + C) * 2u; voffB[i] = (unsigned)(Rb * g.ldb + C) * 2u; }
    const size_t kstep = (size_t)(BK * 2);
    const size_t hstepA = (size_t)HALF * g.lda * 2, hstepB = (size_t)HALF * g.ldb * 2;
    const size_t tstepA = 2 * hstepA, tstepB = 2 * hstepB;
    const unsigned ldsw = (unsigned)wid * 1024u;
    const int aoff = lds_byte(wr * 64 + fr, fq * 8), boff = lds_byte(wc * 32 + fr, fq * 8);
#define PG8_SA(b, h) (((b) * 2 + (h)) * HTB)
#define PG8_SB(b, h) ((4 + (b) * 2 + (h)) * HTB)
#define PG8_STAGE(bufoff, gbase, voff) do { _Pragma("unroll") for (int _i = 0; _i < 2; ++_i) \
        __builtin_amdgcn_global_load_lds((const unsigned*)((const char*)(gbase) + (voff)[_i]), (LAS unsigned*)(lds + (bufoff) + ldsw + _i * 8192), 16, 0, 0); } while (0)
#define PG8_LDA(dst, b, h) do { _Pragma("unroll") for (int m = 0; m < 4; ++m) _Pragma("unroll") for (int k = 0; k < 2; ++k) dst[m][k] = *(const LAS bf16x8*)(lds + PG8_SA(b, h) + aoff + m * 2048 + k * 1024); } while (0)
#define PG8_LDB(dst, b, h) do { _Pragma("unroll") for (int n = 0; n < 2; ++n) _Pragma("unroll") for (int k = 0; k < 2; ++k) dst[n][k] = *(const LAS bf16x8*)(lds + PG8_SB(b, h) + boff + n * 2048 + k * 1024); } while (0)
#define PG8_MMA(ai, bj, At, Bt) do { __builtin_amdgcn_s_setprio(1); _Pragma("unroll") for (int m = 0; m < 4; ++m) _Pragma("unroll") for (int n = 0; n < 2; ++n) _Pragma("unroll") for (int k = 0; k < 2; ++k) \
        acc[ai][bj][m][n] = __builtin_amdgcn_mfma_f32_16x16x32_bf16(Bt[n][k], At[m][k], acc[ai][bj][m][n], 0, 0, 0); __builtin_amdgcn_s_setprio(0); } while (0)
#define PG8_WAIT_V(n) asm volatile("s_waitcnt vmcnt(" #n ")" ::: "memory")
#define PG8_WAIT_L(n) asm volatile("s_waitcnt lgkmcnt(" #n ")" ::: "memory")
#define PG8_BAR __builtin_amdgcn_s_barrier()
#define PG8_SCHED __builtin_amdgcn_sched_barrier(0)
    Unit cur, nxt; int ui = 0;
    if (!S.next(0, cur)) return;
    f32x4 acc[2][2][4][2];
#pragma unroll
    for (int a = 0; a < 2; ++a)
#pragma unroll
        for (int b = 0; b < 2; ++b)
#pragma unroll
            for (int m = 0; m < 4; ++m)
#pragma unroll
                for (int n = 0; n < 2; ++n) acc[a][b][m][n] = (f32x4){0.f, 0.f, 0.f, 0.f};
    bf16x8 At[4][2], B0[2][2], B1[2][2];
    const char* cA = (const char*)g.A + (size_t)cur.pm * tstepA; const char* cB = (const char*)g.Bt + (size_t)cur.pn * tstepB;
    PG8_STAGE(PG8_SB(0, 0), cB, voffB); PG8_STAGE(PG8_SB(0, 1), cB + hstepB, voffB); PG8_STAGE(PG8_SA(0, 0), cA, voffA); PG8_STAGE(PG8_SA(0, 1), cA + hstepA, voffA);
    if (wr == 1) PG8_BAR;
    PG8_WAIT_V(2); PG8_BAR;
    PG8_STAGE(PG8_SB(1, 0), cB + kstep, voffB); PG8_STAGE(PG8_SA(1, 0), cA + kstep, voffA); PG8_STAGE(PG8_SB(1, 1), cB + hstepB + kstep, voffB);
    PG8_WAIT_V(6); PG8_BAR;
    for (;;) {
        const bool has_next = S.next(ui + 1, nxt);
        const char* nA = has_next ? (const char*)g.A + (size_t)nxt.pm * tstepA : cA; const char* nB = has_next ? (const char*)g.Bt + (size_t)nxt.pn * tstepB : cB;
        for (int t = 0; t < nt; t += 2) {
            const bool last = (t == nt - 2);
            const char* a1 = cA + (size_t)(t + 1) * kstep;
            const char* a2 = last ? nA : cA + (size_t)(t + 2) * kstep; const char* b2 = last ? nB : cB + (size_t)(t + 2) * kstep;
            const char* a3 = a2 + kstep; const char* b3 = b2 + kstep;
            PG8_LDB(B0, 0, 0); PG8_LDB(B1, 0, 1); PG8_SCHED; PG8_LDA(At, 0, 0); PG8_STAGE(PG8_SA(1, 1), a1 + hstepA, voffA);
            PG8_WAIT_V(8); PG8_WAIT_L(0); PG8_BAR; PG8_MMA(0, 0, At, B0); PG8_MMA(0, 1, At, B1); PG8_BAR; PG8_SCHED;
            PG8_LDA(At, 0, 1); PG8_STAGE(PG8_SB(0, 0), b2, voffB); PG8_STAGE(PG8_SB(0, 1), b2 + hstepB, voffB); PG8_STAGE(PG8_SA(0, 0), a2, voffA);
            PG8_WAIT_V(8); PG8_WAIT_L(0); PG8_BAR; PG8_MMA(1, 0, At, B0); PG8_MMA(1, 1, At, B1); PG8_BAR; PG8_SCHED;
            PG8_LDB(B0, 1, 0); PG8_LDB(B1, 1, 1); PG8_SCHED; PG8_LDA(At, 1, 0); PG8_STAGE(PG8_SA(0, 1), a2 + hstepA, voffA);
            PG8_WAIT_V(8); PG8_WAIT_L(0); PG8_BAR; PG8_MMA(0, 0, At, B0); PG8_MMA(0, 1, At, B1); PG8_BAR; PG8_SCHED;
            PG8_LDA(At, 1, 1); PG8_STAGE(PG8_SB(1, 0), b3, voffB); PG8_STAGE(PG8_SB(1, 1), b3 + hstepB, voffB); PG8_STAGE(PG8_SA(1, 0), a3, voffA);
            PG8_WAIT_V(8); PG8_WAIT_L(0); PG8_BAR; PG8_MMA(1, 0, At, B0); PG8_MMA(1, 1, At, B1); PG8_BAR; PG8_SCHED;
        }
        if (wr == 0) PG8_BAR;
        { const int lE = ltid() & 63; E(acc, cur, wr, wc, lE & 15, lE >> 4); }
        if (!has_next) break;
#pragma unroll
        for (int a = 0; a < 2; ++a)
#pragma unroll
            for (int b = 0; b < 2; ++b)
#pragma unroll
                for (int m = 0; m < 4; ++m)
#pragma unroll
                    for (int n = 0; n < 2; ++n) acc[a][b][m][n] = (f32x4){0.f, 0.f, 0.f, 0.f};
        cur = nxt; cA = nA; cB = nB; ++ui;
        if (wr == 1) PG8_BAR;
    }
    PG8_WAIT_V(0);
    PG8_BAR;
#undef PG8_SA
#undef PG8_SB
#undef PG8_STAGE
#undef PG8_LDA
#undef PG8_LDB
#undef PG8_MMA
#undef PG8_WAIT_V
#undef PG8_WAIT_L
#undef PG8_BAR
#undef PG8_SCHED
}
}
using pg8::Unit;

__device__ __forceinline__ u32x4 pack8(const f32x4 a, const f32x4 b) { u32x4 w; w.x = cvt_pk_bf16(a[0], a[1]); w.y = cvt_pk_bf16(a[2], a[3]); w.z = cvt_pk_bf16(b[0], b[1]); w.w = cvt_pk_bf16(b[2], b[3]); return w; }
__device__ __forceinline__ void unpack8(const u32x4 w, f32x4& a, f32x4& b) { a = (f32x4){bflo(w.x), bfhi(w.x), bflo(w.y), bfhi(w.y)}; b = (f32x4){bflo(w.z), bfhi(w.z), bflo(w.w), bfhi(w.w)}; }

struct Epi1 {
    static constexpr bool PERM = true;
    bf16_t* ucat; bf16_t* qkvraw; bf16_t* zg; float* gates;
    __device__ __forceinline__ void operator()(const f32x4 (&acc)[2][2][4][2], const Unit& u, int wr, int wc, int fr, int fq) const {
        const int row0 = u.pm * 256 + wr * 64 + fr, pn = u.pn;
#pragma unroll
        for (int ai = 0; ai < 2; ++ai)
#pragma unroll
            for (int m = 0; m < 4; ++m) { const int r = row0 + ai * 128 + m * 16;
#pragma unroll
                for (int bj = 0; bj < 2; ++bj) { const int c0 = pn * 256 + bj * 128 + wc * 32 + 8 * fq;
                    if (pn == 10) { if (bj == 0 && wc == 0 && fq == 0) { *(f32x4*)(gates + (size_t)r * 8) = acc[ai][bj][m][0]; *(f32x4*)(gates + (size_t)r * 8 + 4) = acc[ai][bj][m][1]; } }
                    else { const u32x4 w = pack8(acc[ai][bj][m][0], acc[ai][bj][m][1]); bf16_t* dst;
                        if (pn < 2) dst = ucat + ((size_t)((c0 >> 4) * CRG + (r >> 4)) * 384 + (r & 15) * 16 + (c0 & 15));
                        else if (pn < 8) dst = qkvraw + (size_t)r * 1536 + (c0 - 512);
                        else dst = zg + (size_t)r * 512 + (c0 - 2048);
                        *(u32x4*)dst = w; } } }
    }
};
struct EpiS {
    static constexpr bool PERM = false;
    float* ss;
    __device__ __forceinline__ void operator()(const f32x4 (&acc)[2][2][4][2], const Unit& u, int wr, int wc, int fr, int fq) const {
        const int row0 = u.pm * 256 + wr * 64 + fr, col0 = wc * 32 + 4 * fq;
#pragma unroll
        for (int ai = 0; ai < 2; ++ai)
#pragma unroll
            for (int m = 0; m < 4; ++m) { float* rp = ss + (size_t)(row0 + ai * 128 + m * 16) * 128 + col0;
#pragma unroll
                for (int n = 0; n < 2; ++n) *(f32x4*)(rp + n * 16) = acc[ai][0][m][n]; }
    }
};
struct EpiY {
    static constexpr bool PERM = true;
    const bf16_t* ucat; const float* dvec; bf16_t* zs5;
    __device__ __forceinline__ void operator()(const f32x4 (&acc)[2][2][4][2], const Unit& u, int wr, int wc, int fr, int fq) const {
        const int g = u.pn, crow0 = u.pm * 256 + wr * 64 + fr;
        f32x4 dd[2][2];
#pragma unroll
        for (int bj = 0; bj < 2; ++bj) { const int cp = (bj * 128 + wc * 32 + 8 * fq) & 15; dd[bj][0] = *(const f32x4*)(dvec + g * 16 + cp); dd[bj][1] = *(const f32x4*)(dvec + g * 16 + cp + 4); }
#pragma unroll
        for (int ai = 0; ai < 2; ++ai) {
            u32x4 uw[4][2];
#pragma unroll
            for (int m = 0; m < 4; ++m) { const int crow = crow0 + ai * 128 + m * 16, cr = crow - g * CRG;
#pragma unroll
                for (int bj = 0; bj < 2; ++bj) { const int n0 = bj * 128 + wc * 32 + 8 * fq; uw[m][bj] = (u32x4){0u, 0u, 0u, 0u}; if (cr < CRV) uw[m][bj] = *(const u32x4*)(ucat + (size_t)crow * 384 + n0); } }
#pragma unroll
            for (int m = 0; m < 4; ++m) { const int crow = crow0 + ai * 128 + m * 16, cr = crow - g * CRG;
                if (cr < CRV) {
#pragma unroll
                    for (int bj = 0; bj < 2; ++bj) { const int n0 = bj * 128 + wc * 32 + 8 * fq, tl = n0 >> 4, cp = n0 & 15;
                        f32x4 u0, u1; unpack8(uw[m][bj], u0, u1);
                        f32x4 y0 = acc[ai][bj][m][0] + dd[bj][0] * u0, y1 = acc[ai][bj][m][1] + dd[bj][1] * u1;
#pragma unroll
                        for (int j = 0; j < 4; ++j) { y0[j] = gelu_tanh_f(y0[j]); y1[j] = gelu_tanh_f(y1[j]); }
                        *(u32x4*)(zs5 + (size_t)(cr * 16 + tl) * 512 + g * 16 + cp) = pack8(y0, y1); } } }
            asm volatile("" ::: "memory"); }
    }
};
struct EpiGlu {
    static constexpr bool PERM = true;
    const bf16_t* zs5; const float* bglu; bf16_t* mixin;
    __device__ __forceinline__ void operator()(const f32x4 (&acc)[2][2][4][2], const Unit& u, int wr, int wc, int fr, int fq) const {
        const int row0 = u.pm * 256 + wr * 64 + fr;
#pragma unroll
        for (int bj = 0; bj < 2; ++bj) { const int c0 = u.pn * 256 + bj * 128 + wc * 32 + 8 * fq;
            const f32x4 b0 = *(const f32x4*)(bglu + c0), b1 = *(const f32x4*)(bglu + c0 + 4);
#pragma unroll
            for (int ai = 0; ai < 2; ++ai)
#pragma unroll
                for (int m = 0; m < 4; ++m) { const int r = row0 + ai * 128 + m * 16;
                    const u32x4 zw = *(const u32x4*)(zs5 + (size_t)r * 512 + c0); f32x4 z0, z1; unpack8(zw, z0, z1);
                    f32x4 o0, o1;
#pragma unroll
                    for (int j = 0; j < 4; ++j) { o0[j] = z0[j] * sigmoid_f(acc[ai][bj][m][0][j] + b0[j]); o1[j] = z1[j] * sigmoid_f(acc[ai][bj][m][1][j] + b1[j]); }
                    *(u32x4*)(mixin + (size_t)r * 1024 + c0) = pack8(o0, o1); } }
    }
};
template <bool F32BASE> struct EpiRes {
    static constexpr bool PERM = false;
    const float* base_p; const float* base_s; bf16_t* xb; float* sumsq;
    __device__ __forceinline__ void operator()(const f32x4 (&acc)[2][2][4][2], const Unit& u, int wr, int wc, int fr, int fq) const {
        const int row0 = u.pm * 256 + wr * 64 + fr, col0 = u.pn * 256 + wc * 32 + 4 * fq;
        constexpr int MB = F32BASE ? 2 : 4;
#pragma unroll
        for (int ai = 0; ai < 2; ++ai)
#pragma unroll
            for (int m0 = 0; m0 < 4; m0 += MB) {
                f32x4 b[MB][2][2];
#pragma unroll
                for (int mm = 0; mm < MB; ++mm) { const int r = row0 + ai * 128 + (m0 + mm) * 16;
                    const float* bp = F32BASE ? ((r < TP) ? base_p + (size_t)r * 1024 : base_s + (size_t)(r - TP) * 1024) : nullptr;
#pragma unroll
                    for (int bj = 0; bj < 2; ++bj)
#pragma unroll
                        for (int n = 0; n < 2; ++n) { const int c = col0 + bj * 128 + n * 16;
                            if (F32BASE) b[mm][bj][n] = *(const f32x4*)(bp + c);
                            else { const u32x2 bw = *(const u32x2*)(xb + (size_t)r * 1024 + c); b[mm][bj][n] = (f32x4){bflo(bw.x), bfhi(bw.x), bflo(bw.y), bfhi(bw.y)}; } } }
#pragma unroll
                for (int mm = 0; mm < MB; ++mm) { const int m = m0 + mm, r = row0 + ai * 128 + m * 16; float s = 0.f;
#pragma unroll
                    for (int bj = 0; bj < 2; ++bj)
#pragma unroll
                        for (int n = 0; n < 2; ++n) { const int c = col0 + bj * 128 + n * 16; const f32x4 v = b[mm][bj][n] + acc[ai][bj][m][n];
                            u32x2 w; w.x = cvt_pk_bf16(v[0], v[1]); w.y = cvt_pk_bf16(v[2], v[3]); *(u32x2*)(xb + (size_t)r * 1024 + c) = w;
                            s += (v[0] * v[0] + v[1] * v[1]) + (v[2] * v[2] + v[3] * v[3]); }
                    s += __shfl_xor(s, 16); s += __shfl_xor(s, 32);
                    if (fq == 0) atomicAdd(sumsq + r, s); }
                asm volatile("" ::: "memory"); }
    }
};
struct EpiFF {
    static constexpr bool PERM = true;
    const float* sumsq; bf16_t* act;
    __device__ __forceinline__ void operator()(const f32x4 (&acc)[2][2][4][2], const Unit& u, int wr, int wc, int fr, int fq) const {
        const int row0 = u.pm * 256 + wr * 64 + fr, c0 = u.pn * 128 + wc * 32 + 8 * fq;
        float rsv[2][4];
#pragma unroll
        for (int ai = 0; ai < 2; ++ai)
#pragma unroll
            for (int m = 0; m < 4; ++m) rsv[ai][m] = sumsq[row0 + ai * 128 + m * 16];
#pragma unroll
        for (int ai = 0; ai < 2; ++ai)
#pragma unroll
            for (int m = 0; m < 4; ++m) { const int r = row0 + ai * 128 + m * 16; const float rs = rsqrtf(rsv[ai][m] * (1.0f / 1024.0f) + 1e-6f);
                f32x4 o0, o1;
#pragma unroll
                for (int j = 0; j < 4; ++j) { o0[j] = silu_f(acc[ai][0][m][0][j] * rs) * (acc[ai][1][m][0][j] * rs); o1[j] = silu_f(acc[ai][0][m][1][j] * rs) * (acc[ai][1][m][1][j] * rs); }
                *(u32x4*)(act + (size_t)r * 2816 + c0) = pack8(o0, o1); }
    }
};
struct EpiQKV {
    static constexpr bool PERM = true;
    const float* sumsq; bf16_t* q; bf16_t* kb; bf16_t* vb; float* opk; float* opv; float* osk; float* osv;
    __device__ __forceinline__ void operator()(const f32x4 (&acc)[2][2][4][2], const Unit& u, int wr, int wc, int fr, int fq) const {
        const int row0 = u.pm * 256 + wr * 64 + fr, pn = u.pn;
        float rsv[2][4];
#pragma unroll
        for (int ai = 0; ai < 2; ++ai)
#pragma unroll
            for (int m = 0; m < 4; ++m) rsv[ai][m] = sumsq[row0 + ai * 128 + m * 16];
#pragma unroll
        for (int ai = 0; ai < 2; ++ai)
#pragma unroll
            for (int m = 0; m < 4; ++m) { const int r = row0 + ai * 128 + m * 16; const float rs = rsqrtf(rsv[ai][m] * (1.0f / 1024.0f) + 1e-6f);
#pragma unroll
                for (int bj = 0; bj < 2; ++bj) { const int cl = bj * 128 + wc * 32 + 8 * fq;
                    if (pn < 4) { const float sc = rs * 0.125f; *(u32x4*)(q + (size_t)r * 1024 + pn * 256 + cl) = pack8(acc[ai][bj][m][0] * sc, acc[ai][bj][m][1] * sc); }
                    else { const f32x4 v0 = acc[ai][bj][m][0] * rs, v1 = acc[ai][bj][m][1] * rs;
                        bf16_t* dst = (pn == 4 ? kb : vb) + (size_t)r * 256 + cl; *(u32x4*)dst = pack8(v0, v1);
                        float* od = nullptr;
                        if (r < TP) { const int t = r & 8191; if (t >= 8064) od = (pn == 4 ? opk : opv) + ((size_t)((r >> 13) * 128 + (t - 8064)) * 256 + cl); }
                        else { const int rr = r - TP; od = (pn == 4 ? osk : osv) + ((size_t)((rr >> 4) * 128 + 112 + (rr & 15)) * 256 + cl); }
                        if (od) { *(f32x4*)od = v0; *(f32x4*)(od + 4) = v1; } } } }
    }
};

struct WDesc { const float* src; int ld, K, N, rowoff, mode; bf16_t* dst; const float* fold; };
__device__ __forceinline__ void wt_tile(const WDesc& d, int tile, LAS float* tl) {
    const int ntn = (d.N + 63) >> 6, kt = tile / ntn, ntile = tile - kt * ntn, k0 = kt * 64, n0 = ntile * 64, tid = ltid();
#pragma unroll
    for (int ps = 0; ps < 8; ++ps) { const int k = ps * 8 + (tid >> 6), n = tid & 63; float v = 0.f;
        if (n0 + n < d.N) v = d.src[(size_t)(k0 + k) * d.ld + n0 + n];
        if (d.fold) v *= d.fold[k0 + k];
        tl[k * 65 + n] = v; }
    __syncthreads();
#pragma unroll
    for (int ps = 0; ps < 8; ++ps) { const int n = ps * 8 + (tid >> 6), k = tid & 63, gn = n0 + n;
        if (gn < d.N) { const int drow = (d.mode ? ((gn >> 7) * 256 + (gn & 127)) : gn) + d.rowoff; d.dst[(size_t)drow * d.K + k0 + k] = f2bf(tl[k * 65 + n]); } }
    __syncthreads();
}

__device__ __forceinline__ void wt_run(KPR p, int it, LAS unsigned char* lds) {
    const float* nf = p.in[9]; const float* nm = p.in[8];
    int t = it; WDesc d;
    if (t < 656) d = WDesc{p.in[11], 2568, 1024, 2568, 0, 0, (bf16_t*)(p.ws + WS_W1T), nullptr};
    else if ((t -= 656) < 64) d = WDesc{p.in[20], 512, 512, 512, 0, 0, (bf16_t*)(p.ws + WS_WGLU), nullptr};
    else if ((t -= 64) < 256) d = WDesc{p.in[26], 1024, 1024, 1024, 0, 0, (bf16_t*)(p.ws + WS_WOUT), nullptr};
    else if ((t -= 256) < 704) d = WDesc{p.in[32], 2816, 1024, 2816, 0, 1, (bf16_t*)(p.ws + WS_WF1_0), nf};
    else if ((t -= 704) < 704) d = WDesc{p.in[33], 2816, 1024, 2816, 128, 1, (bf16_t*)(p.ws + WS_WF1_0), nf};
    else if ((t -= 704) < 704) d = WDesc{p.in[34], 1024, 2816, 1024, 0, 0, (bf16_t*)(p.ws + WS_WFD_0), nullptr};
    else if ((t -= 704) < 256) d = WDesc{p.in[27], 1024, 1024, 1024, 0, 0, (bf16_t*)(p.ws + WS_WQKV), nm + 1024};
    else if ((t -= 256) < 64) d = WDesc{p.in[28], 256, 1024, 256, 1024, 0, (bf16_t*)(p.ws + WS_WQKV), nm + 1024};
    else if ((t -= 64) < 64) d = WDesc{p.in[29], 256, 1024, 256, 1280, 0, (bf16_t*)(p.ws + WS_WQKV), nm + 1024};
    else if ((t -= 64) < 256) d = WDesc{p.in[31], 1024, 1024, 1024, 0, 0, (bf16_t*)(p.ws + WS_WO), nullptr};
    else if ((t -= 256) < 704) d = WDesc{p.in[32] + (size_t)1024 * 2816, 2816, 1024, 2816, 0, 1, (bf16_t*)(p.ws + WS_WF1_1), nf + 1024};
    else if ((t -= 704) < 704) d = WDesc{p.in[33] + (size_t)1024 * 2816, 2816, 1024, 2816, 128, 1, (bf16_t*)(p.ws + WS_WF1_1), nf + 1024};
    else { t -= 704; d = WDesc{p.in[34] + (size_t)2816 * 1024, 1024, 2816, 1024, 0, 0, (bf16_t*)(p.ws + WS_WFD_1), nullptr}; }
    wt_tile(d, t, (LAS float*)lds);
}
__device__ __forceinline__ void s5_gen_group(KPR p, int g, LAS unsigned char* lds, int mode) {
    LAS float* LP = (LAS float*)lds;
    LAS float* BB = LP + 17 * 64 * 2;
    LAS float* KL = BB + 64 * 16 * 2;
    LAS float* CF = KL + 4096;
    LAS float* CR = CF + 128; LAS float* CI = CR + 1024;
    const int tid = ltid();
    const float* lam_re = p.in[12]; const float* lam_im = p.in[13]; const float* log_dt = p.in[14];
    const float* b_re = p.in[15]; const float* b_im = p.in[16]; const float* c_re = p.in[17]; const float* c_im = p.in[18];
    bf16_t* kgt = (bf16_t*)(p.ws + WS_KGT) + (size_t)g * 256 * 384; bf16_t* ht = (bf16_t*)(p.ws + WS_HT) + (size_t)g * 256 * 256; float* lp16 = (float*)(p.ws + WS_LP16) + g * 128;
    if (tid < 64) { const int pp = tid; const double dt = exp((double)log_dt[g]); const double lr = (double)lam_re[g * 64 + pp], li = (double)lam_im[g * 64 + pp];
        for (int k = 0; k <= 16; ++k) { const double mg = exp(k * lr * dt), an = k * li * dt; const double cr = mg * cos(an), ci = mg * sin(an);
            LP[(k * 64 + pp) * 2] = (float)cr; LP[(k * 64 + pp) * 2 + 1] = (float)ci;
            if (k == 16 && mode == 0) { lp16[pp * 2] = (float)cr; lp16[pp * 2 + 1] = (float)ci; }
            if (k == 1) { const double nr = cr - 1.0, ni = ci, dn = lr * lr + li * li; CF[pp * 2] = (float)((nr * lr + ni * li) / dn); CF[pp * 2 + 1] = (float)((ni * lr - nr * li) / dn); } } }
    __syncthreads();
    for (int e = tid; e < 1024; e += 512) { CR[e] = c_re[(size_t)g * 1024 + e]; CI[e] = c_im[(size_t)g * 1024 + e]; }
    for (int e = tid; e < 1024; e += 512) { const int pp = e >> 4; const float br = b_re[(size_t)g * 1024 + e], bi = b_im[(size_t)g * 1024 + e], fr_ = CF[pp * 2], fi_ = CF[pp * 2 + 1];
        BB[e * 2] = fr_ * br - fi_ * bi; BB[e * 2 + 1] = fr_ * bi + fi_ * br; }
    __syncthreads();
    if (mode == 1) {
    for (int e = tid; e < 4096; e += 512) { const int k = e >> 8, c = (e >> 4) & 15, cp = e & 15; float s = 0.f;
#pragma unroll 8
        for (int pp = 0; pp < 64; ++pp) { const float cr = CR[c * 64 + pp], ci = CI[c * 64 + pp];
            const float lr = LP[(k * 64 + pp) * 2], li = LP[(k * 64 + pp) * 2 + 1], br = BB[(pp * 16 + cp) * 2], bi = BB[(pp * 16 + cp) * 2 + 1];
            const float mr = lr * br - li * bi, mi = lr * bi + li * br; s += cr * mr - ci * mi; }
        KL[e] = s; }
    __syncthreads();
    for (int e = tid; e < 256 * 384; e += 512) { const int n = e / 384, k = e - n * 384, t = n >> 4, c = n & 15; float v;
        if (k < 256) { const int s = k >> 4, cp = k & 15; v = (s <= t) ? KL[((t - s) * 16 + c) * 16 + cp] : 0.f; }
        else { const int pp = (k - 256) & 63; const float cr = CR[c * 64 + pp], ci = CI[c * 64 + pp];
            const float lr = LP[((t + 1) * 64 + pp) * 2], li = LP[((t + 1) * 64 + pp) * 2 + 1];
            v = (k < 320) ? (cr * lr - ci * li) : -(cr * li + ci * lr); }
        kgt[e] = f2bf(v); }
    } else {
    for (int e = tid; e < 256 * 256; e += 512) { const int n = e >> 8, k = e & 255; float v = 0.f;
        if (n < 128) { const int pp = n & 63, s = k >> 4, cp = k & 15; const float lr = LP[((15 - s) * 64 + pp) * 2], li = LP[((15 - s) * 64 + pp) * 2 + 1], br = BB[(pp * 16 + cp) * 2], bi = BB[(pp * 16 + cp) * 2 + 1];
            v = (n < 64) ? (lr * br - li * bi) : (lr * bi + li * br); }
        ht[e] = f2bf(v); }
    }
    __syncthreads();
}

__device__ __forceinline__ void phase0(KPR p, LAS unsigned char* lds) {
    const int tid = ltid(), G = gridDim.x, bx = blockIdx.x, lane = tid & 63, wid = tid >> 6;
    for (int g = bx; g < 32; g += G) s5_gen_group(p, g, lds, 0);
    {
        const int shift = (bx + G - (32 % G)) % G; const int nt0 = (G > 160) ? 656 : 5840;
        for (int it = shift; it < nt0; it += G) wt_run(p, it, lds);
    }
    {
        bf16_t* h0 = (bf16_t*)(p.ws + WS_R1); const float* nw = p.in[8];
        f32x4 wv[4];
#pragma unroll
        for (int i = 0; i < 4; ++i) wv[i] = *(const f32x4*)(nw + lane * 4 + i * 256);
        for (int r0 = bx * 8 + wid; r0 < T; r0 += G * 8 * 4) {
            f32x4 v[4][4];
#pragma unroll
            for (int q = 0; q < 4; ++q) { const int r = r0 + q * G * 8; if (r < T) { const float* xp = (r < TP) ? p.in[0] + (size_t)r * 1024 : p.in[1] + (size_t)(r - TP) * 1024;
#pragma unroll
                for (int i = 0; i < 4; ++i) v[q][i] = *(const f32x4*)(xp + lane * 4 + i * 256); } else {
#pragma unroll
                for (int i = 0; i < 4; ++i) v[q][i] = (f32x4){0.f, 0.f, 0.f, 0.f}; } }
#pragma unroll
            for (int q = 0; q < 4; ++q) { const int r = r0 + q * G * 8; float s = 0.f;
#pragma unroll
                for (int i = 0; i < 4; ++i) s += (v[q][i][0] * v[q][i][0] + v[q][i][1] * v[q][i][1]) + (v[q][i][2] * v[q][i][2] + v[q][i][3] * v[q][i][3]);
#pragma unroll
                for (int o = 32; o >= 1; o >>= 1) s += __shfl_xor(s, o);
                const float rs = rsqrtf(s * (1.0f / 1024.0f) + 1e-6f);
                if (r < T) {
#pragma unroll
                    for (int i = 0; i < 4; ++i) { const f32x4 y = v[q][i] * rs * wv[i]; u32x2 w; w.x = cvt_pk_bf16(y[0], y[1]); w.y = cvt_pk_bf16(y[2], y[3]); *(u32x2*)(h0 + (size_t)r * 1024 + lane * 4 + i * 256) = w; } } }
        }
    }
    {
        const size_t gt = (size_t)bx * 512 + tid, gs = (size_t)G * 512;
        if (gt == 0) *(unsigned*)(p.ws + WS_BAR) = 0u;
        float* sq = (float*)(p.ws + WS_SUMSQ); for (size_t i = gt; i < (size_t)4 * T; i += gs) sq[i] = 0.f;
        unsigned* wpad = (unsigned*)(p.ws + WS_W1T + (size_t)2568 * 1024 * 2); for (size_t i = gt; i < (size_t)248 * 512; i += gs) wpad[i] = 0u;
        const float* ck = p.in[6]; const float* cv = p.in[7]; float* ok = p.out + O_SK; float* ov = p.out + O_SV;
        for (size_t i = gt; i < (size_t)16 * 112 * 256; i += gs) { const size_t b = i / (112 * 256), rem = i - b * (112 * 256); ok[b * 32768 + rem] = ck[b * 32768 + 4096 + rem]; ov[b * 32768 + rem] = cv[b * 32768 + 4096 + rem]; }
    }
}

struct GdnItem { int b, h, n, rowbase, ntok; bool samp; };
__device__ __forceinline__ GdnItem gdn_decode(int ch) { GdnItem it; it.samp = ch >= 4096;
    if (!it.samp) { it.b = ch >> 9; it.h = (ch >> 7) & 3; it.n = ch & 127; it.rowbase = it.b * 8192 + it.n * 64; it.ntok = 64; } else { const int s = ch - 4096; it.b = s >> 2; it.h = s & 3; it.n = 0; it.rowbase = TP + it.b * 16; it.ntok = 16; }
    return it; }
__device__ __forceinline__ void gdn_s1(KPR p, int ch, LAS unsigned char* buf, int t) {
    const GdnItem it = gdn_decode(ch); const int h = it.h, b = it.b, n = it.n, rowbase = it.rowbase, ntok = it.ntok; const bool samp = it.samp;
    LAS bf16_t* qn = (LAS bf16_t*)buf; LAS bf16_t* kn = qn + 64 * 136; LAS bf16_t* vv = kn + 64 * 136;
    const bf16_t* qkvraw = (const bf16_t*)(p.ws + WS_R2); const float* cw = p.in[22]; const float* cst = p.in[5];
    const int cg = t & 31, t0 = (t >> 5) * 8;
    u32x2 raw[3][11];
#pragma unroll
    for (int part = 0; part < 3; ++part) { const int cbase = part * 512 + h * 128 + cg * 4;
#pragma unroll
        for (int jj = 0; jj < 11; ++jj) { const int ti = t0 - 3 + jj, tabs = n * 64 + ti; raw[part][jj] = (u32x2){0u, 0u};
            if (ti < ntok) {
                if (tabs >= 0) raw[part][jj] = *(const u32x2*)(qkvraw + (size_t)(rowbase + ti) * 1536 + cbase);
                else if (samp) { const f32x4 f = *(const f32x4*)(cst + (size_t)(b * 3 + 3 + tabs) * 1536 + cbase); raw[part][jj].x = cvt_pk_bf16(f[0], f[1]); raw[part][jj].y = cvt_pk_bf16(f[2], f[3]); } } }
    }
#pragma unroll
    for (int part = 0; part < 3; ++part) {
        f32x4 xr[11]; f32x4 cwp[4];
#pragma unroll
        for (int j = 0; j < 4; ++j) cwp[j] = *(const f32x4*)(cw + j * 1536 + part * 512 + h * 128 + cg * 4);
#pragma unroll
        for (int jj = 0; jj < 11; ++jj) xr[jj] = (f32x4){bflo(raw[part][jj].x), bfhi(raw[part][jj].x), bflo(raw[part][jj].y), bfhi(raw[part][jj].y)};
        LAS bf16_t* dstm = (part == 0 ? qn : (part == 1 ? kn : vv)) + cg * 4;
        f32x4 y[8]; float ss[8];
#pragma unroll
        for (int tk = 0; tk < 8; ++tk) { const int tok = t0 + tk;
            y[tk] = xr[tk] * cwp[0] + xr[tk + 1] * cwp[1] + xr[tk + 2] * cwp[2] + xr[tk + 3] * cwp[3];
            if (tok >= ntok) y[tk] = (f32x4){0.f, 0.f, 0.f, 0.f};
#pragma unroll
            for (int e = 0; e < 4; ++e) y[tk][e] = silu_f(y[tk][e]);
            ss[tk] = (y[tk][0] * y[tk][0] + y[tk][1] * y[tk][1]) + (y[tk][2] * y[tk][2] + y[tk][3] * y[tk][3]); }
        if (part < 2) {
#pragma unroll
            for (int o = 1; o < 32; o <<= 1)
#pragma unroll
                for (int tk = 0; tk < 8; ++tk) ss[tk] += __shfl_xor(ss[tk], o); }
#pragma unroll
        for (int tk = 0; tk < 8; ++tk) { float sc = 1.0f;
            if (part < 2) { sc = rsqrtf(ss[tk] + 1e-6f); if (part == 0) sc *= 0.08838834764831845f; }
            u32x2 wv; wv.x = cvt_pk_bf16(y[tk][0] * sc, y[tk][1] * sc); wv.y = cvt_pk_bf16(y[tk][2] * sc, y[tk][3] * sc);
            *(LAS u32x2*)(dstm + (t0 + tk) * 136) = wv; }
    }
}
__device__ __forceinline__ void gdn_prep_phase(KPR p, LAS unsigned char* lds, int bx, int G) {
    const int tid = ltid(), lane = tid & 63, w = tid >> 6, fr = lane & 15, fq = lane >> 4;
    LAS float* Am = (LAS float*)(lds + 2 * 52224); LAS float* gcs = Am + 4096; LAS float* betas = gcs + 64; LAS float* egc = betas + 64;
    const float* gates = (const float*)(p.ws + WS_GATES);
    int ch = bx; if (ch >= NCH) return;
    if (tid >= 256) gdn_s1(p, ch, lds, tid - 256);
    for (int k = 0;; ++k) {
        LAS unsigned char* cur = lds + (k & 1) * 52224; LAS unsigned char* nxt = lds + ((k + 1) & 1) * 52224;
        LAS bf16_t* qn = (LAS bf16_t*)cur; LAS bf16_t* kn = qn + 64 * 136; LAS bf16_t* vv = kn + 64 * 136;
        const GdnItem it = gdn_decode(ch); const int h = it.h, rowbase = it.rowbase, ntok = it.ntok;
        unsigned char* cb = p.ws + WS_R3 + (size_t)ch * GDN_CH_BYTES;
        bf16_t* o_uT = (bf16_t*)cb; bf16_t* o_w = (bf16_t*)(cb + 16384); bf16_t* o_qd = (bf16_t*)(cb + 32768); bf16_t* o_kdT = (bf16_t*)(cb + 49152); bf16_t* o_attn = (bf16_t*)(cb + 65536);
        __syncthreads();
        if (tid < 64) { float gg = 0.f, be = 0.f;
            if (tid < ntok) { const float a = gates[(size_t)(rowbase + tid) * 8 + 4 + h], bb = gates[(size_t)(rowbase + tid) * 8 + h];
                const float xs = a + p.in[24][h]; const float sp = xs > 20.f ? xs : log1pf(expf(xs)); gg = -expf(p.in[23][h]) * sp; be = 1.0f / (1.0f + expf(-bb)); }
            float gc = gg;
#pragma unroll
            for (int o = 1; o < 64; o <<= 1) { const float v = __shfl_up(gc, o); if (lane >= o) gc += v; }
            gcs[tid] = gc; betas[tid] = be; egc[tid] = expf(gc);
            if (tid == 63) ((float*)(p.ws + WS_GL))[ch] = expf(gc); }
        __syncthreads();
        {
            const int rt = w & 3, kind = w >> 2; LAS bf16_t* am = kind ? qn : kn;
            bf16x8 af[4];
#pragma unroll
            for (int ks = 0; ks < 4; ++ks) af[ks] = *(const LAS bf16x8*)(am + (16 * rt + fr) * 136 + 32 * ks + 8 * fq);
#pragma unroll
            for (int ct = 0; ct < 4; ++ct) {
                f32x4 acc = (f32x4){0.f, 0.f, 0.f, 0.f};
                if (ct <= rt) {
#pragma unroll
                    for (int ks = 0; ks < 4; ++ks) { const bf16x8 bfr = *(const LAS bf16x8*)(kn + (16 * ct + fr) * 136 + 32 * ks + 8 * fq); acc = __builtin_amdgcn_mfma_f32_16x16x32_bf16(af[ks], bfr, acc, 0, 0, 0); } }
                const int col = 16 * ct + fr; const float gcc = gcs[col];
#pragma unroll
                for (int j = 0; j < 4; ++j) { const int row = 16 * rt + 4 * fq + j; const float dec = __expf(fminf(gcs[row] - gcc, 0.f));
                    if (kind == 0) Am[row * 64 + col] = (row > col) ? betas[row] * acc[j] * dec : 0.f;
                    else o_attn[row * 64 + col] = f2bf((row >= col) ? acc[j] * dec : 0.f); }
            }
        }
        __syncthreads();
        const int chn = ch + G;
        int vz = 0; asm volatile("" : "+v"(vz));
        if (tid < 256) {
            const int c = tid; const bool isu = c < 128; const int cc = isu ? c : c - 128; LAS bf16_t* srcm = isu ? vv : kn;
            LAS float* AmV = Am + vz; LAS float* beV = betas + vz; LAS float* egV = egc + vz;
            float X[64];
#pragma unroll
            for (int i = 0; i < 64; ++i) {
                float r = bf2f(srcm[i * 136 + cc]) * beV[i]; if (!isu) r *= egV[i];
                float pa[4] = {0.f, 0.f, 0.f, 0.f};
#pragma unroll
                for (int j4 = 0; j4 < (i + 3) / 4; ++j4) { const f32x4 a4 = *(const LAS f32x4*)(AmV + i * 64 + j4 * 4);
#pragma unroll
                    for (int jj = 0; jj < 4; ++jj) { if (j4 * 4 + jj < i) pa[jj] += a4[jj] * X[j4 * 4 + jj]; } }
                r -= (pa[0] + pa[1]) + (pa[2] + pa[3]);
                asm volatile("" : "+v"(r) :: "memory"); X[i] = r; }
            if (isu) {
#pragma unroll
                for (int i8 = 0; i8 < 8; ++i8) { u32x4 wv; wv.x = cvt_pk_bf16(X[i8 * 8], X[i8 * 8 + 1]); wv.y = cvt_pk_bf16(X[i8 * 8 + 2], X[i8 * 8 + 3]); wv.z = cvt_pk_bf16(X[i8 * 8 + 4], X[i8 * 8 + 5]); wv.w = cvt_pk_bf16(X[i8 * 8 + 6], X[i8 * 8 + 7]);
                    *(u32x4*)(o_uT + cc * 64 + i8 * 8) = wv; } }
            else {
#pragma unroll
                for (int i = 0; i < 64; ++i) o_w[i * 128 + cc] = f2bf(X[i]); }
            { LAS float* gcV = gcs + vz; LAS float* egV2 = egc + vz;
              if (c < 128) { const float gl_ = gcV[63];
#pragma unroll
                for (int i8 = 0; i8 < 8; ++i8) { float v[8];
#pragma unroll
                    for (int e = 0; e < 8; ++e) { const int tk = i8 * 8 + e; v[e] = bf2f(kn[tk * 136 + c]) * __expf(gl_ - gcV[tk]); }
                    u32x4 wv; wv.x = cvt_pk_bf16(v[0], v[1]); wv.y = cvt_pk_bf16(v[2], v[3]); wv.z = cvt_pk_bf16(v[4], v[5]); wv.w = cvt_pk_bf16(v[6], v[7]);
                    *(u32x4*)(o_kdT + c * 64 + i8 * 8) = wv; } }
              else { const int cq = c - 128;
#pragma unroll 8
                for (int i = 0; i < 64; ++i) o_qd[i * 128 + cq] = f2bf(bf2f(qn[i * 136 + cq]) * egV2[i]); } }
        } else {
            const int c = tid - 256;
            if (chn < NCH) gdn_s1(p, chn, nxt, c);
        }
        if (chn >= NCH) break;
        ch = chn;
    }
    __syncthreads();
}

struct GFrag { bf16x8 A1[4], A2[2], Ak[2]; float gl; };
__device__ __forceinline__ void gdn_load(GFrag& f, const unsigned char* ws, int ch, int w, int sl, int fr, int fq) {
    const unsigned char* cb = ws + WS_R3 + (size_t)ch * GDN_CH_BYTES;
    const bf16_t* kdT = (const bf16_t*)(cb + 49152);
    const bool vp = w < 4; const int tt = w & 3;
    const bf16_t* p1 = (const bf16_t*)(cb + (vp ? 16384 : 32768)) + (16 * tt + fr) * 128 + 8 * fq;
    const bf16_t* p2 = vp ? (const bf16_t*)cb + (sl * 32 + fr) * 64 + 16 * tt + 4 * fq : (const bf16_t*)(cb + 65536) + (16 * tt + fr) * 64 + 8 * fq;
    const int st2 = vp ? 16 * 64 : 32;
#pragma unroll
    for (int ks = 0; ks < 4; ++ks) f.A1[ks] = *(const bf16x8*)(p1 + 32 * ks);
#pragma unroll
    for (int k2 = 0; k2 < 2; ++k2) f.A2[k2] = *(const bf16x8*)(p2 + st2 * k2);
#pragma unroll
    for (int k2 = 0; k2 < 2; ++k2) f.Ak[k2] = *(const bf16x8*)(kdT + (16 * w + fr) * 64 + 32 * k2 + 8 * fq);
    f.gl = ((const float*)(ws + WS_GL))[ch];
}
__device__ __forceinline__ void gdn_step(const GFrag& cur, f32x4 (&accS)[2], LAS unsigned char* ST, LAS unsigned char* VN, bf16_t* gorow, int ntok, int w, int fr, int fq) {
    const bool vp = w < 4; const int tt = w & 3;
    f32x4 acc[2];
#pragma unroll
    for (int dt = 0; dt < 2; ++dt) acc[dt] = (f32x4){0.f, 0.f, 0.f, 0.f};
#pragma unroll
    for (int ks = 0; ks < 4; ++ks)
#pragma unroll
        for (int dt = 0; dt < 2; ++dt) { const bf16x8 bs = *(const LAS bf16x8*)(ST + (16 * dt + fr) * 272 + (32 * ks + 8 * fq) * 2);
            acc[dt] = __builtin_amdgcn_mfma_f32_16x16x32_bf16(cur.A1[ks], bs, acc[dt], 0, 0, 0); }
    if (vp) {
#pragma unroll
        for (int dt = 0; dt < 2; ++dt) { const float v0 = bf2f((bf16_t)cur.A2[dt][0]) - acc[dt][0], v1 = bf2f((bf16_t)cur.A2[dt][1]) - acc[dt][1], v2 = bf2f((bf16_t)cur.A2[dt][2]) - acc[dt][2], v3 = bf2f((bf16_t)cur.A2[dt][3]) - acc[dt][3];
            u32x2 wv; wv.x = cvt_pk_bf16(v0, v1); wv.y = cvt_pk_bf16(v2, v3); *(LAS u32x2*)(VN + (16 * dt + fr) * 144 + (16 * tt + 4 * fq) * 2) = wv; } }
    LDS_BARRIER();
    if (!vp) {
#pragma unroll
        for (int dt = 0; dt < 2; ++dt) {
#pragma unroll
            for (int k2 = 0; k2 < 2; ++k2) { const bf16x8 bv = *(const LAS bf16x8*)(VN + (16 * dt + fr) * 144 + (32 * k2 + 8 * fq) * 2); acc[dt] = __builtin_amdgcn_mfma_f32_16x16x32_bf16(cur.A2[k2], bv, acc[dt], 0, 0, 0); }
#pragma unroll
            for (int j = 0; j < 4; ++j) { const int tok = 16 * tt + 4 * fq + j; if (tok < ntok) gorow[(size_t)tok * 512 + 16 * dt] = f2bf(acc[dt][j]); } }
    }
#pragma unroll
    for (int d2 = 0; d2 < 2; ++d2) { accS[d2] = accS[d2] * cur.gl;
#pragma unroll
        for (int k2 = 0; k2 < 2; ++k2) { const bf16x8 bv = *(const LAS bf16x8*)(VN + (16 * d2 + fr) * 144 + (32 * k2 + 8 * fq) * 2); accS[d2] = __builtin_amdgcn_mfma_f32_16x16x32_bf16(cur.Ak[k2], bv, accS[d2], 0, 0, 0); }
        u32x2 wv; wv.x = cvt_pk_bf16(accS[d2][0], accS[d2][1]); wv.y = cvt_pk_bf16(accS[d2][2], accS[d2][3]);
        *(LAS u32x2*)(ST + (16 * d2 + fr) * 272 + (16 * w + 4 * fq) * 2) = wv; }
    LDS_BARRIER();
}
__device__ __forceinline__ void gdn_chain_item(KPR p, int item, LAS unsigned char* lds) {
    const int tid = ltid(), lane = tid & 63, w = __builtin_amdgcn_readfirstlane(tid >> 6), fr = lane & 15, fq = lane >> 4;
    int bh, sl, nsteps, ch0, rowbase, h, ntok; float* sout; const float* sin = nullptr;
    if (item < 128) { bh = (item & 7) + 8 * (item >> 5); sl = (item >> 3) & 3; nsteps = 128;
        ch0 = bh * 128; rowbase = (bh >> 2) * 8192; h = bh & 3; ntok = 64; sout = p.out + O_PGDN + (size_t)bh * 16384; }
    else { const int j = item - 128; bh = j >> 2; sl = j & 3; nsteps = 1; ch0 = 4096 + bh; rowbase = TP + (bh >> 2) * 16; h = bh & 3; ntok = 16; sout = p.out + O_SGDN + (size_t)bh * 16384; sin = p.in[4] + (size_t)bh * 16384; }
    LAS unsigned char* ST = lds; LAS unsigned char* VN = lds + 32 * 272;
    bf16_t* go = (bf16_t*)(p.ws + WS_R4) + (size_t)rowbase * 512 + h * 128 + sl * 32 + fr;
    const unsigned char* ws = p.ws; const int last = nsteps - 1;
    f32x4 accS[2];
#pragma unroll
    for (int d2 = 0; d2 < 2; ++d2) {
#pragma unroll
        for (int j = 0; j < 4; ++j) accS[d2][j] = sin ? sin[(size_t)(16 * w + 4 * fq + j) * 128 + sl * 32 + 16 * d2 + fr] : 0.f;
        u32x2 wv; wv.x = cvt_pk_bf16(accS[d2][0], accS[d2][1]); wv.y = cvt_pk_bf16(accS[d2][2], accS[d2][3]);
        *(LAS u32x2*)(ST + (16 * d2 + fr) * 272 + (16 * w + 4 * fq) * 2) = wv; }
    GFrag f0, f1, f2;
    gdn_load(f0, ws, ch0, w, sl, fr, fq); gdn_load(f1, ws, ch0 + (1 < last ? 1 : last), w, sl, fr, fq);
    LDS_BARRIER();
#define CLAMPN(x) ((x) < last ? (x) : last)
    for (int n = 0; n < nsteps; n += 3) {
        gdn_load(f2, ws, ch0 + CLAMPN(n + 2), w, sl, fr, fq); __builtin_amdgcn_sched_barrier(0);
        gdn_step(f0, accS, ST, VN, go + (size_t)n * 64 * 512, ntok, w, fr, fq);
        if (n + 1 < nsteps) { gdn_load(f0, ws, ch0 + CLAMPN(n + 3), w, sl, fr, fq); __builtin_amdgcn_sched_barrier(0);
            gdn_step(f1, accS, ST, VN, go + (size_t)(n + 1) * 64 * 512, ntok, w, fr, fq); }
        if (n + 2 < nsteps) { gdn_load(f1, ws, ch0 + CLAMPN(n + 4), w, sl, fr, fq); __builtin_amdgcn_sched_barrier(0);
            gdn_step(f2, accS, ST, VN, go + (size_t)(n + 2) * 64 * 512, ntok, w, fr, fq); }
    }
#undef CLAMPN
#pragma unroll
    for (int d2 = 0; d2 < 2; ++d2)
#pragma unroll
        for (int j = 0; j < 4; ++j) sout[(size_t)(16 * w + 4 * fq + j) * 128 + sl * 32 + 16 * d2 + fr] = accS[d2][j];
    __syncthreads();
}

__device__ __forceinline__ void s5_scan_prompt(KPR p, int item) {
    const int idx = item * 512 + ltid(), pp = idx & 63, g = (idx >> 6) & 31, b = idx >> 11;
    const float* ss = (const float*)(p.ws + WS_R1) + ((size_t)g * CRG + b * 512) * 128; bf16_t* uc = (bf16_t*)(p.ws + WS_R5) + ((size_t)g * CRG + b * 512) * 384 + 256;
    const float* lp = (const float*)(p.ws + WS_LP16) + g * 128 + pp * 2; const float lr = lp[0], li = lp[1];
    float xr = 0.f, xi = 0.f;
    float sr[8], si[8], nr[8], ni[8];
#pragma unroll
    for (int k = 0; k < 8; ++k) { sr[k] = ss[(size_t)k * 128 + pp]; si[k] = ss[(size_t)k * 128 + 64 + pp]; }
    for (int n0 = 0; n0 < 512; n0 += 8) {
        const int nn = (n0 + 8 < 512) ? n0 + 8 : n0;
#pragma unroll
        for (int k = 0; k < 8; ++k) { nr[k] = ss[(size_t)(nn + k) * 128 + pp]; ni[k] = ss[(size_t)(nn + k) * 128 + 64 + pp]; }
#pragma unroll
        for (int k = 0; k < 8; ++k) { uc[(size_t)(n0 + k) * 384 + pp] = f2bf(xr); uc[(size_t)(n0 + k) * 384 + 64 + pp] = f2bf(xi);
            const float tr = lr * xr - li * xi + sr[k], ti = lr * xi + li * xr + si[k]; xr = tr; xi = ti; }
#pragma unroll
        for (int k = 0; k < 8; ++k) { sr[k] = nr[k]; si[k] = ni[k]; }
    }
    p.out[O_PS5RE + (size_t)(b * 32 + g) * 64 + pp] = xr; p.out[O_PS5IM + (size_t)(b * 32 + g) * 64 + pp] = xi;
}
__device__ __forceinline__ void s5_scan_sample(KPR p, int item) {
    const int idx = item * 512 + threadIdx.x, pp = idx & 63, g = (idx >> 6) & 31, b = idx >> 11;
    const size_t row = (size_t)g * CRG + 4096 + b;
    const float* ss = (const float*)(p.ws + WS_R1) + row * 128; bf16_t* uc = (bf16_t*)(p.ws + WS_R5) + row * 384 + 256;
    const float* lp = (const float*)(p.ws + WS_LP16) + g * 128 + pp * 2; const float lr = lp[0], li = lp[1];
    const float xr = p.in[2][(size_t)(b * 32 + g) * 64 + pp], xi = p.in[3][(size_t)(b * 32 + g) * 64 + pp];
    uc[pp] = f2bf(xr); uc[64 + pp] = f2bf(xi);
    p.out[O_SS5RE + (size_t)(b * 32 + g) * 64 + pp] = lr * xr - li * xi + ss[pp]; p.out[O_SS5IM + (size_t)(b * 32 + g) * 64 + pp] = lr * xi + li * xr + ss[64 + pp];
}

__device__ __forceinline__ void attn_item(KPR p, int item, LAS unsigned char* lds) {
    const int tid = ltid(), lane = tid & 63, w = __builtin_amdgcn_readfirstlane(tid >> 6), fr = lane & 15, fq = lane >> 4;
    const bf16_t* Q = (const bf16_t*)(p.ws + WS_R1); const bf16_t* KB = (const bf16_t*)(p.ws + WS_R5); const bf16_t* VB = KB + (size_t)T * 256; bf16_t* AO = (bf16_t*)(p.ws + WS_R2);
    LAS unsigned char* Ks = lds; LAS unsigned char* Vt = lds + 192 * 144;
    int kvh, qrow0, nq, nkt, nvalid; const bool samp = item >= 4096;
    if (!samp) { kvh = item & 3; const int c = (item >> 2) & 127, b = item >> 9; const int c0 = c >= 2 ? c - 2 : 0; qrow0 = b * 8192 + c * 64; nq = 64; nvalid = (c - c0 + 1) * 64; nkt = nvalid >> 4;
        const int krow0 = b * 8192 + c0 * 64;
        for (int e = tid; e < nvalid * 8; e += 512) { const int row = e >> 3, pc = e & 7;
            const u32x4 kw = *(const u32x4*)(KB + (size_t)(krow0 + row) * 256 + kvh * 64 + pc * 8); *(LAS u32x4*)(Ks + row * 144 + pc * 16) = kw;
            const u32x4 vw = *(const u32x4*)(VB + (size_t)(krow0 + row) * 256 + kvh * 64 + pc * 8);
            const unsigned vs[4] = {vw.x, vw.y, vw.z, vw.w};
#pragma unroll
            for (int jj = 0; jj < 4; ++jj) { *(LAS bf16_t*)(Vt + (pc * 8 + 2 * jj) * 400 + row * 2) = (bf16_t)(vs[jj] & 0xffffu); *(LAS bf16_t*)(Vt + (pc * 8 + 2 * jj + 1) * 400 + row * 2) = (bf16_t)(vs[jj] >> 16); } } }
    else { const int j = item - 4096; kvh = j & 3; const int b = j >> 2; qrow0 = TP + b * 16; nq = 16; nvalid = 144; nkt = 10;
        const float* ck = p.in[6]; const float* cv = p.in[7];
        for (int e = tid; e < 160 * 8; e += 512) { const int row = e >> 3, pc = e & 7; u32x4 kw = (u32x4){0u, 0u, 0u, 0u}, vw = (u32x4){0u, 0u, 0u, 0u};
            if (row < 128) { const float* kp = ck + ((size_t)(b * 128 + row) * 4 + kvh) * 64 + pc * 8; const float* vp = cv + ((size_t)(b * 128 + row) * 4 + kvh) * 64 + pc * 8;
                kw = pack8(*(const f32x4*)kp, *(const f32x4*)(kp + 4)); vw = pack8(*(const f32x4*)vp, *(const f32x4*)(vp + 4)); }
            else if (row < 144) { kw = *(const u32x4*)(KB + (size_t)(qrow0 + row - 128) * 256 + kvh * 64 + pc * 8); vw = *(const u32x4*)(VB + (size_t)(qrow0 + row - 128) * 256 + kvh * 64 + pc * 8); }
            *(LAS u32x4*)(Ks + row * 144 + pc * 16) = kw;
            const unsigned vs[4] = {vw.x, vw.y, vw.z, vw.w};
#pragma unroll
            for (int jj = 0; jj < 4; ++jj) { *(LAS bf16_t*)(Vt + (pc * 8 + 2 * jj) * 400 + row * 2) = (bf16_t)(vs[jj] & 0xffffu); *(LAS bf16_t*)(Vt + (pc * 8 + 2 * jj + 1) * 400 + row * 2) = (bf16_t)(vs[jj] >> 16); } } }
    const int hg = w >> 1, th = w & 1, head = kvh * 4 + hg;
    bf16x8 qf[2][2];
#pragma unroll
    for (int qt = 0; qt < 2; ++qt)
#pragma unroll
        for (int ks = 0; ks < 2; ++ks) { const int tok = 32 * th + 16 * qt + fr; qf[qt][ks] = (bf16x8){0, 0, 0, 0, 0, 0, 0, 0};
            if (tok < nq) qf[qt][ks] = *(const bf16x8*)(Q + (size_t)(qrow0 + tok) * 1024 + head * 64 + 32 * ks + 8 * fq); }
    const float sink = p.in[30][head];
    __syncthreads();
    f32x4 sc[12][2];
#pragma unroll
    for (int kt = 0; kt < 12; ++kt) {
#pragma unroll
        for (int qt = 0; qt < 2; ++qt) sc[kt][qt] = (f32x4){0.f, 0.f, 0.f, 0.f};
        if (kt < nkt) {
#pragma unroll
            for (int ks = 0; ks < 2; ++ks) { const bf16x8 kf = *(const LAS bf16x8*)(Ks + (16 * kt + fr) * 144 + (32 * ks + 8 * fq) * 2);
#pragma unroll
                for (int qt = 0; qt < 2; ++qt) sc[kt][qt] = __builtin_amdgcn_mfma_f32_16x16x32_bf16(kf, qf[qt][ks], sc[kt][qt], 0, 0, 0); } }
    }
    float mx[2] = {sink, sink};
#pragma unroll
    for (int kt = 0; kt < 12; ++kt)
#pragma unroll
        for (int qt = 0; qt < 2; ++qt)
#pragma unroll
            for (int j = 0; j < 4; ++j) { const bool ok = (kt < nkt) && (16 * kt + 4 * fq + j < nvalid); if (!ok) sc[kt][qt][j] = -1e30f; mx[qt] = fmaxf(mx[qt], sc[kt][qt][j]); }
    float sm[2];
#pragma unroll
    for (int qt = 0; qt < 2; ++qt) { mx[qt] = fmaxf(mx[qt], __shfl_xor(mx[qt], 16)); mx[qt] = fmaxf(mx[qt], __shfl_xor(mx[qt], 32)); sm[qt] = 0.f; }
#pragma unroll
    for (int kt = 0; kt < 12; ++kt)
#pragma unroll
        for (int qt = 0; qt < 2; ++qt)
#pragma unroll
            for (int j = 0; j < 4; ++j) { const float e = __expf(sc[kt][qt][j] - mx[qt]); sc[kt][qt][j] = e; sm[qt] += e; }
    float inv[2];
#pragma unroll
    for (int qt = 0; qt < 2; ++qt) { sm[qt] += __shfl_xor(sm[qt], 16); sm[qt] += __shfl_xor(sm[qt], 32); inv[qt] = 1.0f / (sm[qt] + __expf(sink - mx[qt])); }
    f32x4 oacc[4][2];
#pragma unroll
    for (int dd = 0; dd < 4; ++dd)
#pragma unroll
        for (int qt = 0; qt < 2; ++qt) oacc[dd][qt] = (f32x4){0.f, 0.f, 0.f, 0.f};
#pragma unroll
    for (int kp = 0; kp < 6; ++kp) {
        if (2 * kp < nkt) {
            bf16x8 pf[2];
#pragma unroll
            for (int qt = 0; qt < 2; ++qt) { const f32x4 a = sc[2 * kp][qt] * inv[qt], b2 = sc[2 * kp + 1][qt] * inv[qt]; const u32x4 pw = pack8(a, b2); pf[qt] = __builtin_bit_cast(bf16x8, pw); }
#pragma unroll
            for (int dd = 0; dd < 4; ++dd) { const bf16x4 v0 = *(const LAS bf16x4*)(Vt + (16 * dd + fr) * 400 + (32 * kp + 4 * fq) * 2), v1 = *(const LAS bf16x4*)(Vt + (16 * dd + fr) * 400 + (32 * kp + 16 + 4 * fq) * 2);
                const bf16x8 vf = (bf16x8){v0[0], v0[1], v0[2], v0[3], v1[0], v1[1], v1[2], v1[3]};
#pragma unroll
                for (int qt = 0; qt < 2; ++qt) oacc[dd][qt] = __builtin_amdgcn_mfma_f32_16x16x32_bf16(vf, pf[qt], oacc[dd][qt], 0, 0, 0); } }
    }
#pragma unroll
    for (int qt = 0; qt < 2; ++qt) { const int tok = 32 * th + 16 * qt + fr;
        if (tok < nq) {
#pragma unroll
            for (int dd = 0; dd < 4; ++dd) { u32x2 wv; wv.x = cvt_pk_bf16(oacc[dd][qt][0], oacc[dd][qt][1]); wv.y = cvt_pk_bf16(oacc[dd][qt][2], oacc[dd][qt][3]);
                *(u32x2*)(AO + (size_t)(qrow0 + tok) * 1024 + head * 64 + 16 * dd + 4 * fq) = wv; } } }
    __syncthreads();
}

__global__ void __launch_bounds__(512) fwd_kernel(Params p_arg) {
    extern __shared__ __attribute__((aligned(16))) unsigned char lds_raw[];
    LAS unsigned char* lds = (LAS unsigned char*)lds_raw;
    cg::grid_group grid = cg::this_grid();
    const int G = gridDim.x, bx = blockIdx.x, tid = threadIdx.x;
    const int lo = p_arg.ph_lo, hi = p_arg.ph_hi;
#ifndef PHMASK
#define PHMASK 0x7fff
#endif
#define IN(k) (((PHMASK >> (k)) & 1) && lo <= (k) && (k) < hi)
    unsigned* const barctr = (unsigned*)(p_arg.ws + WS_BAR); unsigned nbar = 0;
#define GRIDBAR() do { __syncthreads(); ++nbar; \
        if (tid == 0) { const unsigned target = nbar * (unsigned)G; __builtin_amdgcn_fence(__ATOMIC_RELEASE, "agent"); __hip_atomic_fetch_add(barctr, 1u, __ATOMIC_RELAXED, __HIP_MEMORY_SCOPE_AGENT); \
            while (__hip_atomic_load(barctr, __ATOMIC_RELAXED, __HIP_MEMORY_SCOPE_AGENT) < target) __builtin_amdgcn_s_sleep(1); \
            __builtin_amdgcn_fence(__ATOMIC_ACQUIRE, "agent"); } \
        __syncthreads(); } while (0)
#define SEAM(k) do { if (IN(k) && IN((k) + 1)) { if ((k) <= CG_SEAMS) grid.sync(); else GRIDBAR(); } } while (0)
#define PHASE_BEGIN(k) _Pragma("unroll 1") for (int rep_ = 0; rep_ < ((((REP_MASK) >> (k)) & 1) ? 2 : 1); ++rep_) { if (rep_) GRIDBAR();
#define PHASE_END }
#define R1 ((bf16_t*)(p.ws + WS_R1))
#define R2 ((bf16_t*)(p.ws + WS_R2))
#define ACT ((bf16_t*)(p.ws + WS_R3))
#define ZG ((bf16_t*)(p.ws + WS_R3 + GDN_BYTES))
#define XB ((bf16_t*)(p.ws + WS_R4))
#define GO XB
#define ZS5 (XB + (size_t)T * 512)
#define UCAT ((bf16_t*)(p.ws + WS_R5))
#define SUMSQ ((float*)(p.ws + WS_SUMSQ))
#define GATES ((float*)(p.ws + WS_GATES))
    PHASE_BEGIN(0)
    if (IN(0)) { KPR p = *launder_kp(); phase0(p, lds); }
    PHASE_END
    SEAM(0);
    PHASE_BEGIN(1)
    if (IN(1)) { KPR p = *launder_kp(); pg8::Gemm g{R1, (const bf16_t*)(p.ws + WS_W1T), 1024, 1024, 1024}; pg8::StaticOrder S; S.init(T, 2816, G, bx); Epi1 E{UCAT, R2, ZG, GATES}; pg8::gemm_phase(lds, g, S, E); }
    PHASE_END
    SEAM(1);
    PHASE_BEGIN(2)
    if (IN(2)) { KPR p = *launder_kp();
        { pg8::Gemm g{UCAT, (const bf16_t*)(p.ws + WS_HT), 384, 256, 256}; pg8::GroupOrder S{G, bx}; EpiS E{(float*)(p.ws + WS_R1)}; pg8::gemm_phase(lds, g, S, E); }
        __syncthreads();
        gdn_prep_phase(p, lds, bx, G);
        for (int i = bx * 512 + tid; i < 24 * 3 * 1536; i += G * 512) { const int c = i % 1536, j = (i / 1536) % 3, b = i / 4608;
            if (b < 8) p.out[O_PCONV + (size_t)(b * 3 + j) * 1536 + c] = bf2f(R2[(size_t)(b * 8192 + 8189 + j) * 1536 + c]);
            else p.out[O_SCONV + (size_t)((b - 8) * 3 + j) * 1536 + c] = bf2f(R2[(size_t)(TP + (b - 8) * 16 + 13 + j) * 1536 + c]); }
    }
    PHASE_END
    SEAM(2);
    PHASE_BEGIN(3)
    if (IN(3)) { KPR p = *launder_kp();
        for (int it = bx; it < 480; it += G) {
#ifdef REP_SUB
            if (rep_ == 1 && ((REP_SUB == 1) != (it < 128))) continue;
#endif
            if (it < 128) gdn_chain_item(p, it, lds);
            else if (it < 160) s5_scan_prompt(p, it - 128);
            else if (it < 416) gdn_chain_item(p, it - 160 + 128, lds);
            else s5_scan_sample(p, it - 416);
        }
        if (G > 160 && bx >= 160) { __syncthreads(); if (bx >= G - 32) s5_gen_group(p, bx - (G - 32), lds, 1); for (int it = 656 + (bx - 160); it < 5840; it += G - 160) wt_run(p, it, lds); }
        else if (G <= 160) { __syncthreads(); for (int g = bx; g < 32; g += G) s5_gen_group(p, g, lds, 1); }
    }
    PHASE_END
    SEAM(3);
    PHASE_BEGIN(4)
    if (IN(4)) { KPR p = *launder_kp();
        { pg8::Gemm g{UCAT, (const bf16_t*)(p.ws + WS_KGT), 384, 384, 384}; pg8::GroupOrder S{G, bx}; EpiY E{UCAT, p.in[19], ZS5}; pg8::gemm_phase(lds, g, S, E); }
        const float* nw = p.in[25];
        { const int tl_ = ltid(); const int l16 = tl_ & 15; const f32x4 w0 = *(const f32x4*)(nw + l16 * 8), w1 = *(const f32x4*)(nw + l16 * 8 + 4);
          const size_t gstride = ((size_t)G * 512) >> 4;
          for (size_t gi0 = ((size_t)bx * 512 + tl_) >> 4; gi0 < (size_t)T * 4; gi0 += 4 * gstride) {
            u32x4 ow[4], zw[4];
#pragma unroll
            for (int q = 0; q < 4; ++q) { const size_t gi = gi0 + q * gstride; if (gi < (size_t)T * 4) { const size_t r = gi >> 2; const int h = (int)(gi & 3);
                ow[q] = *(const u32x4*)(GO + r * 512 + h * 128 + l16 * 8); zw[q] = *(const u32x4*)(ZG + r * 512 + h * 128 + l16 * 8); } else { ow[q] = (u32x4){0u, 0u, 0u, 0u}; zw[q] = ow[q]; } }
#pragma unroll
            for (int q = 0; q < 4; ++q) { const size_t gi = gi0 + q * gstride; const size_t r = gi >> 2; const int h = (int)(gi & 3);
                f32x4 o0, o1, z0, z1; unpack8(ow[q], o0, o1); unpack8(zw[q], z0, z1);
                float s = (o0[0] * o0[0] + o0[1] * o0[1]) + (o0[2] * o0[2] + o0[3] * o0[3]) + (o1[0] * o1[0] + o1[1] * o1[1]) + (o1[2] * o1[2] + o1[3] * o1[3]);
                s += __shfl_xor(s, 1); s += __shfl_xor(s, 2); s += __shfl_xor(s, 4); s += __shfl_xor(s, 8);
                const float rs = rsqrtf(s * (1.0f / 128.0f) + 1e-6f);
                f32x4 y0, y1;
#pragma unroll
                for (int j = 0; j < 4; ++j) { y0[j] = o0[j] * rs * w0[j] * silu_f(z0[j]); y1[j] = o1[j] * rs * w1[j] * silu_f(z1[j]); }
                if (gi < (size_t)T * 4) *(u32x4*)(R1 + r * 1024 + 512 + h * 128 + l16 * 8) = pack8(y0, y1); } } }
    }
    PHASE_END
    SEAM(4);
    PHASE_BEGIN(5)
    if (IN(5)) { KPR p = *launder_kp(); pg8::Gemm g{ZS5, (const bf16_t*)(p.ws + WS_WGLU), 512, 512, 512}; pg8::StaticOrder S; S.init(T, 512, G, bx); EpiGlu E{ZS5, p.in[21], R1}; pg8::gemm_phase(lds, g, S, E); }
    PHASE_END
    SEAM(5);
    PHASE_BEGIN(6)
    if (IN(6)) { KPR p = *launder_kp(); pg8::Gemm g{R1, (const bf16_t*)(p.ws + WS_WOUT), 1024, 1024, 1024}; pg8::StaticOrder S; S.init(T, 1024, G, bx); EpiRes<true> E{p.in[0], p.in[1], XB, SUMSQ}; pg8::gemm_phase(lds, g, S, E); }
    PHASE_END
    SEAM(6);
    PHASE_BEGIN(7)
    if (IN(7)) { KPR p = *launder_kp(); pg8::Gemm g{XB, (const bf16_t*)(p.ws + WS_WF1_0), 1024, 1024, 1024}; pg8::StaticOrder S; S.init(T, 5632, G, bx); EpiFF E{SUMSQ, ACT}; pg8::gemm_phase(lds, g, S, E); }
    PHASE_END
    SEAM(7);
    PHASE_BEGIN(8)
    if (IN(8)) { KPR p = *launder_kp(); pg8::Gemm g{ACT, (const bf16_t*)(p.ws + WS_WFD_0), 2816, 2816, 2816}; pg8::StaticOrder S; S.init(T, 1024, G, bx); EpiRes<false> E{nullptr, nullptr, XB, SUMSQ + T}; pg8::gemm_phase(lds, g, S, E); }
    PHASE_END
    SEAM(8);
    PHASE_BEGIN(9)
    if (IN(9)) { KPR p = *launder_kp(); pg8::Gemm g{XB, (const bf16_t*)(p.ws + WS_WQKV), 1024, 1024, 1024}; pg8::StaticOrder S; S.init(T, 1536, G, bx);
        EpiQKV E{SUMSQ + T, R1, UCAT, UCAT + (size_t)T * 256, p.out + O_PK, p.out + O_PV, p.out + O_SK, p.out + O_SV}; pg8::gemm_phase(lds, g, S, E); }
    PHASE_END
    SEAM(9);
    PHASE_BEGIN(10)
    if (IN(10)) { KPR p = *launder_kp(); for (int it = bx; it < 4160; it += G) attn_item(p, it, lds); }
    PHASE_END
    SEAM(10);
    PHASE_BEGIN(11)
    if (IN(11)) { KPR p = *launder_kp(); pg8::Gemm g{R2, (const bf16_t*)(p.ws + WS_WO), 1024, 1024, 1024}; pg8::StaticOrder S; S.init(T, 1024, G, bx); EpiRes<false> E{nullptr, nullptr, XB, SUMSQ + 2 * T}; pg8::gemm_phase(lds, g, S, E); }
    PHASE_END
    SEAM(11);
    PHASE_BEGIN(12)
    if (IN(12)) { KPR p = *launder_kp(); pg8::Gemm g{XB, (const bf16_t*)(p.ws + WS_WF1_1), 1024, 1024, 1024}; pg8::StaticOrder S; S.init(T, 5632, G, bx); EpiFF E{SUMSQ + 2 * T, ACT}; pg8::gemm_phase(lds, g, S, E); }
    PHASE_END
    SEAM(12);
    PHASE_BEGIN(13)
    if (IN(13)) { KPR p = *launder_kp(); pg8::Gemm g{ACT, (const bf16_t*)(p.ws + WS_WFD_1), 2816, 2816, 2816}; pg8::StaticOrder S; S.init(T, 1024, G, bx); EpiRes<false> E{nullptr, nullptr, XB, SUMSQ + 3 * T}; pg8::gemm_phase(lds, g, S, E); }
    PHASE_END
    SEAM(13);
    PHASE_BEGIN(14)
    if (IN(14)) { KPR p = *launder_kp();
        const int tl_ = ltid(); const int lane = tl_ & 63, wid = tl_ >> 6; const float* nw = p.in[10]; const float* sq = SUMSQ + 3 * T;
        f32x4 wv[4];
#pragma unroll
        for (int i = 0; i < 4; ++i) wv[i] = *(const f32x4*)(nw + lane * 4 + i * 256);
        for (int r0 = bx * 8 + wid; r0 < T; r0 += G * 8 * 4) {
            u32x2 bw[4][4]; float rs[4];
#pragma unroll
            for (int q = 0; q < 4; ++q) { const int r = r0 + q * G * 8; rs[q] = 0.f;
#pragma unroll
                for (int i = 0; i < 4; ++i) bw[q][i] = (u32x2){0u, 0u};
                if (r < T) { rs[q] = sq[r]; const bf16_t* xs = XB + (size_t)r * 1024;
#pragma unroll
                    for (int i = 0; i < 4; ++i) bw[q][i] = *(const u32x2*)(xs + lane * 4 + i * 256); } }
#pragma unroll
            for (int q = 0; q < 4; ++q) { const int r = r0 + q * G * 8; if (r < T) { const float sc = rsqrtf(rs[q] * (1.0f / 1024.0f) + 1e-6f); float* xp = p.out + (size_t)r * 1024;
#pragma unroll
                for (int i = 0; i < 4; ++i) { const f32x4 v = (f32x4){bflo(bw[q][i].x), bfhi(bw[q][i].x), bflo(bw[q][i].y), bfhi(bw[q][i].y)}; *(f32x4*)(xp + lane * 4 + i * 256) = v * sc * wv[i]; } } }
        }
    }
    PHASE_END
#undef IN
#undef SEAM
}

extern "C" void kernel_launch(void* const* d_in, const int* in_sizes, int n_in, void* d_out, int out_size, void* d_ws, size_t ws_size, hipStream_t stream) {
    static int grid_blocks = 0;
    if (!grid_blocks) {
        int dev = 0, cus = 0, per_cu = 0;
        hipGetDevice(&dev);
        hipDeviceGetAttribute(&cus, hipDeviceAttributeMultiprocessorCount, dev);
        hipFuncSetAttribute((const void*)fwd_kernel, hipFuncAttributeMaxDynamicSharedMemorySize, LDS_BYTES);
        hipOccupancyMaxActiveBlocksPerMultiprocessor(&per_cu, (const void*)fwd_kernel, 512, LDS_BYTES);
        if (per_cu < 1) per_cu = 1;
        grid_blocks = cus * per_cu;
        if (ws_size < WS_END) fprintf(stderr, "kernel_launch: workspace too small: %zu < %zu\n", ws_size, (size_t)WS_END);
    }
    Params p{};
    for (int i = 0; i < 35; ++i) p.in[i] = (const float*)d_in[i];
    p.out = (float*)d_out; p.ws = (unsigned char*)d_ws; p.ph_lo = 0; p.ph_hi = PH_HI;
    void* args[] = {&p};
    hipError_t e = hipLaunchCooperativeKernel((const void*)fwd_kernel, dim3(grid_blocks), dim3(512), args, LDS_BYTES, stream);
    if (e != hipSuccess) fprintf(stderr, "cooperative launch failed: %s (grid %d)\n", hipGetErrorString(e), grid_blocks);
}
```
